# Optimizing an MI355X kernel written in HIP

```python
import math
import jax, jax.numpy as jnp
from jax import lax
import numpy as np

D_MODEL = 1024
BATCH = 4
SEQ = 4096
DEPTH = 4

HEAD_DIM = 64
REC_WIDTH = 3 * D_MODEL // 8
REC_HEADS = REC_WIDTH // HEAD_DIM
REC_CONV = 4
REC_C = 8.0
DIFF_WIDTH = 3 * D_MODEL // 8
DIFF_HEADS = DIFF_WIDTH // HEAD_DIM
DIFF_SUB = HEAD_DIM // 2
ROPE_THETA = 500000.0
ROPE_DIM = DIFF_SUB // 4
Q_BLOCK = 128
RET_WIDTH = D_MODEL // 4
RET_HEADS = RET_WIDTH // HEAD_DIM
RET_CHUNK = 128
RET_ROT_BASE = 10000.0
MIX_WIDTH = REC_WIDTH + DIFF_WIDTH + RET_WIDTH
IN_SIZES = (REC_WIDTH, REC_WIDTH,
            DIFF_WIDTH, DIFF_WIDTH, DIFF_WIDTH,
            RET_WIDTH, RET_WIDTH, RET_WIDTH, RET_WIDTH)
IN_WIDTH = sum(IN_SIZES)
D_FF = 2816
N_MOD = 9
EPS = 1e-6

kernel_name = "hybrid_macaron_rglru_diffattn_retention_adaln"


def rmsnorm(x, g):
    xf = x.astype(jnp.float32)
    y = xf * lax.rsqrt(jnp.mean(xf * xf, axis=-1, keepdims=True) + EPS)
    return (y * g.astype(jnp.float32)).astype(x.dtype)


def modulate(h, shift, scale):
    return h * (1.0 + scale) + shift


def swiglu(h, w_in, w_out):
    hg, hu = jnp.split(h @ w_in, 2, axis=-1)
    return (jax.nn.silu(hg) * hu) @ w_out


def rotary(x, pos, rot_dim, base):
    half = rot_dim // 2
    inv = jnp.power(jnp.float32(base), -jnp.arange(half, dtype=jnp.float32) * (2.0 / rot_dim))
    ang = pos.astype(jnp.float32)[:, :, None] * inv
    ang = ang.reshape(ang.shape[:2] + (1,) * (x.ndim - 3) + (half,))
    cos, sin = jnp.cos(ang), jnp.sin(ang)
    xr = x[..., :rot_dim].astype(jnp.float32)
    x1, x2 = xr[..., :half], xr[..., half:]
    rot = jnp.concatenate([x1 * cos - x2 * sin, x2 * cos + x1 * sin], axis=-1).astype(x.dtype)
    return jnp.concatenate([rot, x[..., rot_dim:]], axis=-1)


def _lru_combine(left, right):
    a_l, b_l = left
    a_r, b_r = right
    return a_l * a_r, a_r * b_l + b_r


def rglru_group(xr, gate, conv_w, conv_b, wa, ba, wx, bx, lam):
    B, T, _ = xr.shape
    xc = lax.conv_general_dilated(xr, conv_w[:, None, :], window_strides=(1,),
                                  padding=[(REC_CONV - 1, 0)],
                                  dimension_numbers=('NWC', 'WIO', 'NWC'),
                                  feature_group_count=REC_WIDTH) + conv_b
    xb = xc.reshape(B, T, REC_HEADS, HEAD_DIM)
    r = jax.nn.sigmoid(jnp.einsum('bthi,hij->bthj', xb, wa).reshape(B, T, REC_WIDTH) + ba)
    i = jax.nn.sigmoid(jnp.einsum('bthi,hij->bthj', xb, wx).reshape(B, T, REC_WIDTH) + bx)
    log_a = -REC_C * r.astype(jnp.float32) * jax.nn.softplus(-lam.astype(jnp.float32))
    a = jnp.exp(log_a)
    b = jnp.sqrt(-jnp.expm1(2.0 * log_a)) * (i * xc).astype(jnp.float32)
    _, h = lax.associative_scan(_lru_combine, (a, b), axis=1)
    return jax.nn.gelu(gate) * h.astype(gate.dtype)


def diff_attention_group(q, k, v, positions, lq1, lk1, lq2, lk2, subln_g, lambda_init):
    B, T, _ = q.shape
    q = rotary(q.reshape(B, T, DIFF_HEADS, 2, DIFF_SUB), positions, ROPE_DIM, ROPE_THETA)
    k = rotary(k.reshape(B, T, DIFF_HEADS, 2, DIFF_SUB), positions, ROPE_DIM, ROPE_THETA)
    q = q.transpose(0, 2, 3, 1, 4)
    k = k.transpose(0, 2, 3, 1, 4)
    v = v.reshape(B, T, DIFF_HEADS, HEAD_DIM).transpose(0, 2, 1, 3)
    scale = DIFF_SUB ** -0.5
    lam = (jnp.exp(jnp.sum(lq1.astype(jnp.float32) * lk1.astype(jnp.float32)))
           - jnp.exp(jnp.sum(lq2.astype(jnp.float32) * lk2.astype(jnp.float32))) + lambda_init)
    outs = []
    for blk in range(T // Q_BLOCK):
        s0 = blk * Q_BLOCK
        end = s0 + Q_BLOCK
        scores = jnp.einsum('bhsqd,bhskd->bhsqk', q[:, :, :, s0:end], k[:, :, :, :end]).astype(jnp.float32) * scale
        mask = jnp.arange(end)[None, :] <= (s0 + jnp.arange(Q_BLOCK))[:, None]
        p = jax.nn.softmax(jnp.where(mask, scores, -jnp.inf), axis=-1)
        w = p[:, :, 0] - lam * p[:, :, 1]
        outs.append(jnp.einsum('bhqk,bhkd->bhqd', w.astype(v.dtype), v[:, :, :end]))
    o = jnp.concatenate(outs, axis=2)
    o = rmsnorm(o, subln_g) * (1.0 - lambda_init)
    return o.transpose(0, 2, 1, 3).reshape(B, T, DIFF_WIDTH)


def retention_group(q, k, v, g, positions):
    B, T, _ = q.shape
    C = RET_CHUNK
    N = T // C
    q = rotary(q.reshape(B, T, RET_HEADS, HEAD_DIM), positions, HEAD_DIM, RET_ROT_BASE)
    k = rotary(k.reshape(B, T, RET_HEADS, HEAD_DIM), positions, HEAD_DIM, RET_ROT_BASE) * (HEAD_DIM ** -0.5)
    v = v.reshape(B, T, RET_HEADS, HEAD_DIM)
    to_chunks = lambda t: t.astype(jnp.float32).transpose(0, 2, 1, 3).reshape(B, RET_HEADS, N, C, HEAD_DIM)
    qc, kc, vc = to_chunks(q), to_chunks(k), to_chunks(v)
    lg = jnp.log1p(-jnp.exp2(-5.0 - jnp.arange(RET_HEADS, dtype=jnp.float32)))
    idx = jnp.arange(C, dtype=jnp.float32)
    rel = idx[:, None] - idx[None, :]
    decay = jnp.where(rel >= 0, jnp.exp(jnp.maximum(rel, 0.0)[None] * lg[:, None, None]), 0.0)
    intra = jnp.einsum('bhncd,bhnmd->bhncm', qc, kc) * decay[None, :, None]
    o_intra = jnp.einsum('bhncm,bhnme->bhnce', intra, vc)
    k_decay = jnp.exp((C - 1.0 - idx)[None, :] * lg[:, None])
    kv = jnp.einsum('bhncd,bhnce->bhnde', kc * k_decay[None, :, None, :, None], vc)
    chunk_decay = jnp.exp(C * lg)[None, :, None, None]

    def step(state, kv_i):
        return chunk_decay * state + kv_i, state

    _, r_prev = lax.scan(step, jnp.zeros((B, RET_HEADS, HEAD_DIM, HEAD_DIM), jnp.float32),
                         jnp.moveaxis(kv, 2, 0))
    r_prev = jnp.moveaxis(r_prev, 0, 2)
    q_decay = jnp.exp((idx + 1.0)[None, :] * lg[:, None])
    o_cross = jnp.einsum('bhncd,bhnde->bhnce', qc * q_decay[None, :, None, :, None], r_prev)
    o = (o_intra + o_cross).reshape(B, RET_HEADS, T, HEAD_DIM)
    o = o * lax.rsqrt(jnp.mean(o * o, axis=-1, keepdims=True) + EPS)
    o = o.transpose(0, 2, 1, 3).reshape(B, T, RET_WIDTH)
    return (jax.nn.silu(g.astype(jnp.float32)) * o).astype(g.dtype)


def setup_inputs(seed: int = 0) -> dict:
    key = jax.random.key(seed)
    ks = jax.random.split(key, 32)
    f32 = jnp.float32
    D, F, L = D_MODEL, D_FF, DEPTH
    nrm = lambda k, shape, s: jax.random.normal(k, shape, f32) * s
    x = nrm(ks[0], (BATCH, SEQ, D), 1.0)
    c = nrm(ks[1], (BATCH, D), 1.0)
    positions = (jnp.arange(SEQ, dtype=jnp.int32)[None, :]
                 + jax.random.randint(ks[2], (BATCH, 1), 0, 1024, dtype=jnp.int32))
    u = jax.random.uniform(ks[20], (L, REC_WIDTH), f32, 0.9, 0.999)
    p = u ** (1.0 / REC_C)
    rec_lambda = jnp.log(p) - jnp.log1p(-p)
    return {
        "x": x,
        "c": c,
        "positions": positions,
        "norm_ffn1_g": 1.0 + nrm(ks[3], (L, D), 0.02),
        "norm_mix_g": 1.0 + nrm(ks[4], (L, D), 0.02),
        "norm_ffn2_g": 1.0 + nrm(ks[5], (L, D), 0.02),
        "ada_w": nrm(ks[6], (L, D, N_MOD * D), 0.5 * D ** -0.5),
        "ada_b": nrm(ks[7], (L, N_MOD * D), 0.02),
        "ffn1_w_in": nrm(ks[8], (L, D, 2 * F), D ** -0.5),
        "ffn1_w_out": nrm(ks[9], (L, F, D), F ** -0.5),
        "ffn2_w_in": nrm(ks[10], (L, D, 2 * F), D ** -0.5),
        "ffn2_w_out": nrm(ks[11], (L, F, D), F ** -0.5),
        "w_in": nrm(ks[12], (L, D, IN_WIDTH), D ** -0.5),
        "w_out": nrm(ks[13], (L, MIX_WIDTH, D), MIX_WIDTH ** -0.5),
        "rec_conv_w": nrm(ks[14], (L, REC_CONV, REC_WIDTH), REC_CONV ** -0.5),
        "rec_conv_b": nrm(ks[15], (L, REC_WIDTH), 0.02),
        "rec_gate_a_w": nrm(ks[16], (L, REC_HEADS, HEAD_DIM, HEAD_DIM), HEAD_DIM ** -0.5),
        "rec_gate_a_b": nrm(ks[17], (L, REC_WIDTH), 0.02),
        "rec_gate_x_w": nrm(ks[18], (L, REC_HEADS, HEAD_DIM, HEAD_DIM), HEAD_DIM ** -0.5),
        "rec_gate_x_b": nrm(ks[19], (L, REC_WIDTH), 0.02),
        "rec_lambda": rec_lambda,
        "diff_lambda_q1": nrm(ks[21], (L, DIFF_SUB), 0.1),
        "diff_lambda_k1": nrm(ks[22], (L, DIFF_SUB), 0.1),
        "diff_lambda_q2": nrm(ks[23], (L, DIFF_SUB), 0.1),
        "diff_lambda_k2": nrm(ks[24], (L, DIFF_SUB), 0.1),
        "diff_subln_g": 1.0 + nrm(ks[25], (L, HEAD_DIM), 0.02),
        "final_norm_g": 1.0 + nrm(ks[26], (D,), 0.02),
    }


def reference(x, c, positions, norm_ffn1_g, norm_mix_g, norm_ffn2_g, ada_w, ada_b,
              ffn1_w_in, ffn1_w_out, ffn2_w_in, ffn2_w_out, w_in, w_out,
              rec_conv_w, rec_conv_b, rec_gate_a_w, rec_gate_a_b, rec_gate_x_w, rec_gate_x_b,
              rec_lambda, diff_lambda_q1, diff_lambda_k1, diff_lambda_q2, diff_lambda_k2,
              diff_subln_g, final_norm_g):
    split_at = [int(s) for s in np.cumsum(IN_SIZES)[:-1]]
    silu_c = jax.nn.silu(c)
    for l in range(DEPTH):
        mod = (silu_c @ ada_w[l] + ada_b[l])[:, None, :]
        sh1, sc1, g1, sh2, sc2, g2, sh3, sc3, g3 = jnp.split(mod, N_MOD, axis=-1)
        h = modulate(rmsnorm(x, norm_ffn1_g[l]), sh1, sc1)
        x = x + 0.5 * g1 * swiglu(h, ffn1_w_in[l], ffn1_w_out[l])
        h = modulate(rmsnorm(x, norm_mix_g[l]), sh2, sc2)
        rx, rg, dq, dk, dv, tq, tk, tv, tg = jnp.split(h @ w_in[l], split_at, axis=-1)
        y_rec = rglru_group(rx, rg, rec_conv_w[l], rec_conv_b[l], rec_gate_a_w[l], rec_gate_a_b[l],
                            rec_gate_x_w[l], rec_gate_x_b[l], rec_lambda[l])
        lambda_init = 0.8 - 0.6 * math.exp(-0.3 * l)
        y_diff = diff_attention_group(dq, dk, dv, positions, diff_lambda_q1[l], diff_lambda_k1[l],
                                      diff_lambda_q2[l], diff_lambda_k2[l], diff_subln_g[l], lambda_init)
        y_ret = retention_group(tq, tk, tv, tg, positions)
        y = jnp.concatenate([y_rec, y_diff, y_ret], axis=-1) @ w_out[l]
        x = x + g2 * y
        h = modulate(rmsnorm(x, norm_ffn2_g[l]), sh3, sc3)
        x = x + 0.5 * g3 * swiglu(h, ffn2_w_in[l], ffn2_w_out[l])
    return rmsnorm(x, final_norm_g)
```

```cpp
#include <hip/hip_runtime.h>
#include <cstdio>
#include <cstdint>
#include <cmath>

#ifndef MK_ONE_LAUNCH
#define MK_ONE_LAUNCH 1
#endif
#ifndef PROBE_REP5
#define PROBE_REP5 1
#endif
#ifndef PROBE_EPIR2
#define PROBE_EPIR2 0
#endif
#ifndef PROBE_EPI2
#define PROBE_EPI2 0
#endif
#ifndef PROBE_XEXP
#define PROBE_XEXP 0
#endif
#if PROBE_XEXP
#define PROBE_EXTRA_EXP(pa, pb) do { _Pragma("unroll") for (int r = 0; r < 16; ++r) { float d0_, d1_; asm volatile("v_exp_f32 %0, %2\n\tv_exp_f32 %1, %3" : "=v"(d0_), "=v"(d1_) : "v"(pa[r]), "v"(pb[r])); } } while (0)
#else
#define PROBE_EXTRA_EXP(pa, pb) do { } while (0)
#endif
#ifndef MK_SP2
#define MK_SP2 true
#endif
#ifndef PROBE_REPO
#define PROBE_REPO 1
#endif
#ifndef PROBE_REPP
#define PROBE_REPP 1
#endif
#ifndef PROBE_REPR
#define PROBE_REPR 1
#endif
#ifndef PROBE_BAR2
#define PROBE_BAR2 0
#endif
#ifndef PROBE_REPG
#define PROBE_REPG 1
#endif
#ifndef MK_NAIVE_MIX
#define MK_NAIVE_MIX 0
#endif
#ifndef MK_NAIVE_MASK
#define MK_NAIVE_MASK 0
#endif

constexpr int D = 1024, NB = 4, T = 4096, M = NB * T, NL = 4, F = 2816, NMOD = 9, NMD = NMOD * D;
constexpr int NIN = 2944, NINP = 3072;
constexpr int C_DQ = 0, C_DK = 384, C_TQ = 768, C_TK = 1024, C_DV = 1280, C_TV = 1664, C_TG = 1920, C_RX = 2176, C_RG = 2560;
constexpr int RW = 384;
constexpr float EPS = 1e-6f;
constexpr float QSCALE = 0.17677669529663687f * 1.4426950408889634f;
constexpr int KC = 32, NKC = D / KC;

constexpr size_t MiB = 1u << 20;
constexpr size_t WS_CTL = 0, CTL_ZERO_BYTES = 1 * MiB;
constexpr size_t WS_MODP = 1 * MiB;
constexpr size_t WS_MOD = 20 * MiB;
constexpr size_t WS_GW = 20 * MiB + 640 * 1024;
constexpr size_t WS_TABD = 21 * MiB;
constexpr size_t WS_TABR = 22 * MiB;
constexpr size_t WS_W = 26 * MiB;
constexpr size_t W_L = 41 * MiB, W_1IN = 0, W_1OUT = 11 * MiB, W_2IN = 16 * MiB + MiB / 2, W_2OUT = 27 * MiB + MiB / 2, W_IN = 33 * MiB, W_OUT = 39 * MiB;
constexpr size_t WS_X = WS_W + NL * W_L;
constexpr size_t WS_H = WS_X + 64 * MiB;
constexpr size_t WS_Y = WS_H + 32 * MiB;
constexpr size_t WS_ACT = WS_Y + 32 * MiB;
constexpr size_t WS_PROJ = WS_ACT;
constexpr size_t WS_TMP = WS_ACT + 96 * MiB;
constexpr size_t WS_SP8 = 21 * MiB + 512 * 1024;
constexpr size_t WS_LAMS = 21 * MiB + 520 * 1024;
constexpr size_t WS_ANORM = 21 * MiB + 528 * 1024;
constexpr size_t WS_BIAS = WS_TMP + 100 * MiB;
constexpr size_t WS_SSQ = WS_TMP + 104 * MiB;
constexpr size_t WS_AGGA = WS_TMP + 110 * MiB, WS_AGGB = WS_TMP + 111 * MiB;
constexpr size_t WS_END = WS_TMP + 112 * MiB;
constexpr int CW_TMO = 0, CW_CODE = 1, CW_Q = 2048  , CW_BAR = 4096;

#define GAS __attribute__((address_space(1)))
#define LAS __attribute__((address_space(3)))
typedef unsigned short bf16_t;
typedef short bf16x8 __attribute__((ext_vector_type(8)));
typedef float f32x4 __attribute__((ext_vector_type(4)));
typedef float f32x2 __attribute__((ext_vector_type(2)));
typedef unsigned u32x4 __attribute__((ext_vector_type(4)));
typedef unsigned u32x2 __attribute__((ext_vector_type(2)));
typedef __bf16 bf16x2_t __attribute__((ext_vector_type(2)));
typedef GAS unsigned gu32;
#define RLX_AGENT __ATOMIC_RELAXED, __HIP_MEMORY_SCOPE_AGENT
#define LDS_WAIT() asm volatile("s_waitcnt lgkmcnt(0)" ::: "memory")
#define VM_WAIT() asm volatile("s_waitcnt vmcnt(0)" ::: "memory")
__device__ __forceinline__ unsigned pk2(float lo, float hi) { f32x2 v = {lo, hi}; bf16x2_t b = __builtin_convertvector(v, bf16x2_t); return __builtin_bit_cast(unsigned, b); }
typedef _Float16 h16x2_t __attribute__((ext_vector_type(2)));
__device__ __forceinline__ unsigned pkh2(float lo, float hi) { f32x2 v = {lo, hi}; h16x2_t h = __builtin_convertvector(v, h16x2_t); return __builtin_bit_cast(unsigned, h); }
__device__ __forceinline__ float hlo(unsigned w) { const h16x2_t h = __builtin_bit_cast(h16x2_t, w); return (float)h[0]; }
__device__ __forceinline__ float hhi(unsigned w) { const h16x2_t h = __builtin_bit_cast(h16x2_t, w); return (float)h[1]; }
__device__ __forceinline__ float bf2f(bf16_t v) { return __uint_as_float((unsigned)v << 16); }
__device__ __forceinline__ float bflo(unsigned w) { return __uint_as_float(w << 16); }
__device__ __forceinline__ float bfhi(unsigned w) { return __uint_as_float(w & 0xffff0000u); }
__device__ __forceinline__ float fast_rcp(float x) { return __builtin_amdgcn_rcpf(x); }
__device__ __forceinline__ float sigmoidf_(float x) { return fast_rcp(1.f + __builtin_amdgcn_exp2f(-1.4426950408889634f * x)); }
__device__ __forceinline__ float siluf_(float x) { return x * sigmoidf_(x); }
__device__ __forceinline__ float gelu_tanh(float x) { const float u = 0.7978845608028654f * (x + 0.044715f * x * x * x); return x * sigmoidf_(2.f * u); }
__device__ __forceinline__ int lane_id() { int l; asm volatile("v_mbcnt_lo_u32_b32 %0, -1, 0\n\tv_mbcnt_hi_u32_b32 %0, -1, %0" : "=v"(l)); return l; }
template <int XM> __device__ __forceinline__ float swz_xor(float v) { return __int_as_float(__builtin_amdgcn_ds_swizzle(__float_as_int(v), (XM << 10) | 0x1F)); }
__device__ __forceinline__ float sum_x32(float v) { const auto r = __builtin_amdgcn_permlane32_swap(__float_as_uint(v), __float_as_uint(v), false, false); return __uint_as_float(r[0]) + __uint_as_float(r[1]); }
__device__ __forceinline__ int imax_x32(int v) { const auto r = __builtin_amdgcn_permlane32_swap((unsigned)v, (unsigned)v, false, false); const int a = (int)r[0], b = (int)r[1]; return a > b ? a : b; }
__device__ __forceinline__ float wave_sum(float v) {
    v += swz_xor<1>(v); v += swz_xor<2>(v); v += swz_xor<4>(v); v += swz_xor<8>(v); v += swz_xor<16>(v);
    return sum_x32(v);
}

__device__ __forceinline__ float lg2gamma(int hh) { return hh == 0 ? -0.04580368961312479f : hh == 1 ? -0.02272007650008353f : hh == 2 ? -0.011315313227834146f : -0.005646563141142063f; }

constexpr int RING_OFF = 0, RING_BYTES = 131072, LDSCTL_OFF = RING_BYTES, MISC_OFF = LDSCTL_OFF + 320, LDS_RSTD_OFF = RING_BYTES + 1024  , LDS_BYTES = 163840;
extern __shared__ __attribute__((aligned(16))) unsigned char lds_raw[];

namespace pg8 {
#define PG8_LAS __attribute__((address_space(3)))
constexpr int BM = 256, BK = 64, HALF = 128, HTB = HALF * BK * 2, STAGE_BYTES = 8 * HTB, NXCD = 8, WGM = 8;
__host__ __device__ __forceinline__ int lds_byte(int r, int c) { const int st = (r >> 4) * 2 + (c >> 5), rr = r & 15, cc = c & 31, ob = rr * 64 + cc * 2; return st * 1024 + (ob ^ (((ob >> 9) & 1) << 5)); }
__host__ __device__ __forceinline__ void stage_rc(int b, int& R, int& C) { const int st = b / 1024, sb = b % 1024, swz = sb ^ (((sb >> 9) & 1) << 5); R = (st >> 1) * 16 + swz / 64; C = (st & 1) * 32 + (swz % 64) / 2; }
__host__ __device__ __forceinline__ int perm32(int rho) { const int n = rho >> 4, i = rho & 15; return 8 * (i >> 2) + 4 * n + (i & 3); }
struct Unit { int pm, pn, idx; };
struct Gemm { const bf16_t* A; const bf16_t* Bt; int M, N, K, tiled; };
struct StaticOrder {
    int nM, nN, nwg, G, c;
    __host__ __device__ void init(int M_, int N_, int G_, int c_) { nM = M_ / BM; nN = N_ / BM; nwg = nM * nN; G = G_; c = c_;
#if defined(__HIP_DEVICE_COMPILE__)
        asm volatile("" : "+s"(c));
#endif
    }
    __host__ __device__ __forceinline__ bool next(int i, Unit& u) const {
        const long L = (long)i * G + c; if (L >= nwg) return false;
        int wgid = (int)L; { const int q = nwg / NXCD, r = nwg % NXCD, xcd = wgid % NXCD, off = wgid / NXCD; wgid = (xcd < r ? xcd * (q + 1) : r * (q + 1) + (xcd - r) * q) + off; }
        const int nig = WGM * nN, gid = wgid / nig, fm = gid * WGM, gsz = (nM - fm) < WGM ? (nM - fm) : WGM;
        u.pm = fm + ((wgid % nig) % gsz); u.pn = (wgid % nig) / gsz; u.idx = i; return true;
    }
    __device__ __forceinline__ void a_ready(const Unit&) const {}
    __device__ __forceinline__ void done(const Unit&) const {}
};

struct EpiSwiglu {
    static constexpr bool PERM = true, AFTER_DRAIN = false;
    unsigned char* ws; int lg;
    __device__ __forceinline__ void operator()(const f32x4 (&acc)[2][2][4][2], const Unit& u, int wr, int wc, int fr, int fq) const {
        bf16_t* O = (bf16_t*)(ws + WS_ACT); const float* bias = (const float*)(ws + WS_BIAS) + (size_t)lg * NB * (2 * F); const LAS float* rstd = (const LAS float*)((LAS unsigned char*)lds_raw + LDS_RSTD_OFF);
        const int row0 = u.pm * BM + wr * 64 + fr, col0 = u.pn * HALF + wc * 32 + 8 * fq;
        const float* bp = bias + (size_t)(u.pm >> 4) * (2 * F) + u.pn * BM + wc * 32 + 8 * fq;
        const f32x4 bg0 = *(const f32x4*)bp, bg1 = *(const f32x4*)(bp + 4), bu0 = *(const f32x4*)(bp + HALF), bu1 = *(const f32x4*)(bp + HALF + 4);
#pragma unroll
        for (int ai = 0; ai < 2; ++ai)
#pragma unroll
            for (int m = 0; m < 4; ++m) {
                const float rs = rstd[u.idx * BM + ai * HALF + m * 16 + wr * 64 + fr];
                const int row_ = row0 + ai * HALF + m * 16;
                bf16_t* rowp = O + ((((size_t)(row_ >> 8) * (F / 64) + (col0 >> 6)) * BM + (row_ & 255)) << 6) + (col0 & 63);
                const f32x4 g0 = acc[ai][0][m][0] * rs + bg0, g1 = acc[ai][0][m][1] * rs + bg1, u0 = acc[ai][1][m][0] * rs + bu0, u1 = acc[ai][1][m][1] * rs + bu1;
                u32x4 w;
                w.x = pk2(siluf_(g0[0]) * u0[0], siluf_(g0[1]) * u0[1]); w.y = pk2(siluf_(g0[2]) * u0[2], siluf_(g0[3]) * u0[3]);
                w.z = pk2(siluf_(g1[0]) * u1[0], siluf_(g1[1]) * u1[1]); w.w = pk2(siluf_(g1[2]) * u1[2], siluf_(g1[3]) * u1[3]);
                *(u32x4*)rowp = w;
            }
    }
};
struct EpiResid {
    static constexpr bool PERM = true, AFTER_DRAIN = false;
    unsigned char* ws; int l, gidx, an_idx, slot; float coef;
    __device__ __forceinline__ void operator()(const f32x4 (&acc)[2][2][4][2], const Unit& u, int wr, int wc, int fr, int fq) const {
        bf16_t* X = (bf16_t*)(ws + WS_X); bf16_t* XS = (bf16_t*)(ws + WS_H); float* SSQ = (float*)(ws + WS_SSQ) + (size_t)slot * M * 16;
        const float* gate = (const float*)(ws + WS_MOD) + (size_t)l * NB * NMD + gidx * D; const float* An = (const float*)(ws + WS_ANORM) + (size_t)(an_idx < 0 ? 0 : an_idx) * NB * D; const bool has_an = an_idx >= 0;
        const int row0 = u.pm * BM + wr * 64 + fr, col0 = u.pn * BM + wc * 32 + 8 * fq, b = u.pm >> 4;
        f32x4 gv[2][2], av[2][2];
#pragma unroll
        for (int bj = 0; bj < 2; ++bj)
#pragma unroll
            for (int n = 0; n < 2; ++n) { gv[bj][n] = *(const f32x4*)(gate + (size_t)b * NMD + col0 + bj * HALF + n * 4) * coef;
                av[bj][n] = *(const f32x4*)(An + (size_t)b * D + col0 + bj * HALF + n * 4); }
        u32x4 xin[2][2];
#define RES_LOAD(g_, buf) do { const size_t ro_ = (size_t)(row0 + ((g_) >> 2) * HALF + ((g_) & 3) * 16) * D + col0; \
            _Pragma("unroll") for (int bj = 0; bj < 2; ++bj) xin[buf][bj] = *(const u32x4*)(X + ro_ + bj * HALF); } while (0)
        RES_LOAD(0, 0);
#pragma unroll
        for (int g = 0; g < 8; ++g) { const int ai = g >> 2, m = g & 3, row = row0 + ai * HALF + m * 16; const size_t ro = (size_t)row * D + col0; float ss = 0.f;
            if (g + 1 < 8) RES_LOAD(g + 1, (g + 1) & 1);
#pragma unroll
            for (int bj = 0; bj < 2; ++bj) { const size_t o = ro + bj * HALF; const u32x4 xi = xin[g & 1][bj];
                const f32x4 x0 = (f32x4){hlo(xi.x), hhi(xi.x), hlo(xi.y), hhi(xi.y)} + gv[bj][0] * acc[ai][bj][m][0], x1 = (f32x4){hlo(xi.z), hhi(xi.z), hlo(xi.w), hhi(xi.w)} + gv[bj][1] * acc[ai][bj][m][1];
                { u32x4 w; w.x = pkh2(x0[0], x0[1]); w.y = pkh2(x0[2], x0[3]); w.z = pkh2(x1[0], x1[1]); w.w = pkh2(x1[2], x1[3]); *(u32x4*)(X + o) = w; }
                ss += ((x0[0] * x0[0] + x0[1] * x0[1]) + (x0[2] * x0[2] + x0[3] * x0[3])) + ((x1[0] * x1[0] + x1[1] * x1[1]) + (x1[2] * x1[2] + x1[3] * x1[3]));
                if (has_an) { const f32x4 s0 = x0 * av[bj][0], s1 = x1 * av[bj][1]; u32x4 w; w.x = pk2(s0[0], s0[1]); w.y = pk2(s0[2], s0[3]); w.z = pk2(s1[0], s1[1]); w.w = pk2(s1[2], s1[3]); *(u32x4*)(XS + o) = w; } }
            ss += swz_xor<16>(ss); ss = sum_x32(ss);
            if (fq == 0) SSQ[(size_t)row * 16 + u.pn * 4 + wc] = ss; }
#undef RES_LOAD
    }
};
struct EpiMixIn {
    static constexpr bool PERM = true, AFTER_DRAIN = false;
    unsigned char* ws; int l;
    __device__ __forceinline__ void operator()(const f32x4 (&acc)[2][2][4][2], const Unit& u, int wr, int wc, int fr, int fq) const {
        bf16_t* O = (bf16_t*)(ws + WS_PROJ); const float* tabD = (const float*)(ws + WS_TABD); const float* tabR = (const float*)(ws + WS_TABR);
        const float* bias = (const float*)(ws + WS_BIAS) + (size_t)(3 * l + 1) * NB * (2 * F); const LAS float* rstd = (const LAS float*)((LAS unsigned char*)lds_raw + LDS_RSTD_OFF);
        const int row0 = u.pm * BM + wr * 64 + fr;
#pragma unroll
        for (int bj = 0; bj < 2; ++bj) {
            const int kb = 2 * u.pn + bj, col0 = kb * HALF + wc * 32 + 8 * fq;
            const f32x4 b0 = *(const f32x4*)(bias + (size_t)(u.pm >> 4) * (2 * F) + col0), b1 = *(const f32x4*)(bias + (size_t)(u.pm >> 4) * (2 * F) + col0 + 4);
            if (kb < 6) {
                const float qs = (kb < 3) ? QSCALE : 1.f;
#pragma unroll
                for (int ai = 0; ai < 2; ++ai)
#pragma unroll
                    for (int m = 0; m < 4; ++m) { const int row = row0 + ai * HALF + m * 16; const float rs = rstd[u.idx * BM + ai * HALF + m * 16 + wr * 64 + fr];
                        f32x4 v0 = acc[ai][bj][m][0] * rs + b0, v1 = acc[ai][bj][m][1] * rs + b1;
                        if (fq == 0) { const f32x4 c = *(const f32x4*)(tabD + (size_t)row * 8), s = *(const f32x4*)(tabD + (size_t)row * 8 + 4); const f32x4 r0 = v0 * c - v1 * s, r1 = v1 * c + v0 * s; v0 = r0; v1 = r1; }
                        v0 = v0 * qs; v1 = v1 * qs;
                        u32x4 w; w.x = pk2(v0[0], v0[1]); w.y = pk2(v0[2], v0[3]); w.z = pk2(v1[0], v1[1]); w.w = pk2(v1[2], v1[3]);
                        *(u32x4*)(O + (size_t)row * NINP + col0) = w; }
            } else if (kb < 10) {
                const bool isk = (kb >= 8); const int i0 = 16 * (wc & 1) + 4 * fq; const float lg = lg2gamma(2 * (kb & 1) + (wc >> 1)) * (isk ? -1.f : 1.f);
#pragma unroll
                for (int ai = 0; ai < 2; ++ai)
#pragma unroll
                    for (int m = 0; m < 4; ++m) { const int row = row0 + ai * HALF + m * 16; const float rs = rstd[u.idx * BM + ai * HALF + m * 16 + wr * 64 + fr];
                        const f32x4 v0 = acc[ai][bj][m][0] * rs + b0, v1 = acc[ai][bj][m][1] * rs + b1;
                        const f32x4 c = *(const f32x4*)(tabR + (size_t)row * 64 + i0), s = *(const f32x4*)(tabR + (size_t)row * 64 + 32 + i0);
                        const float ks = __builtin_amdgcn_exp2f((float)(row & 63) * lg) * (isk ? 0.125f : 1.f);
                        const f32x4 r0 = (v0 * c - v1 * s) * ks, r1 = (v1 * c + v0 * s) * ks;
                        u32x4 w; w.x = pk2(r0[0], r0[1]); w.y = pk2(r0[2], r0[3]); w.z = pk2(r1[0], r1[1]); w.w = pk2(r1[2], r1[3]);
                        *(u32x4*)(O + (size_t)row * NINP + col0) = w; }
            } else {
#pragma unroll
                for (int ai = 0; ai < 2; ++ai)
#pragma unroll
                    for (int m = 0; m < 4; ++m) { const int row = row0 + ai * HALF + m * 16; const float rs = rstd[u.idx * BM + ai * HALF + m * 16 + wr * 64 + fr];
                        const f32x4 v0 = acc[ai][bj][m][0] * rs + b0, v1 = acc[ai][bj][m][1] * rs + b1;
                        u32x4 w; w.x = pk2(v0[0], v0[1]); w.y = pk2(v0[2], v0[3]); w.z = pk2(v1[0], v1[1]); w.w = pk2(v1[2], v1[3]);
                        *(u32x4*)(O + (size_t)row * NINP + col0) = w; }
            }
        }
    }
};

template <class Epi, class Sched, bool ALIGN_EPI = false, bool SP2 = false>
__device__ __forceinline__ void gemm_phase(PG8_LAS unsigned char* lds, const Gemm g, const Sched& S, const Epi& E) {
    int tid_ = threadIdx.x; asm volatile("" : "+v"(tid_));
    const int tid = tid_, wid = __builtin_amdgcn_readfirstlane(tid >> 6), lane = tid & 63, wr = wid >> 2, wc = wid & 3, fr = lane & 15, fq = lane >> 4;
    const int K = g.K, nt = K / BK, ld = g.tiled ? BK : K;
    unsigned voffA[2], voffB[2];
#pragma unroll
    for (int i = 0; i < 2; ++i) { int R, C; stage_rc(tid * 16 + i * 8192, R, C); const int Rb = Epi::PERM ? ((R & ~31) + perm32(R & 31)) : R;
        voffA[i] = (unsigned)(R * ld + C) * 2u; voffB[i] = (unsigned)(Rb * ld + C) * 2u; }
    const size_t kstep = g.tiled ? (size_t)(BM * BK * 2) : (size_t)(BK * 2);
    const size_t hstep = (size_t)HALF * ld * 2;
    const size_t tstep = g.tiled ? (size_t)nt * (BM * BK * 2) : 2 * hstep;
    const unsigned ldsw = (unsigned)wid * 1024u;
    const int aoff = lds_byte(wr * 64 + fr, fq * 8), boff = lds_byte(wc * 32 + fr, fq * 8);
#define PG8_SA(b, h) (((b) * 2 + (h)) * HTB)
#define PG8_SB(b, h) ((4 + (b) * 2 + (h)) * HTB)
#define PG8_STAGE(bufoff, gbase, voff) do { _Pragma("unroll") for (int _i = 0; _i < 2; ++_i) \
        __builtin_amdgcn_global_load_lds((const unsigned*)((const char*)(gbase) + (voff)[_i]), (PG8_LAS unsigned*)(lds + (bufoff) + ldsw + _i * 8192), 16, 0, 0); } while (0)
#define PG8_LDA(dst, b, h) do { _Pragma("unroll") for (int m = 0; m < 4; ++m) _Pragma("unroll") for (int k = 0; k < 2; ++k) dst[m][k] = *(const PG8_LAS bf16x8*)(lds + PG8_SA(b, h) + aoff + m * 2048 + k * 1024); } while (0)
#define PG8_LDB(dst, b, h) do { _Pragma("unroll") for (int n = 0; n < 2; ++n) _Pragma("unroll") for (int k = 0; k < 2; ++k) dst[n][k] = *(const PG8_LAS bf16x8*)(lds + PG8_SB(b, h) + boff + n * 2048 + k * 1024); } while (0)
#define PG8_MMA(ai, bj, At, Bt) do { __builtin_amdgcn_s_setprio(1); _Pragma("unroll") for (int m = 0; m < 4; ++m) _Pragma("unroll") for (int n = 0; n < 2; ++n) _Pragma("unroll") for (int k = 0; k < 2; ++k) \
        acc[ai][bj][m][n] = __builtin_amdgcn_mfma_f32_16x16x32_bf16(Bt[n][k], At[m][k], acc[ai][bj][m][n], 0, 0, 0); __builtin_amdgcn_s_setprio(0); } while (0)
#define PG8_WAIT_V(n) asm volatile("s_waitcnt vmcnt(" #n ")" ::: "memory")
#define PG8_WAIT_L(n) asm volatile("s_waitcnt lgkmcnt(" #n ")" ::: "memory")
#define PG8_BAR __builtin_amdgcn_s_barrier()
#define PG8_SCHED __builtin_amdgcn_sched_barrier(0)
    Unit cur, nxt; int ui = 0;
    if (!S.next(0, cur)) return;
    f32x4 acc[2][2][4][2];
#pragma unroll
    for (int a = 0; a < 2; ++a)
#pragma unroll
        for (int b = 0; b < 2; ++b)
#pragma unroll
            for (int m = 0; m < 4; ++m)
#pragma unroll
                for (int n = 0; n < 2; ++n) acc[a][b][m][n] = (f32x4){0.f, 0.f, 0.f, 0.f};
    bf16x8 At[4][2], B0[2][2], B1[2][2];
    const char* cA = (const char*)g.A + (size_t)cur.pm * tstep; const char* cB = (const char*)g.Bt + (size_t)cur.pn * tstep;
    S.a_ready(cur);
    if constexpr (SP2) {
        PG8_STAGE(PG8_SB(0, 0), cB, voffB); PG8_STAGE(PG8_SB(0, 1), cB + hstep, voffB); PG8_STAGE(PG8_SA(0, 0), cA, voffA); PG8_STAGE(PG8_SA(0, 1), cA + hstep, voffA);
        if (wr == 1) PG8_BAR;
        PG8_WAIT_V(2); PG8_BAR;
        PG8_STAGE(PG8_SB(1, 0), cB + kstep, voffB); PG8_STAGE(PG8_SA(1, 0), cA + kstep, voffA); PG8_STAGE(PG8_SB(1, 1), cB + hstep + kstep, voffB);
        PG8_WAIT_V(6); PG8_BAR;
    } else {
        PG8_STAGE(PG8_SB(0, 0), cB, voffB); PG8_STAGE(PG8_SA(0, 0), cA, voffA); PG8_STAGE(PG8_SB(0, 1), cB + hstep, voffB); PG8_STAGE(PG8_SA(0, 1), cA + hstep, voffA);
        if (wr == 1) PG8_BAR;
        PG8_WAIT_V(4); PG8_BAR;
        PG8_STAGE(PG8_SB(1, 0), cB + kstep, voffB); PG8_STAGE(PG8_SA(1, 0), cA + kstep, voffA); PG8_STAGE(PG8_SB(1, 1), cB + hstep + kstep, voffB);
        PG8_WAIT_V(6); PG8_BAR;
    }
    for (;;) {
        const bool has_next = S.next(ui + 1, nxt);
        const char* nA = has_next ? (const char*)g.A + (size_t)nxt.pm * tstep : cA; const char* nB = has_next ? (const char*)g.Bt + (size_t)nxt.pn * tstep : cB;
        for (int t = 0; t < nt; t += 2) {
            const bool last = (t == nt - 2);
            const char* a1 = cA + (size_t)(t + 1) * kstep;
            const char* a2 = last ? nA : cA + (size_t)(t + 2) * kstep; const char* b2 = last ? nB : cB + (size_t)(t + 2) * kstep;
            const char* a3 = a2 + kstep; const char* b3 = b2 + kstep;
            if (last && has_next) S.a_ready(nxt);
            if constexpr (SP2) {
            PG8_LDB(B0, 0, 0); PG8_LDB(B1, 0, 1); PG8_SCHED; PG8_LDA(At, 0, 0); PG8_STAGE(PG8_SA(1, 1), a1 + hstep, voffA);
            PG8_WAIT_V(8); PG8_WAIT_L(0); PG8_BAR; PG8_MMA(0, 0, At, B0); PG8_MMA(0, 1, At, B1); PG8_BAR; PG8_SCHED;
            PG8_LDA(At, 0, 1); PG8_STAGE(PG8_SB(0, 0), b2, voffB); PG8_STAGE(PG8_SB(0, 1), b2 + hstep, voffB); PG8_STAGE(PG8_SA(0, 0), a2, voffA);
            PG8_WAIT_V(8); PG8_WAIT_L(0); PG8_BAR; PG8_MMA(1, 0, At, B0); PG8_MMA(1, 1, At, B1); PG8_BAR; PG8_SCHED;
            PG8_LDB(B0, 1, 0); PG8_LDB(B1, 1, 1); PG8_SCHED; PG8_LDA(At, 1, 0); PG8_STAGE(PG8_SA(0, 1), a2 + hstep, voffA);
            PG8_WAIT_V(8); PG8_WAIT_L(0); PG8_BAR; PG8_MMA(0, 0, At, B0); PG8_MMA(0, 1, At, B1); PG8_BAR; PG8_SCHED;
            PG8_LDA(At, 1, 1); PG8_STAGE(PG8_SB(1, 0), b3, voffB); PG8_STAGE(PG8_SB(1, 1), b3 + hstep, voffB); PG8_STAGE(PG8_SA(1, 0), a3, voffA);
            PG8_WAIT_V(8); PG8_WAIT_L(0); PG8_BAR; PG8_MMA(1, 0, At, B0); PG8_MMA(1, 1, At, B1); PG8_BAR; PG8_SCHED;
            } else {
            PG8_LDB(B0, 0, 0); PG8_SCHED; PG8_LDA(At, 0, 0); PG8_STAGE(PG8_SA(1, 1), a1 + hstep, voffA);
            PG8_WAIT_L(8); PG8_BAR; PG8_WAIT_L(0); PG8_MMA(0, 0, At, B0); PG8_BAR; PG8_SCHED;
            PG8_LDB(B1, 0, 1); PG8_STAGE(PG8_SB(0, 0), b2, voffB);
            PG8_BAR; PG8_WAIT_L(0); PG8_MMA(0, 1, At, B1); PG8_BAR;
            PG8_LDA(At, 0, 1); PG8_STAGE(PG8_SA(0, 0), a2, voffA);
            PG8_BAR; PG8_WAIT_L(0); PG8_MMA(1, 0, At, B0); PG8_BAR; PG8_SCHED;
            PG8_STAGE(PG8_SB(0, 1), b2 + hstep, voffB);
            PG8_WAIT_V(6); PG8_BAR; PG8_MMA(1, 1, At, B1); PG8_BAR;
            PG8_LDB(B0, 1, 0); PG8_SCHED; PG8_LDA(At, 1, 0); PG8_STAGE(PG8_SA(0, 1), a2 + hstep, voffA);
            PG8_WAIT_L(8); PG8_BAR; PG8_WAIT_L(0); PG8_MMA(0, 0, At, B0); PG8_BAR; PG8_SCHED;
            PG8_LDB(B1, 1, 1); PG8_STAGE(PG8_SB(1, 0), b3, voffB);
            PG8_BAR; PG8_WAIT_L(0); PG8_MMA(0, 1, At, B1); PG8_BAR;
            PG8_LDA(At, 1, 1); PG8_STAGE(PG8_SA(1, 0), a3, voffA);
            PG8_BAR; PG8_WAIT_L(0); PG8_MMA(1, 0, At, B0); PG8_BAR; PG8_SCHED;
            PG8_STAGE(PG8_SB(1, 1), b3 + hstep, voffB);
            PG8_WAIT_V(6); PG8_BAR; PG8_MMA(1, 1, At, B1); PG8_BAR;
            }
        }
        if constexpr (ALIGN_EPI) { if (wr == 0) PG8_BAR; }
        if constexpr (!Epi::AFTER_DRAIN) { E(acc, cur, wr, wc, fr, fq);
#if PROBE_EPI2
            if constexpr (Epi::PERM) { asm volatile("" ::: "memory"); E(acc, cur, wr, wc, fr, fq); }
#elif PROBE_EPIR2
            if constexpr (!Epi::PERM) { asm volatile("s_waitcnt vmcnt(0)" ::: "memory"); Epi E2 = E; E2.coef = 0.f; E2(acc, cur, wr, wc, fr, fq); }
#endif
            S.done(cur); }
        if (!has_next) break;
#pragma unroll
        for (int a = 0; a < 2; ++a)
#pragma unroll
            for (int b = 0; b < 2; ++b)
#pragma unroll
                for (int m = 0; m < 4; ++m)
#pragma unroll
                    for (int n = 0; n < 2; ++n) acc[a][b][m][n] = (f32x4){0.f, 0.f, 0.f, 0.f};
        cur = nxt; cA = nA; cB = nB; ++ui;
        if constexpr (ALIGN_EPI) { if (wr == 1) PG8_BAR; }
    }
    PG8_WAIT_V(0);
    if constexpr (!ALIGN_EPI) { if (wr == 0) PG8_BAR; }
    PG8_BAR;
#undef PG8_SA
#undef PG8_SB
#undef PG8_STAGE
#undef PG8_LDA
#undef PG8_LDB
#undef PG8_MMA
#undef PG8_WAIT_V
#undef PG8_WAIT_L
#undef PG8_BAR
#undef PG8_SCHED
}
}

#define XB_TMO      128
#define XB_XCNT(j)  (256  + 64 * (j))
#define XB_XSUB(j)  (1280 + 64 * (j))
#define XB_XGEN(j)  (2304 + 64 * (j))
#define XB_TOP      3328
#define XB_TOPGEN   3392
#define XCD_BAR_WORDS 3456
#define XB_SPIN_CAP (1u << 18)
__device__ __forceinline__ unsigned xb_ld(unsigned* p)              { return __hip_atomic_load(p, __ATOMIC_RELAXED, __HIP_MEMORY_SCOPE_AGENT); }
__device__ __forceinline__ unsigned xb_add(unsigned* p, unsigned v) { return __hip_atomic_fetch_add(p, v, __ATOMIC_RELAXED, __HIP_MEMORY_SCOPE_AGENT); }
__device__ __forceinline__ unsigned xb_xcc_id() { return (unsigned)__builtin_amdgcn_s_getreg((3 << 11) | 20) & 0xFu; }
#define XB_SPIN(cond, bar) do { unsigned _sp = 0; while (cond) { __builtin_amdgcn_s_sleep(1); \
    if ((++_sp & 255u) == 0u) { if (xb_ld(&(bar)[XB_TMO])) break; if (_sp > XB_SPIN_CAP) { atomicAdd(&(bar)[XB_TMO], 1u); break; } } } } while (0)
struct XcdBarrier { unsigned* bar; unsigned x; volatile LAS unsigned* st; };
__device__ __forceinline__ XcdBarrier xcd_barrier_post(unsigned* bar, volatile LAS unsigned* st) {
    XcdBarrier b; b.bar = bar; b.x = xb_xcc_id(); b.st = st;
    if (threadIdx.x == 0) (void)xb_add(&bar[XB_XCNT(b.x)], 1u);
    return b;
}
__device__ __forceinline__ void xcd_barrier_complete(unsigned* bar, unsigned x, unsigned& nloc, unsigned& nx) {
    const unsigned G = gridDim.x * gridDim.y * gridDim.z;
    unsigned sum, cnt, mine, sp = 0u;
    for (;;) {
        sum = 0u; cnt = 0u; mine = 0u;
#pragma unroll
        for (unsigned j = 0; j < 16; ++j) { const unsigned c = xb_ld(&bar[XB_XCNT(j)]); sum += c; cnt += (c > 0u) ? 1u : 0u; mine = (j == x) ? c : mine; }
        if (sum == G) break;
        __builtin_amdgcn_s_sleep(1);
        if ((++sp & 255u) == 0u) { if (xb_ld(&bar[XB_TMO])) break; if (sp > XB_SPIN_CAP) { atomicAdd(&bar[XB_TMO], 1u); break; } }
    }
    nloc = mine > 0u ? mine : 1u; nx = cnt > 0u ? cnt : 1u;
}
__device__ __forceinline__ void xcd_barrier(const XcdBarrier& b) {
    asm volatile("s_waitcnt vmcnt(0)" ::: "memory");
    __syncthreads();
    if (threadIdx.x == 0) {
        unsigned* bar = b.bar; asm volatile("" : "+s"(bar));
        __builtin_amdgcn_s_waitcnt(0);
        unsigned nloc = b.st[0], nx = b.st[1];
        if (nloc == 0u) { xcd_barrier_complete(bar, b.x, nloc, nx); b.st[0] = nloc; b.st[1] = nx; }
        const unsigned old = xb_add(&bar[XB_XSUB(b.x)], 1u);
        const unsigned gen = old / nloc;
        if (old + 1u == (gen + 1u) * nloc) {
            __builtin_amdgcn_fence(__ATOMIC_RELEASE, "agent");
            asm volatile("s_waitcnt vmcnt(0)" ::: "memory");
            const unsigned og = xb_add(&bar[XB_TOP], 1u);
            const unsigned tg = og / nx;
            if (og + 1u == (tg + 1u) * nx) xb_add(&bar[XB_TOPGEN], 1u);
            else XB_SPIN(xb_ld(&bar[XB_TOPGEN]) == tg, bar);
            __builtin_amdgcn_fence(__ATOMIC_ACQUIRE, "agent");
            xb_add(&bar[XB_XGEN(b.x)], 1u);
            asm volatile("s_waitcnt vmcnt(0)" ::: "memory");
        } else {
            XB_SPIN(xb_ld(&bar[XB_XGEN(b.x)]) == gen, bar);
            __builtin_amdgcn_fence(__ATOMIC_ACQUIRE, "agent");
            asm volatile("s_waitcnt vmcnt(0)" ::: "memory");
        }
    }
    __syncthreads();
}

namespace mix {
typedef float f32x16 __attribute__((ext_vector_type(16)));
typedef short s16x4 __attribute__((ext_vector_type(4)));
typedef short v4i16_t __attribute__((ext_vector_type(4)));
typedef LAS const char* lds_cptr;
constexpr int SLOTB = 8192, LDS_K = 0, LDS_V = 2 * SLOTB, LDS_QW = 4 * SLOTB, LDS_QF = 4 * SLOTB + 1024;
constexpr int N_DIFF = 24 * 16, N_RET = 16, N_ITEMS = N_DIFF + N_RET;
__device__ __forceinline__ int crow(int r, int hi) { return (r & 3) + 8 * (r >> 2) + 4 * hi; }
__device__ __forceinline__ int imax(int a, int b) { return a > b ? a : b; }
__device__ __forceinline__ void glds16(const void* g, unsigned lds_base) { unsigned sv; asm volatile("s_mov_b32 %0, m0\n\ts_mov_b32 m0, %2\n\ts_nop 0\n\tglobal_load_lds_dwordx4 %1, off\n\ts_mov_b32 m0, %0" : "=&s"(sv) : "v"(g), "s"(lds_base) : "memory"); }
__device__ __forceinline__ s16x4 vtr(lds_cptr p) { return __builtin_bit_cast(s16x4, __builtin_amdgcn_ds_read_tr16_b64_v4i16((LAS v4i16_t*)p)); }
#define MFMA32(a, b, c) __builtin_amdgcn_mfma_f32_32x32x16_bf16(a, b, c, 0, 0, 0)
#define MFMA16(a, b, c) __builtin_amdgcn_mfma_f32_16x16x32_bf16(a, b, c, 0, 0, 0)

struct ItemTab { unsigned short v[N_ITEMS]; };
constexpr ItemTab make_items() {
    ItemTab t{}; int n = 0;
    for (int bh = 0; bh < 16; ++bh) t.v[n++] = (unsigned short)(0x8000 | bh);
    for (int qb = 15; qb >= 0; --qb) for (int bh = 0; bh < 24; ++bh) t.v[n++] = (unsigned short)((qb << 8) | bh);
    return t;
}
__device__ const ItemTab g_items = make_items();

template <int MODE>
__device__ __forceinline__ void attn_unit(int b, int h, int qb, const bf16_t* PROJ, bf16_t* Y, LAS unsigned char* lds, float lam, float lam_init, const float* subg) {
    int tid_ = threadIdx.x; asm volatile("" : "+v"(tid_));
    const int tid = tid_, lane = tid & 63, r32 = lane & 31, hi = lane >> 5; const int wid = __builtin_amdgcn_readfirstlane(tid >> 6);
    constexpr int CQ = MODE == 0 ? C_DQ : C_TQ, CK = MODE == 0 ? C_DK : C_TK, CV = MODE == 0 ? C_DV : C_TV;
    const size_t rowbase = (size_t)b * T; const int q0 = qb * 256, NT = 4 * (qb + 1), my_last = 4 * qb + (wid >> 1);
    const bf16_t* Qw = PROJ + (rowbase + q0 + wid * 32) * NINP + CQ + 64 * h;
    const bf16_t* ksrc = PROJ + (rowbase + lane) * NINP + CK + 64 * h + wid * 8;
    const bf16_t* vsrc = PROJ + (rowbase + 16 * (wid & 3) + (lane >> 2)) * NINP + CV + 64 * h + (wid >> 2) * 32 + (lane & 3) * 8;
    const unsigned lds0 = (unsigned)(uintptr_t)lds;
    const unsigned kdst = lds0 + LDS_K + wid * 1024, vdst = lds0 + LDS_V + wid * 1024;
    const lds_cptr kp0 = (lds_cptr)lds + LDS_K + hi * 1024 + r32 * 16;
    const lds_cptr vp0 = (lds_cptr)lds + LDS_V + ((lane >> 4) & 1) * 32 + (lane & 3) * 8 + (4 * hi + ((lane & 15) >> 2)) * 64;
#define DMA_K(t, slot) glds16(ksrc + (size_t)(t) * 64 * NINP, (unsigned)__builtin_amdgcn_readfirstlane(kdst + (slot)))
#define DMA_V(t, slot) glds16(vsrc + (size_t)(t) * 64 * NINP, (unsigned)__builtin_amdgcn_readfirstlane(vdst + (slot)))
    DMA_K(0, 0); DMA_V(0, 0);
#pragma unroll
    for (int p = 0; p < 4; ++p) glds16(Qw + (size_t)(lane & 31) * NINP + (2 * p + (lane >> 5)) * 8, (unsigned)__builtin_amdgcn_readfirstlane(lds0 + LDS_QF + wid * 4096 + p * 1024));
    const lds_cptr qp0 = (lds_cptr)lds + LDS_QF + wid * 4096 + hi * 512 + r32 * 16;
    f32x16 oA[2], oB[2];
    oA[0] = f32x16{}; oA[1] = f32x16{}; oB[0] = f32x16{}; oB[1] = f32x16{};
    float mref = 0.f, lA = 0.f, lB = 0.f; f32x16 nm = f32x16{};
    const int qabs = q0 + wid * 32 + r32;
    const float lg2 = lg2gamma(h);
    for (int t = 0; t < NT; ++t) {
        asm volatile("s_waitcnt vmcnt(0) lgkmcnt(0)\n\ts_barrier" ::: "memory");
        const int sl = (t & 1) * SLOTB;
        if (t + 1 < NT) { DMA_K(t + 1, SLOTB - sl); DMA_V(t + 1, SLOTB - sl); }
        if (t <= my_last) {
            bf16x8 kf[8], vf[8], qr[4];
#pragma unroll
            for (int d0 = 0; d0 < 4; ++d0) { qr[d0] = *(const LAS bf16x8*)(qp0 + d0 * 1024); kf[2 * d0] = *(const LAS bf16x8*)(kp0 + sl + d0 * 2048); kf[2 * d0 + 1] = *(const LAS bf16x8*)(kp0 + sl + d0 * 2048 + 512); }
#define LOAD_VF() do { _Pragma("unroll") for (int i = 0; i < 8; ++i) { const s16x4 lo = vtr(vp0 + sl + (i >> 2) * 4096 + (i & 3) * 1024), hh = vtr(vp0 + sl + (i >> 2) * 4096 + (i & 3) * 1024 + 512); \
                vf[i] = (bf16x8){lo[0], lo[1], lo[2], lo[3], hh[0], hh[1], hh[2], hh[3]}; } } while (0)
            const bool diag = (t == my_last);
            const int kv0 = 64 * t + 4 * hi;
            const f32x16 z16 = f32x16{};
            if constexpr (MODE == 0) {
                f32x16 paA = MFMA32(kf[0], qr[0], nm); paA = MFMA32(kf[2], qr[1], paA);
                f32x16 pbA = MFMA32(kf[1], qr[0], nm); pbA = MFMA32(kf[3], qr[1], pbA);
                f32x16 paB = MFMA32(kf[4], qr[2], nm); paB = MFMA32(kf[6], qr[3], paB);
                f32x16 pbB = MFMA32(kf[5], qr[2], nm); pbB = MFMA32(kf[7], qr[3], pbB);
                if ((t & 7) == 0) {
                int ti = imax(imax(__float_as_int(paA[0]), __float_as_int(pbA[0])), imax(__float_as_int(paB[0]), __float_as_int(pbB[0])));
#pragma unroll
                for (int r = 1; r < 16; ++r) ti = imax(imax(ti, imax(__float_as_int(paA[r]), __float_as_int(pbA[r]))), imax(__float_as_int(paB[r]), __float_as_int(pbB[r])));
                ti = imax_x32(ti);
                if (t == 0 || __any(ti > 0x41000000)) {
                    const float tmf = __int_as_float(ti); const float dl = (t == 0) ? tmf : fmaxf(tmf, 0.f); mref += dl;
#pragma unroll
                    for (int r = 0; r < 16; ++r) { paA[r] -= dl; pbA[r] -= dl; paB[r] -= dl; pbB[r] -= dl; nm[r] = -mref; }
                    if (t > 0) { const float f = __builtin_amdgcn_exp2f(-dl); lA *= f; lB *= f; oA[0] = oA[0] * f; oA[1] = oA[1] * f; oB[0] = oB[0] * f; oB[1] = oB[1] * f; } }
                }
                if (diag) {
#pragma unroll
                    for (int r = 0; r < 16; ++r) { const int kv = kv0 + (r & 3) + 8 * (r >> 2); if (kv > qabs) { paA[r] = -1e30f; paB[r] = -1e30f; } if (kv + 32 > qabs) { pbA[r] = -1e30f; pbB[r] = -1e30f; } } }
#define EXP_PACK(pa, pb, L_, pf) do { \
                float rs0 = 0.f, rs1 = 0.f; \
                _Pragma("unroll") for (int r = 0; r < 16; ++r) { pa[r] = __builtin_amdgcn_exp2f(pa[r]); pb[r] = __builtin_amdgcn_exp2f(pb[r]); rs0 += pa[r]; rs1 += pb[r]; } \
                L_ += rs0 + rs1; \
                PROBE_EXTRA_EXP(pa, pb); \
                _Pragma("unroll") for (int s = 0; s < 2; ++s) { \
                    u32x4 w0, w1; \
                    w0.x = pk2(pa[8 * s + 0], pa[8 * s + 1]); w0.y = pk2(pa[8 * s + 2], pa[8 * s + 3]); w0.z = pk2(pa[8 * s + 4], pa[8 * s + 5]); w0.w = pk2(pa[8 * s + 6], pa[8 * s + 7]); \
                    w1.x = pk2(pb[8 * s + 0], pb[8 * s + 1]); w1.y = pk2(pb[8 * s + 2], pb[8 * s + 3]); w1.z = pk2(pb[8 * s + 4], pb[8 * s + 5]); w1.w = pk2(pb[8 * s + 6], pb[8 * s + 7]); \
                    pf[s] = __builtin_bit_cast(bf16x8, w0); pf[2 + s] = __builtin_bit_cast(bf16x8, w1); } } while (0)
#define PV_ACC(O, pf) do { _Pragma("unroll") for (int dh = 0; dh < 2; ++dh) _Pragma("unroll") for (int s = 0; s < 4; ++s) O[dh] = MFMA32(vf[4 * dh + s], pf[s], O[dh]); } while (0)
                __builtin_amdgcn_sched_barrier(0);
                LOAD_VF();
                bf16x8 pfA[4], pfB[4];
                EXP_PACK(paA, pbA, lA, pfA);
                __builtin_amdgcn_sched_barrier(0);
                PV_ACC(oA, pfA);
                EXP_PACK(paB, pbB, lB, pfB);
#pragma unroll
                for (int i = 0; i < 8; ++i) { __builtin_amdgcn_sched_group_barrier(0x008, 1, 0); __builtin_amdgcn_sched_group_barrier(0x402, 10, 0); }
                __builtin_amdgcn_sched_barrier(0);
                PV_ACC(oB, pfB);
#undef EXP_PACK
#undef PV_ACC
            } else {
                f32x16 pa = MFMA32(kf[0], qr[0], z16), pb = MFMA32(kf[1], qr[0], z16);
#pragma unroll
                for (int d0 = 1; d0 < 4; ++d0) { pa = MFMA32(kf[2 * d0], qr[d0], pa); pb = MFMA32(kf[2 * d0 + 1], qr[d0], pb); }
                const int qt = (q0 + wid * 32) >> 6;
                const float tf = __builtin_amdgcn_exp2f(64.0f * (float)(qt - t) * lg2);
#pragma unroll
                for (int r = 0; r < 16; ++r) { pa[r] *= tf; pb[r] *= tf; }
                if (diag) {
#pragma unroll
                    for (int r = 0; r < 16; ++r) { const int kv = kv0 + (r & 3) + 8 * (r >> 2); if (kv > qabs) pa[r] = 0.f; if (kv + 32 > qabs) pb[r] = 0.f; } }
                LOAD_VF();
                bf16x8 pf[4];
#pragma unroll
                for (int s = 0; s < 2; ++s) {
                    u32x4 w0, w1;
                    w0.x = pk2(pa[8 * s + 0], pa[8 * s + 1]); w0.y = pk2(pa[8 * s + 2], pa[8 * s + 3]); w0.z = pk2(pa[8 * s + 4], pa[8 * s + 5]); w0.w = pk2(pa[8 * s + 6], pa[8 * s + 7]);
                    w1.x = pk2(pb[8 * s + 0], pb[8 * s + 1]); w1.y = pk2(pb[8 * s + 2], pb[8 * s + 3]); w1.z = pk2(pb[8 * s + 4], pb[8 * s + 5]); w1.w = pk2(pb[8 * s + 6], pb[8 * s + 7]);
                    pf[s] = __builtin_bit_cast(bf16x8, w0); pf[2 + s] = __builtin_bit_cast(bf16x8, w1); }
#pragma unroll
                for (int dh = 0; dh < 2; ++dh)
#pragma unroll
                    for (int s = 0; s < 4; ++s) oA[dh] = MFMA32(vf[4 * dh + s], pf[s], oA[dh]);
            }
        }
    }
#undef DMA_K
#undef DMA_V
#undef LOAD_VF
    const size_t mrow = rowbase + qabs;
    if constexpr (MODE == 0) {
        lA = sum_x32(lA); lB = sum_x32(lB);
        const float rA = 1.0f / lA, rB = lam / lB;
        float ss = 0.f;
#pragma unroll
        for (int dh = 0; dh < 2; ++dh)
#pragma unroll
            for (int r = 0; r < 16; ++r) { const float v = oA[dh][r] * rA - oB[dh][r] * rB; oA[dh][r] = v; ss += v * v; }
        ss = sum_x32(ss);
        float li_ = lam_init; asm volatile("" : "+v"(li_));
        const float rn = (1.0f / sqrtf(ss * (1.f / 64.f) + EPS)) * (1.0f - li_);
#pragma unroll
        for (int dh = 0; dh < 2; ++dh)
#pragma unroll
            for (int g = 0; g < 4; ++g) { const int d = 32 * dh + 8 * g + 4 * hi; const f32x4 sg = *(const f32x4*)(subg + d);
                u32x2 w; w.x = pk2(oA[dh][4 * g] * rn * sg[0], oA[dh][4 * g + 1] * rn * sg[1]); w.y = pk2(oA[dh][4 * g + 2] * rn * sg[2], oA[dh][4 * g + 3] * rn * sg[3]);
                *(u32x2*)(Y + mrow * D + RW + 64 * h + d) = w; }
    } else {
        float ss = 0.f;
#pragma unroll
        for (int dh = 0; dh < 2; ++dh)
#pragma unroll
            for (int r = 0; r < 16; ++r) ss += oA[dh][r] * oA[dh][r];
        ss = sum_x32(ss);
        const float rn = 1.0f / sqrtf(ss * (1.f / 64.f) + EPS);
#pragma unroll
        for (int dh = 0; dh < 2; ++dh)
#pragma unroll
            for (int g = 0; g < 4; ++g) { const int d = 32 * dh + 8 * g + 4 * hi; const u32x2 tg = *(const u32x2*)(PROJ + mrow * NINP + C_TG + 64 * h + d);
                u32x2 w; w.x = pk2(siluf_(bflo(tg.x)) * oA[dh][4 * g] * rn, siluf_(bfhi(tg.x)) * oA[dh][4 * g + 1] * rn); w.y = pk2(siluf_(bflo(tg.y)) * oA[dh][4 * g + 2] * rn, siluf_(bfhi(tg.y)) * oA[dh][4 * g + 3] * rn);
                *(u32x2*)(Y + mrow * D + 768 + 64 * h + d) = w; }
    }
}

namespace rseq { constexpr int SLOT = 40960, KB_ = 0, KT_ = 8192, VT_ = 16384, QB_ = 24576, TG_ = 32768, RS_ = 139264, RSB = 8192; }
__device__ __forceinline__ void ret_seq(int b, int h, const bf16_t* PROJ, bf16_t* Y, LAS unsigned char* lds) {
    using namespace rseq;
    int tid_ = threadIdx.x; asm volatile("" : "+v"(tid_));
    const int tid = tid_, lane = tid & 63, r32 = lane & 31, hi = lane >> 5; const int wid = __builtin_amdgcn_readfirstlane(tid >> 6);
    const size_t rowbase = (size_t)b * T;
    const unsigned lds0 = (unsigned)(uintptr_t)lds;
    const bf16_t* kb_src = PROJ + (rowbase + lane) * NINP + C_TK + 64 * h + wid * 8;
    const bf16_t* qb_src = PROJ + (rowbase + lane) * NINP + C_TQ + 64 * h + wid * 8;
    const size_t tr_off = (size_t)(16 * (wid & 3) + (lane >> 2)) * NINP + (wid >> 2) * 32 + (lane & 3) * 8;
    const bf16_t* kt_src = PROJ + rowbase * NINP + C_TK + 64 * h + tr_off;
    const bf16_t* vt_src = PROJ + rowbase * NINP + C_TV + 64 * h + tr_off;
    const bf16_t* tg_src = PROJ + (rowbase + 8 * wid + (lane >> 3)) * NINP + C_TG + 64 * h + (lane & 7) * 8;
#define RS_DMA(blk, slot_) do { const size_t go_ = (size_t)(blk) * 64 * NINP; const unsigned d_ = lds0 + (slot_) * SLOT + wid * 1024; \
        glds16(kb_src + go_, (unsigned)__builtin_amdgcn_readfirstlane(d_ + KB_)); glds16(kt_src + go_, (unsigned)__builtin_amdgcn_readfirstlane(d_ + KT_)); \
        glds16(vt_src + go_, (unsigned)__builtin_amdgcn_readfirstlane(d_ + VT_)); glds16(qb_src + go_, (unsigned)__builtin_amdgcn_readfirstlane(d_ + QB_)); \
        glds16(tg_src + go_, (unsigned)__builtin_amdgcn_readfirstlane(d_ + TG_)); } while (0)
    RS_DMA(0, 0); RS_DMA(1, 1);
    { unsigned z = 0u; asm volatile("" : "+v"(z)); for (int i = tid; i < RSB / 16; i += 512) ((LAS u32x4*)(lds + RS_))[i] = (u32x4){z, z, z, z}; }
    const int qh = wid & 1;
    const int dvh = (wid >> 1) & 1, dkh = wid & 1;
    f32x16 Rq = f32x16{};
    const float g64 = __builtin_amdgcn_exp2f(64.0f * lg2gamma(h));
    const lds_cptr trb = (lds_cptr)lds + ((lane >> 4) & 1) * 32 + (lane & 3) * 8 + (4 * hi + ((lane & 15) >> 2)) * 64;
    for (int i = 0; i < T / 64; ++i) {
        if (i + 1 < T / 64) { if (wid < 2 && i > 0) asm volatile("s_waitcnt vmcnt(13) lgkmcnt(0)\n\ts_barrier" ::: "memory"); else asm volatile("s_waitcnt vmcnt(5) lgkmcnt(0)\n\ts_barrier" ::: "memory"); }
        else asm volatile("s_waitcnt vmcnt(0) lgkmcnt(0)\n\ts_barrier" ::: "memory");
        const int sl = (i % 3) * SLOT, rb = (i & 1) * RSB;
        if (i + 2 < T / 64) RS_DMA(i + 2, (i + 2) % 3);
        if (wid < 2) {
            bf16x8 kf[8], qr[4];
#pragma unroll
            for (int d0 = 0; d0 < 4; ++d0) { qr[d0] = *(const LAS bf16x8*)((lds_cptr)lds + sl + QB_ + (2 * d0 + hi) * 1024 + (32 * qh + r32) * 16);
                kf[2 * d0] = *(const LAS bf16x8*)((lds_cptr)lds + sl + KB_ + (2 * d0 + hi) * 1024 + r32 * 16); kf[2 * d0 + 1] = *(const LAS bf16x8*)((lds_cptr)lds + sl + KB_ + (2 * d0 + hi) * 1024 + 512 + r32 * 16); }
            const f32x16 z16 = f32x16{};
            f32x16 pa = MFMA32(kf[0], qr[0], z16), pb = z16;
#pragma unroll
            for (int d0 = 1; d0 < 4; ++d0) pa = MFMA32(kf[2 * d0], qr[d0], pa);
            if (qh) {
#pragma unroll
                for (int d0 = 0; d0 < 4; ++d0) pb = MFMA32(kf[2 * d0 + 1], qr[d0], pb); }
#pragma unroll
            for (int r = 0; r < 16; ++r) { const int kv = (r & 3) + 8 * (r >> 2) + 4 * hi;
                if (qh == 0) { if (kv > r32) pa[r] = 0.f; }
                else { if (kv > r32) pb[r] = 0.f; } }
            bf16x8 pf[4];
#pragma unroll
            for (int s = 0; s < 2; ++s) { u32x4 w0, w1;
                w0.x = pk2(pa[8 * s + 0], pa[8 * s + 1]); w0.y = pk2(pa[8 * s + 2], pa[8 * s + 3]); w0.z = pk2(pa[8 * s + 4], pa[8 * s + 5]); w0.w = pk2(pa[8 * s + 6], pa[8 * s + 7]);
                w1.x = pk2(pb[8 * s + 0], pb[8 * s + 1]); w1.y = pk2(pb[8 * s + 2], pb[8 * s + 3]); w1.z = pk2(pb[8 * s + 4], pb[8 * s + 5]); w1.w = pk2(pb[8 * s + 6], pb[8 * s + 7]);
                pf[s] = __builtin_bit_cast(bf16x8, w0); pf[2 + s] = __builtin_bit_cast(bf16x8, w1); }
            f32x16 o[2]; o[0] = z16; o[1] = z16;
#pragma unroll
            for (int dh = 0; dh < 2; ++dh)
#pragma unroll
                for (int s = 0; s < 4; ++s) {
                    if (s < 2 || qh) { const s16x4 lo = vtr(trb + sl + VT_ + dh * 4096 + s * 1024), hh = vtr(trb + sl + VT_ + dh * 4096 + s * 1024 + 512);
                        o[dh] = MFMA32(((bf16x8){lo[0], lo[1], lo[2], lo[3], hh[0], hh[1], hh[2], hh[3]}), pf[s], o[dh]); }
                    const bf16x8 rf = *(const LAS bf16x8*)((lds_cptr)lds + RS_ + rb + (2 * s + hi) * 1024 + (32 * dh + r32) * 16);
                    o[dh] = MFMA32(rf, qr[s], o[dh]); }
            const size_t mrow = rowbase + (size_t)i * 64 + 32 * qh + r32;
            float ss = 0.f;
#pragma unroll
            for (int dh = 0; dh < 2; ++dh)
#pragma unroll
                for (int r = 0; r < 16; ++r) ss += o[dh][r] * o[dh][r];
            ss = sum_x32(ss);
            const float rn = 1.0f / sqrtf(ss * (1.f / 64.f) + EPS);
#pragma unroll
            for (int dh = 0; dh < 2; ++dh)
#pragma unroll
                for (int g = 0; g < 4; ++g) { const int d = 32 * dh + 8 * g + 4 * hi; const u32x2 tg = *(const LAS u32x2*)((lds_cptr)lds + sl + TG_ + (32 * qh + r32) * 128 + d * 2);
                    u32x2 w; w.x = pk2(siluf_(bflo(tg.x)) * o[dh][4 * g] * rn, siluf_(bfhi(tg.x)) * o[dh][4 * g + 1] * rn); w.y = pk2(siluf_(bflo(tg.y)) * o[dh][4 * g + 2] * rn, siluf_(bfhi(tg.y)) * o[dh][4 * g + 3] * rn);
                    *(u32x2*)(Y + mrow * D + 768 + 64 * h + d) = w; }
        } else if (wid >= 4) {
#pragma unroll
            for (int s = 0; s < 4; ++s) {
                const s16x4 vl = vtr(trb + sl + VT_ + dvh * 4096 + s * 1024), vh = vtr(trb + sl + VT_ + dvh * 4096 + s * 1024 + 512);
                const s16x4 kl = vtr(trb + sl + KT_ + dkh * 4096 + s * 1024), kh = vtr(trb + sl + KT_ + dkh * 4096 + s * 1024 + 512);
                Rq = MFMA32(((bf16x8){vl[0], vl[1], vl[2], vl[3], vh[0], vh[1], vh[2], vh[3]}), ((bf16x8){kl[0], kl[1], kl[2], kl[3], kh[0], kh[1], kh[2], kh[3]}), Rq); }
            Rq = Rq * g64;
            LAS bf16_t* rs = (LAS bf16_t*)(lds + RS_ + (RSB - rb));
            const int dk = 32 * dkh + r32;
#pragma unroll
            for (int r = 0; r < 16; ++r) { const int dv = 32 * dvh + (r & 3) + 8 * (r >> 2) + 4 * hi; rs[(dk >> 3) * 512 + dv * 8 + (dk & 7)] = (bf16_t)(pk2(Rq[r], 0.f) & 0xffffu); }
        }
    }
    asm volatile("s_waitcnt lgkmcnt(0)\n\ts_barrier" ::: "memory");
#undef RS_DMA
}

__device__ __forceinline__ float em1(float x) {
    if (x > -0.25f) { float p = 1.f / 720.f; p = p * x + 1.f / 120.f; p = p * x + 1.f / 24.f; p = p * x + 1.f / 6.f; p = p * x + 0.5f; p = p * x + 1.f; return p * x; }
    return expm1f(x);
}
template <int DD> __device__ __forceinline__ float dpp_shr(float v) { return __int_as_float(__builtin_amdgcn_update_dpp(__float_as_int(v), __float_as_int(v), 0x110 + DD, 0xF, 0xF, false)); }
template <int DD> __device__ __forceinline__ f32x4 shup4(f32x4 v) { f32x4 r; r[0] = dpp_shr<DD>(v[0]); r[1] = dpp_shr<DD>(v[1]); r[2] = dpp_shr<DD>(v[2]); r[3] = dpp_shr<DD>(v[3]); return r; }
__device__ __forceinline__ float bc15f(float v) { return __int_as_float(__builtin_amdgcn_ds_swizzle(__float_as_int(v), (0x0F << 5) | 0x10)); }
__device__ __forceinline__ f32x4 bc15(f32x4 v) { f32x4 r; r[0] = bc15f(v[0]); r[1] = bc15f(v[1]); r[2] = bc15f(v[2]); r[3] = bc15f(v[3]); return r; }
template <int PASS>
__device__ __forceinline__ void rglru_item(int wi, const bf16_t* PROJ, const bf16_t* GWl, const float* SP8l, const float* cw, const float* cb, const float* ba, const float* bx, float* AGGA, float* AGGB, bf16_t* Y, int lane_in) {
    int lane = lane_in; asm volatile("" : "+v"(lane));
    const int fr = lane & 15, fq = lane >> 4;
    const int h = wi % 6, chunk = (wi / 6) & 63, b = wi / 384;
    const long m0 = (long)b * T + chunk * 64;
    const int chb = 64 * h + 4 * fq;
    bf16x8 wf[2][4][2];
#pragma unroll
    for (int g = 0; g < 2; ++g)
#pragma unroll
        for (int nbo = 0; nbo < 4; ++nbo)
#pragma unroll
            for (int ks = 0; ks < 2; ++ks) { const bf16_t* p = GWl + (((size_t)g * 6 + h) * 64 + 16 * nbo + fr) * 64 + 32 * ks + 4 * fq; const u32x2 lo = *(const u32x2*)p, hi2 = *(const u32x2*)(p + 16);
                wf[g][nbo][ks] = __builtin_bit_cast(bf16x8, (u32x4){lo.x, lo.y, hi2.x, hi2.y}); }
    f32x4 bav[4], bxv[4], spv[4], hc[4], At[4];
#pragma unroll
    for (int nb = 0; nb < 4; ++nb) { bav[nb] = *(const f32x4*)(ba + chb + 16 * nb); bxv[nb] = *(const f32x4*)(bx + chb + 16 * nb); spv[nb] = *(const f32x4*)(SP8l + chb + 16 * nb);
        hc[nb] = (f32x4){0.f, 0.f, 0.f, 0.f}; At[nb] = (f32x4){1.f, 1.f, 1.f, 1.f}; }
#define KS_STEP(DD, A_, B_) do { const f32x4 As = shup4<DD>(A_), Bs = shup4<DD>(B_); if (fr >= DD) { B_ = A_ * Bs + B_; A_ = A_ * As; } } while (0)
    if constexpr (PASS == 2) {
        f32x4 FA[4], FB[4];
#pragma unroll
        for (int nb = 0; nb < 4; ++nb) { FA[nb] = (f32x4){1.f, 1.f, 1.f, 1.f}; FB[nb] = (f32x4){0.f, 0.f, 0.f, 0.f}; }
#pragma unroll
        for (int k = 0; k < 4; ++k) { const int ci = 4 * fr + k;
            if (ci < chunk) {
#pragma unroll
                for (int nb = 0; nb < 4; ++nb) { const size_t o = ((size_t)(b * 64 + ci)) * RW + chb + 16 * nb; const f32x4 a = *(const f32x4*)(AGGA + o), bb = *(const f32x4*)(AGGB + o);
                    FB[nb] = a * FB[nb] + bb; FA[nb] = a * FA[nb]; } } }
#pragma unroll
        for (int nb = 0; nb < 4; ++nb) { KS_STEP(1, FA[nb], FB[nb]); KS_STEP(2, FA[nb], FB[nb]); KS_STEP(4, FA[nb], FB[nb]); KS_STEP(8, FA[nb], FB[nb]); }
#pragma unroll
        for (int nb = 0; nb < 4; ++nb) hc[nb] = bc15(FB[nb]);
    }
#pragma unroll 1
    for (int mb = 0; mb < 4; ++mb) {
        const int tl = 16 * mb + fr;
        f32x4 xc[4];
#pragma unroll
        for (int nb = 0; nb < 4; ++nb) { f32x4 acc = *(const f32x4*)(cb + chb + 16 * nb);
#pragma unroll
            for (int j = 0; j < 4; ++j) { const int tj = tl - 3 + j;
                if (chunk > 0 || tj >= 0) { const u32x2 w = *(const u32x2*)(PROJ + (size_t)(m0 + tj) * NINP + C_RX + chb + 16 * nb); const f32x4 cwv = *(const f32x4*)(cw + j * RW + chb + 16 * nb);
                    acc += cwv * (f32x4){bflo(w.x), bfhi(w.x), bflo(w.y), bfhi(w.y)}; } }
            xc[nb] = acc; }
        bf16x8 bfr[2];
#pragma unroll
        for (int ks = 0; ks < 2; ++ks) { u32x4 w; w.x = pk2(xc[2 * ks][0], xc[2 * ks][1]); w.y = pk2(xc[2 * ks][2], xc[2 * ks][3]); w.z = pk2(xc[2 * ks + 1][0], xc[2 * ks + 1][1]); w.w = pk2(xc[2 * ks + 1][2], xc[2 * ks + 1][3]);
            bfr[ks] = __builtin_bit_cast(bf16x8, w); }
#pragma unroll
        for (int nb = 0; nb < 4; ++nb) {
            f32x4 ra = bav[nb], ia = bxv[nb];
#pragma unroll
            for (int ks = 0; ks < 2; ++ks) { ra = MFMA16(wf[0][nb][ks], bfr[ks], ra); ia = MFMA16(wf[1][nb][ks], bfr[ks], ia); }
            f32x4 A, B;
#pragma unroll
            for (int r = 0; r < 4; ++r) { const float rg = sigmoidf_(ra[r]), ig = sigmoidf_(ia[r]); const float la = spv[nb][r] * rg;
                A[r] = 1.0f + em1(la); B[r] = sqrtf(-em1(2.0f * la)) * ig * xc[nb][r]; }
            KS_STEP(1, A, B); KS_STEP(2, A, B); KS_STEP(4, A, B); KS_STEP(8, A, B);
            const f32x4 hv = B + A * hc[nb];
            hc[nb] = bc15(hv);
            if constexpr (PASS == 1) { At[nb] = At[nb] * bc15(A); }
            else { const size_t mr = (size_t)(m0 + tl); const u32x2 gw = *(const u32x2*)(PROJ + mr * NINP + C_RG + chb + 16 * nb);
                u32x2 w; w.x = pk2(gelu_tanh(bflo(gw.x)) * hv[0], gelu_tanh(bfhi(gw.x)) * hv[1]); w.y = pk2(gelu_tanh(bflo(gw.y)) * hv[2], gelu_tanh(bfhi(gw.y)) * hv[3]);
                *(u32x2*)(Y + mr * D + chb + 16 * nb) = w; }
        }
    }
    if constexpr (PASS == 1) {
        if (fr == 15) {
#pragma unroll
            for (int nb = 0; nb < 4; ++nb) { const size_t o = ((size_t)(b * 64 + chunk)) * RW + chb + 16 * nb; *(f32x4*)(AGGA + o) = At[nb]; *(f32x4*)(AGGB + o) = hc[nb]; } }
    }
}
#undef KS_STEP
#undef MFMA32
#undef MFMA16
}

constexpr int NWAVES = 8;
struct Args { const float* in[27]; const int* pos; float* out; unsigned char* ws; float lam_init[4]; int ph_lo, ph_hi, li, pad; };
constexpr int PH_L0 = 3, NPH = 8, PH_FINAL = PH_L0 + NL * NPH, PH_END = PH_FINAL + 1;

struct Frame { LAS unsigned char* lds; int wave, vcu, G, gw, NGW; };

template <class Map>
__device__ __forceinline__ void transpose_item(const float* W, int K, int Nsrc, bf16_t* WT, int NT, LAS float* scr, int item, int lane, Map src, bool tiled = false) {
    const int nblk = NT / 32, kb = item / nblk, nb = item % nblk, k0 = 64 * kb, n0 = 32 * nb;
    const int sc = src(n0 + (lane & 31));
    float wv_[32];
#pragma unroll
    for (int i = 0; i < 32; ++i) { const int kk = 2 * i + (lane >> 5); wv_[i] = sc >= 0 ? W[(size_t)(k0 + kk) * Nsrc + sc] : 0.f; }
#pragma unroll
    for (int i = 0; i < 32; ++i) { const int kk = 2 * i + (lane >> 5); scr[kk * 33 + (lane & 31)] = wv_[i]; }
    LDS_WAIT(); asm volatile("" ::: "memory");
    const int c = lane & 7;
#pragma unroll
    for (int j = 0; j < 4; ++j) { const int n = (lane >> 3) + 8 * j; const LAS float* s = scr + (8 * c) * 33 + n;
        u32x4 o; o.x = pk2(s[0 * 33], s[1 * 33]); o.y = pk2(s[2 * 33], s[3 * 33]); o.z = pk2(s[4 * 33], s[5 * 33]); o.w = pk2(s[6 * 33], s[7 * 33]);
        const size_t off = tiled ? (((size_t)((n0 + n) >> 8) * (K / 64) + kb) * 256 + ((n0 + n) & 255)) * 64 + 8 * c : (size_t)(n0 + n) * K + k0 + 8 * c;
        *(GAS u32x4*)(WT + off) = o; }
    LDS_WAIT(); asm volatile("" ::: "memory");
}
struct MapId { __device__ __forceinline__ int operator()(int n) const { return n; } };
struct MapFfnIn { __device__ __forceinline__ int operator()(int n) const { const int pn = n >> 8, bj = (n >> 7) & 1, cc = n & 127; return bj * F + pn * 128 + cc; } };
__device__ __forceinline__ int ret_dim(int pos) { const int w = pos >> 5, rem = pos & 31, fq = rem >> 3, n = (rem >> 2) & 1, j = rem & 3; return 32 * n + 16 * w + 4 * fq + j; }
struct MapMixIn { __device__ __forceinline__ int operator()(int p) const {
    if (p < C_DK) return 768 + p;
    if (p < C_TQ) return 1152 + (p - C_DK);
    if (p < C_TK) { const int q = p - C_TQ; return 1920 + (q & ~63) + ret_dim(q & 63); }
    if (p < C_DV) { const int q = p - C_TK; return 2176 + (q & ~63) + ret_dim(q & 63); }
    if (p < C_TV) return 1536 + (p - C_DV);
    if (p < C_TG) return 2432 + (p - C_TV);
    if (p < C_RX) return 2688 + (p - C_TG);
    if (p < C_RG) return p - C_RX;
    if (p < NIN) return 384 + (p - C_RG);
    return -1; } };

constexpr int I_FI = (D / 64) * (2 * F / 32), I_FO = (F / 64) * (D / 32), I_MI = (D / 64) * (NINP / 32), I_MO = (D / 64) * (D / 32), CONV_ITEMS_L = 2 * I_FI + 2 * I_FO + I_MI + I_MO;
constexpr int CONV_WG_ITEMS = (CONV_ITEMS_L + NWAVES - 1) / NWAVES;
struct ConvSrc { const float *f1i, *f1o, *f2i, *f2o, *mi, *mo; };
__device__ __forceinline__ void conv_item(const ConvSrc cs, unsigned char* ws, int l, int r, LAS float* scr, int lane) {
    unsigned char* wl = ws + WS_W + (size_t)l * W_L;
    if (r < I_FI) { transpose_item(cs.f1i + (size_t)l * D * 2 * F, D, 2 * F, (bf16_t*)(wl + W_1IN), 2 * F, scr, r, lane, MapFfnIn()); return; } r -= I_FI;
    if (r < I_FI) { transpose_item(cs.f2i + (size_t)l * D * 2 * F, D, 2 * F, (bf16_t*)(wl + W_2IN), 2 * F, scr, r, lane, MapFfnIn()); return; } r -= I_FI;
    if (r < I_FO) { transpose_item(cs.f1o + (size_t)l * F * D, F, D, (bf16_t*)(wl + W_1OUT), D, scr, r, lane, MapId(), true); return; } r -= I_FO;
    if (r < I_FO) { transpose_item(cs.f2o + (size_t)l * F * D, F, D, (bf16_t*)(wl + W_2OUT), D, scr, r, lane, MapId(), true); return; } r -= I_FO;
    if (r < I_MI) { transpose_item(cs.mi + (size_t)l * D * NIN, D, NIN, (bf16_t*)(wl + W_IN), NINP, scr, r, lane, MapMixIn()); return; } r -= I_MI;
    transpose_item(cs.mo + (size_t)l * D * D, D, D, (bf16_t*)(wl + W_OUT), D, scr, r, lane, MapId());
}
__device__ __forceinline__ void bias_layer(unsigned char* ws, int l, int gw, int ngw, int lane) {
    const float* MOD = (const float*)(ws + WS_MOD); float* BIAS = (float*)(ws + WS_BIAS);
    for (int g = 0; g < 3; ++g) {
        const int lg = l * 3 + g; const int Nw = (g == 1) ? NINP : 2 * F;
        const bf16_t* Wt = (const bf16_t*)(ws + WS_W + (size_t)l * W_L + (g == 0 ? W_1IN : g == 1 ? W_IN : W_2IN));
        f32x4 Sv[4][4];
#pragma unroll
        for (int b = 0; b < 4; ++b)
#pragma unroll
            for (int q = 0; q < 4; ++q) Sv[b][q] = *(const f32x4*)(MOD + ((size_t)l * NB + b) * NMD + (3 * g) * D + 16 * lane + 4 * q);
        for (int n = gw; n < Nw; n += ngw) {
            const u32x4 w0 = *(const u32x4*)(Wt + (size_t)n * D + 16 * lane), w1 = *(const u32x4*)(Wt + (size_t)n * D + 16 * lane + 8);
            const f32x4 wv[4] = {{bflo(w0.x), bfhi(w0.x), bflo(w0.y), bfhi(w0.y)}, {bflo(w0.z), bfhi(w0.z), bflo(w0.w), bfhi(w0.w)}, {bflo(w1.x), bfhi(w1.x), bflo(w1.y), bfhi(w1.y)}, {bflo(w1.z), bfhi(w1.z), bflo(w1.w), bfhi(w1.w)}};
            float acc4[4];
#pragma unroll
            for (int b = 0; b < 4; ++b) { f32x4 a = Sv[b][0] * wv[0] + Sv[b][1] * wv[1] + Sv[b][2] * wv[2] + Sv[b][3] * wv[3]; acc4[b] = wave_sum((a[0] + a[1]) + (a[2] + a[3])); }
            if (lane < 4) BIAS[((size_t)lg * NB + lane) * (2 * F) + n] = lane == 0 ? acc4[0] : lane == 1 ? acc4[1] : lane == 2 ? acc4[2] : acc4[3];
        }
    }
}

__global__ void __launch_bounds__(NWAVES * 64, 2) mega(Args args) {
    Frame FR;
    FR.lds = (LAS unsigned char*)lds_raw;
    volatile LAS unsigned* MISC = (volatile LAS unsigned*)(FR.lds + MISC_OFF);
    FR.wave = __builtin_amdgcn_readfirstlane((int)threadIdx.x >> 6);
    FR.G = gridDim.x; { const int bx = blockIdx.x; FR.vcu = (FR.G % 8 == 0) ? (bx % 8) * (FR.G / 8) + bx / 8 : bx; }
    FR.gw = FR.vcu * NWAVES + FR.wave; FR.NGW = FR.G * NWAVES;
    unsigned char* ws = args.ws;
    gu32* ctl = (gu32*)(ws + WS_CTL);
    for (int u = (int)threadIdx.x; u < (LDS_BYTES - LDSCTL_OFF) / 4; u += NWAVES * 64) ((LAS unsigned*)(FR.lds + LDSCTL_OFF))[u] = 0u;
    __syncthreads();
    const int lo = args.ph_lo, hi = args.ph_hi;
    if (MK_ONE_LAUNCH || hi - lo > 1) (void)xcd_barrier_post((unsigned*)(ctl + CW_BAR) + args.li * XCD_BAR_WORDS, MISC + 8);
#define bar (XcdBarrier{(unsigned*)((gu32*)(args.ws + WS_CTL) + CW_BAR) + args.li * XCD_BAR_WORDS, xb_xcc_id(), (volatile LAS unsigned*)((LAS unsigned char*)lds_raw + MISC_OFF) + 8})
#if MK_ONE_LAUNCH
#define IN(k) true
#if PROBE_BAR2
#define SEAM(k) do { xcd_barrier(bar); xcd_barrier(bar); } while (0)
#else
#define SEAM(k) xcd_barrier(bar)
#endif
#else
#define IN(k) (lo <= (k) && (k) < hi)
#define SEAM(k) do { if (IN(k) && IN((k) + 1)) xcd_barrier(bar); } while (0)
#endif
    float* X = (float*)(ws + WS_X); bf16_t* H = (bf16_t*)(ws + WS_H); bf16_t* Y = (bf16_t*)(ws + WS_Y); bf16_t* ACT = (bf16_t*)(ws + WS_ACT); bf16_t* PROJ = (bf16_t*)(ws + WS_PROJ);
    float* MODP = (float*)(ws + WS_MODP); float* MOD = (float*)(ws + WS_MOD); float* TABD = (float*)(ws + WS_TABD); float* TABR = (float*)(ws + WS_TABR);

    float* ANORM = (float*)(ws + WS_ANORM); float* BIAS = (float*)(ws + WS_BIAS); float* SSQ = (float*)(ws + WS_SSQ); bf16_t* XS = H;
    for (int repp = 0; repp < PROBE_REPP; ++repp) {
    if (IN(0)) {
        for (int i = FR.gw * 64 + lane_id(); i < M * 36; i += FR.NGW * 64) {
            const int m = i / 36, f = i % 36; const float p = (float)args.pos[m];
            if (f < 4) { const float inv = powf(500000.0f, -0.25f * (float)f); float s, c; sincosf(p * (f == 0 ? 1.0f : inv), &s, &c); TABD[m * 8 + f] = c; TABD[m * 8 + 4 + f] = s; }
            else { const int g = f - 4; const float inv = powf(10000.0f, -(float)g * (2.0f / 64.0f)); float s, c; sincosf(p * inv, &s, &c); TABR[m * 64 + g] = c; TABR[m * 64 + 32 + g] = s; }
        }
        LAS float* sc = (LAS float*)(FR.lds + RING_OFF);
        for (int i = (int)threadIdx.x; i < NB * D; i += NWAVES * 64) sc[i] = siluf_(args.in[1][i]);
        __syncthreads();
        for (int it = FR.gw; it < NL * NKC * (NMD / 256); it += FR.NGW) {
            const int nb = it % (NMD / 256), kc = (it / (NMD / 256)) % NKC, l = it / ((NMD / 256) * NKC);
            const float* W = args.in[6] + ((size_t)l * D + kc * KC) * NMD + nb * 256 + lane_id() * 4;
            f32x4 a0 = {0, 0, 0, 0}, a1 = a0, a2 = a0, a3 = a0;
#pragma unroll 8
            for (int k = 0; k < KC; ++k) { const f32x4 w = *(const GAS f32x4*)(W + (size_t)k * NMD); const int kk = kc * KC + k;
                a0 += w * sc[kk]; a1 += w * sc[D + kk]; a2 += w * sc[2 * D + kk]; a3 += w * sc[3 * D + kk]; }
            float* P = MODP + ((size_t)(kc * NL + l) * NB) * NMD + nb * 256 + lane_id() * 4;
            *(f32x4*)(P) = a0; *(f32x4*)(P + NMD) = a1; *(f32x4*)(P + 2 * NMD) = a2; *(f32x4*)(P + 3 * NMD) = a3;
        }
        __syncthreads();
        { LAS float* scr = (LAS float*)(FR.lds + RING_OFF + FR.wave * 16384);
          for (int it = FR.gw; it < CONV_ITEMS_L; it += FR.NGW) conv_item(ConvSrc{args.in[8], args.in[9], args.in[10], args.in[11], args.in[12], args.in[13]}, ws, 0, it, scr, lane_id()); }
        __syncthreads();
    }
    SEAM(0);
    if (IN(1)) {
        for (int i = FR.gw * 64 + lane_id(); i < NL * NB * NMD; i += FR.NGW * 64) {
            const int l = i / (NB * NMD), b = (i / NMD) % NB, n = i % NMD; float s = args.in[7][l * NMD + n];
            for (int kc = 0; kc < NKC; ++kc) s += MODP[(size_t)kc * NL * NB * NMD + i];
            MOD[i] = s;
            const int part = n / D, k = n % D;
            if (part % 3 == 1) { const int j = part / 3; ANORM[(((size_t)l * 3 + j) * NB + b) * D + k] = args.in[3 + j][l * D + k] * (1.0f + s); } }
        { bf16_t* GW = (bf16_t*)(ws + WS_GW); float* SP8 = (float*)(ws + WS_SP8); float* LAMS = (float*)(ws + WS_LAMS);
          for (int i = FR.gw * 64 + lane_id(); i < NL * 2 * 6 * 64 * 64; i += FR.NGW * 64) { const int in_ = i & 63, out = (i >> 6) & 63, h = (i >> 12) % 6, g = ((i >> 12) / 6) & 1, l = (i >> 12) / 12;
              const float v = args.in[g ? 18 : 16][(((size_t)l * 6 + h) * 64 + in_) * 64 + out]; GW[i] = (bf16_t)(pk2(v, 0.f) & 0xffffu); }
          for (int i = FR.gw * 64 + lane_id(); i < NL * RW; i += FR.NGW * 64) SP8[i] = -8.0f * log1pf(expf(-args.in[20][i]));
          if (FR.gw < NL) { const int l = FR.gw; float s1 = 0.f, s2 = 0.f; if (lane_id() < 32) { s1 = args.in[21][l * 32 + lane_id()] * args.in[22][l * 32 + lane_id()]; s2 = args.in[23][l * 32 + lane_id()] * args.in[24][l * 32 + lane_id()]; }
              s1 = wave_sum(s1); s2 = wave_sum(s2); if (lane_id() == 0) LAMS[l] = expf(s1) - expf(s2) + args.lam_init[l]; } }
    }
    SEAM(1);
    if (IN(2)) {
        { const int b = FR.gw >> 9; const float* ap = ANORM + (size_t)b * D; f32x4 Av[4];
#pragma unroll
          for (int jj = 0; jj < 4; ++jj) Av[jj] = *(const f32x4*)(ap + 4 * lane_id() + 256 * jj);
          for (int rr = 0; rr < 8; ++rr) { const int m = FR.gw * 8 + rr; const GAS f32x4* xr = (const GAS f32x4*)(args.in[0] + (size_t)m * D) + lane_id(); f32x4 v[4]; float s2 = 0.f;
#pragma unroll
              for (int jj = 0; jj < 4; ++jj) { v[jj] = xr[64 * jj]; s2 += (v[jj].x * v[jj].x + v[jj].y * v[jj].y) + (v[jj].z * v[jj].z + v[jj].w * v[jj].w); }
              s2 = wave_sum(s2);
              if (lane_id() < 16) SSQ[(size_t)m * 16 + lane_id()] = lane_id() == 0 ? s2 : 0.f;
              GAS u32x2* o8 = (GAS u32x2*)(XS + (size_t)m * D) + lane_id();
#pragma unroll
              for (int jj = 0; jj < 4; ++jj) { const f32x4 h = v[jj] * Av[jj]; u32x2 w; w.x = pk2(h.x, h.y); w.y = pk2(h.z, h.w); o8[64 * jj] = w;
                  u32x2 xw; xw.x = pkh2(v[jj].x, v[jj].y); xw.y = pkh2(v[jj].z, v[jj].w); ((GAS u32x2*)((bf16_t*)(ws + WS_X) + (size_t)m * D) + lane_id())[64 * jj] = xw; } } }
        bias_layer(ws, 0, FR.gw, FR.NGW, lane_id());
        __syncthreads();
    }
    SEAM(2);

    }
    LAS float* rstd_lds = (LAS float*)(FR.lds + LDS_RSTD_OFF);
    for (int l = 0; l < NL; ++l) {
        const int pb = PH_L0 + l * NPH;
        unsigned char* wl = ws + WS_W + (size_t)l * W_L;
        const float* modl = MOD + (size_t)l * NB * NMD;
#define RSTD_TABLE(Ncols, slot) do { int tl_ = (int)threadIdx.x; asm volatile("" : "+v"(tl_)); pg8::StaticOrder S_; S_.init(M, (Ncols), FR.G, (int)blockIdx.x); const float* sq_ = SSQ + (size_t)(slot) * M * 16; \
            for (int i_ = 0; i_ < 6; ++i_) { pg8::Unit u_; if (!S_.next(i_, u_)) break; if (tl_ < 256) { const f32x4* q_ = (const f32x4*)(sq_ + ((size_t)u_.pm * 256 + tl_) * 16); \
                const f32x4 a_ = (q_[0] + q_[1]) + (q_[2] + q_[3]); rstd_lds[i_ * 256 + tl_] = 1.0f / sqrtf(((a_[0] + a_[1]) + (a_[2] + a_[3])) * (1.f / D) + EPS); } } \
            __syncthreads(); } while (0)
#define FFN_IN_PHASE(k, c, WOFF, g) do { if (IN(pb + (k))) { RSTD_TABLE(2 * F, (c) & 1); \
            pg8::Gemm g_{XS, (const bf16_t*)(wl + (WOFF)), M, 2 * F, D, 0}; pg8::StaticOrder S; S.init(M, 2 * F, FR.G, (int)blockIdx.x); pg8::EpiSwiglu E{ws, l * 3 + (g)}; \
            pg8::gemm_phase<pg8::EpiSwiglu, pg8::StaticOrder, true, MK_SP2>(FR.lds + RING_OFF, g_, S, E); } } while (0)
#define OUT_PHASE(k, c, Aop, WOFF, Kdim, gidx, coef_, jn) do { if (IN(pb + (k))) { \
            const bool last_ = (l == NL - 1) && ((jn) == 3); \
            pg8::Gemm g_{Aop, (const bf16_t*)(wl + (WOFF)), M, D, (Kdim), (Kdim) == F ? 1 : 0}; pg8::StaticOrder S; S.init(M, D, FR.G, (int)blockIdx.x); \
            pg8::EpiResid E{ws, l, (gidx), last_ ? -1 : ((jn) == 3 ? (l + 1) * 3 : l * 3 + (jn)), ((c) + 1) & 1, (coef_)}; \
            pg8::gemm_phase<pg8::EpiResid, pg8::StaticOrder, true, MK_SP2>(FR.lds + RING_OFF, g_, S, E); } } while (0)
        const int c0 = 3 * l;
        FFN_IN_PHASE(0, c0, W_1IN, 0);
#if PROBE_REPG > 1
        if (IN(pb + 0)) xcd_barrier(bar);
        FFN_IN_PHASE(0, c0, W_1IN, 0);
#endif
        SEAM(pb + 0);
        OUT_PHASE(1, c0, ACT, W_1OUT, F, 2, 0.5f, 1);
#if PROBE_REPO > 1
        xcd_barrier(bar); OUT_PHASE(1, (c0) + 2, ACT, W_1OUT, F, 2, 0.0f, 1);
#endif
        SEAM(pb + 1);
        if (IN(pb + 2)) { RSTD_TABLE(NINP, (c0 + 1) & 1);
            pg8::Gemm g{XS, (const bf16_t*)(wl + W_IN), M, NINP, D, 0}; pg8::StaticOrder S; S.init(M, NINP, FR.G, (int)blockIdx.x); pg8::EpiMixIn E{ws, l};
            pg8::gemm_phase<pg8::EpiMixIn, pg8::StaticOrder, true, MK_SP2>(FR.lds + RING_OFF, g, S, E); }
        SEAM(pb + 2);
#if !MK_NAIVE_MIX
        for (int rep5 = 0; rep5 < PROBE_REP5; ++rep5) { if (rep5) xcd_barrier(bar);
        if (IN(pb + 3)) {
            const bf16_t* GWl = (const bf16_t*)(ws + WS_GW) + (size_t)l * 2 * 6 * 64 * 64;
            const float lam = ((const float*)(ws + WS_LAMS))[l], lam_init = args.lam_init[l];
            LAS unsigned* qw = (LAS unsigned*)(FR.lds + LDSCTL_OFF + 256);
            for (;;) {
                if ((int)threadIdx.x == 0) *qw = __hip_atomic_fetch_add((unsigned*)(ctl + CW_Q + 64 * (l + NL * rep5)), 1u, RLX_AGENT);
                __syncthreads();
                const unsigned it = __builtin_amdgcn_readfirstlane(*qw);
                constexpr unsigned N_R1 = NB * 64 * 6 / NWAVES;
                if (it >= (unsigned)mix::N_ITEMS && it < (unsigned)mix::N_ITEMS + N_R1) { const int wi = (int)(it - (unsigned)mix::N_ITEMS) * NWAVES + FR.wave;
                mix::rglru_item<1>(wi, PROJ, GWl, (const float*)(ws + WS_SP8) + l * RW, args.in[14] + l * 4 * RW, args.in[15] + l * RW, args.in[17] + l * RW, args.in[19] + l * RW, (float*)(ws + WS_AGGA), (float*)(ws + WS_AGGB), Y, lane_id());
                    continue; }
                if (it >= (unsigned)mix::N_ITEMS + N_R1) {
                    const int cw = (int)(it - (unsigned)mix::N_ITEMS - N_R1);
                    if (l + 1 >= NL || cw >= CONV_WG_ITEMS) break;
                    const int r = cw * NWAVES + FR.wave;
                    if (r < CONV_ITEMS_L) conv_item(ConvSrc{args.in[8], args.in[9], args.in[10], args.in[11], args.in[12], args.in[13]}, ws, l + 1, r, (LAS float*)(FR.lds + RING_OFF + FR.wave * 16384), lane_id());
                    continue; }
                const unsigned code = mix::g_items.v[it]; const int qb = (code >> 8) & 15, bh = code & 31;
                if (code & 0x8000u) mix::ret_seq(bh >> 2, bh & 3, PROJ, Y, FR.lds + RING_OFF);
                else mix::attn_unit<0>(bh / 6, bh % 6, qb, PROJ, Y, FR.lds + RING_OFF, lam, lam_init, args.in[25] + l * 64);
            }
        } }
#endif
        SEAM(pb + 3);
#if !MK_NAIVE_MIX
        if (IN(pb + 4)) {
            const bf16_t* GWl = (const bf16_t*)(ws + WS_GW) + (size_t)l * 2 * 6 * 64 * 64;
            for (int wi = FR.gw; wi < NB * 64 * 6; wi += FR.NGW)
                mix::rglru_item<2>(wi, PROJ, GWl, (const float*)(ws + WS_SP8) + l * RW, args.in[14] + l * 4 * RW, args.in[15] + l * RW, args.in[17] + l * RW, args.in[19] + l * RW, (float*)(ws + WS_AGGA), (float*)(ws + WS_AGGB), Y, lane_id());
            if (l + 1 < NL) bias_layer(ws, l + 1, FR.gw, FR.NGW, lane_id());
        }
#endif
#if PROBE_REPR > 1
        xcd_barrier(bar);
#if !MK_NAIVE_MIX
        if (IN(pb + 4)) {
            const bf16_t* GWl = (const bf16_t*)(ws + WS_GW) + (size_t)l * 2 * 6 * 64 * 64;
            for (int wi = FR.gw; wi < NB * 64 * 6; wi += FR.NGW)
                mix::rglru_item<2>(wi, PROJ, GWl, (const float*)(ws + WS_SP8) + l * RW, args.in[14] + l * 4 * RW, args.in[15] + l * RW, args.in[17] + l * RW, args.in[19] + l * RW, (float*)(ws + WS_AGGA), (float*)(ws + WS_AGGB), Y, lane_id());
        }
#endif
#endif
        SEAM(pb + 4);
        OUT_PHASE(5, c0 + 1, Y, W_OUT, D, 5, 1.0f, 2);
#if PROBE_REPO > 1
        xcd_barrier(bar); OUT_PHASE(5, (c0 + 1) + 2, Y, W_OUT, D, 5, 0.0f, 2);
#endif
        SEAM(pb + 5);
        FFN_IN_PHASE(6, c0 + 2, W_2IN, 2);
        SEAM(pb + 6);
        OUT_PHASE(7, c0 + 2, ACT, W_2OUT, F, 8, 0.5f, 3);
#if PROBE_REPO > 1
        xcd_barrier(bar); OUT_PHASE(7, (c0 + 2) + 2, ACT, W_2OUT, F, 8, 0.0f, 3);
#endif
        SEAM(pb + 7);
    }
    if (IN(PH_FINAL)) {
        int lnf = lane_id(); asm volatile("" : "+v"(lnf));
        const float* gp = args.in[26]; f32x4 Gv[4];
#pragma unroll
        for (int jj = 0; jj < 4; ++jj) Gv[jj] = *(const f32x4*)(gp + 4 * lnf + 256 * jj);
        for (int rr = 0; rr < 8; ++rr) { const int m = FR.gw * 8 + rr; const GAS u32x2* xr = (const GAS u32x2*)((const bf16_t*)(ws + WS_X) + (size_t)m * D) + lnf; f32x4 v[4]; float s2 = 0.f;
#pragma unroll
            for (int jj = 0; jj < 4; ++jj) { const u32x2 xw = xr[64 * jj]; v[jj] = (f32x4){hlo(xw.x), hhi(xw.x), hlo(xw.y), hhi(xw.y)}; s2 += (v[jj].x * v[jj].x + v[jj].y * v[jj].y) + (v[jj].z * v[jj].z + v[jj].w * v[jj].w); }
            const float rstd = 1.0f / sqrtf(wave_sum(s2) * (1.f / D) + EPS);
            GAS f32x4* o = (GAS f32x4*)(args.out + (size_t)m * D) + lnf;
#pragma unroll
            for (int jj = 0; jj < 4; ++jj) o[64 * jj] = v[jj] * rstd * Gv[jj]; }
    }
#undef IN
#undef SEAM
#undef bar
}

__global__ void nv_conv(const bf16_t* PROJ, const float* cw, const float* cb, float* xc) {
    const int idx = blockIdx.x * 256 + threadIdx.x; if (idx >= M * RW) return;
    const int m = idx / RW, c = idx % RW, t = m & (T - 1); float s = cb[c];
    for (int j = 0; j < 4; ++j) { const int tt = t - 3 + j; if (tt >= 0) s += cw[j * RW + c] * bf2f(PROJ[(size_t)(m - 3 + j) * NINP + C_RX + c]); }
    xc[idx] = s;
}
__global__ void nv_gates(const float* xc, const float* wa, const float* ba, const float* wx, const float* bx, const float* lam, float* av, float* bv) {
    const int idx = blockIdx.x * 256 + threadIdx.x; if (idx >= M * RW) return;
    const int m = idx / RW, c = idx % RW, h = c >> 6, cc = c & 63; float sr = ba[c], si = bx[c];
    for (int i = 0; i < 64; ++i) { const float xv = xc[(size_t)m * RW + 64 * h + i]; sr += xv * wa[(h * 64 + i) * 64 + cc]; si += xv * wx[(h * 64 + i) * 64 + cc]; }
    const float r = 1.f / (1.f + expf(-sr)), ig = 1.f / (1.f + expf(-si)); const float sp = log1pf(expf(-lam[c])); const float la = -8.0f * r * sp;
    av[idx] = expf(la); bv[idx] = sqrtf(-expm1f(2.f * la)) * ig * xc[idx];
}
__global__ void nv_scan(const float* av, const float* bv, const bf16_t* PROJ, bf16_t* Y) {
    const int idx = blockIdx.x * 64 + threadIdx.x; if (idx >= NB * RW) return;
    const int b = idx / RW, c = idx % RW; float h = 0.f;
    for (int t = 0; t < T; ++t) { const size_t m = (size_t)b * T + t; h = av[m * RW + c] * h + bv[m * RW + c];
        const float g = bf2f(PROJ[m * NINP + C_RG + c]); const float u = 0.7978845608028654f * (g + 0.044715f * g * g * g); const float y = 0.5f * g * (1.f + tanhf(u)) * h;
        Y[m * D + c] = (bf16_t)(pk2(y, 0.f) & 0xffffu); }
}
__global__ void __launch_bounds__(64) nv_diff(const bf16_t* PROJ, float* OT) {
    const int t = blockIdx.x * 64 + threadIdx.x, hc = blockIdx.y, h = hc >> 1, comp = hc & 1, b = blockIdx.z;
    const size_t m = (size_t)b * T + t;
    float q[32], o[64];
#pragma unroll
    for (int i = 0; i < 32; ++i) q[i] = bf2f(PROJ[m * NINP + C_DQ + 64 * h + 32 * comp + i]);
#pragma unroll
    for (int i = 0; i < 64; ++i) o[i] = 0.f;
    float mx = -INFINITY, lsum = 0.f; const int tmax = blockIdx.x * 64 + 63;
    for (int j = 0; j <= tmax; ++j) {
        const bf16_t* kr = PROJ + ((size_t)b * T + j) * NINP + C_DK + 64 * h + 32 * comp; const bf16_t* vr = PROJ + ((size_t)b * T + j) * NINP + C_DV + 64 * h;
        float s = 0.f;
#pragma unroll
        for (int i = 0; i < 32; ++i) s += q[i] * bf2f(kr[i]);
        if (j <= t) { const float mn = fmaxf(mx, s); const float al = exp2f(mx - mn), p = exp2f(s - mn); lsum = lsum * al + p; mx = mn;
#pragma unroll
            for (int i = 0; i < 64; ++i) o[i] = o[i] * al + p * bf2f(vr[i]); }
    }
    const float il = 1.f / lsum; float* op = OT + ((m * 6 + h) * 2 + comp) * 64;
#pragma unroll
    for (int i = 0; i < 64; ++i) op[i] = o[i] * il;
}
__global__ void nv_diff_fin(const float* OT, const float* lq1, const float* lk1, const float* lq2, const float* lk2, const float* subg, float lambda_init, bf16_t* Y) {
    const int idx = blockIdx.x * 256 + threadIdx.x; if (idx >= M * 6) return;
    float s1 = 0.f, s2 = 0.f; for (int i = 0; i < 32; ++i) { s1 += lq1[i] * lk1[i]; s2 += lq2[i] * lk2[i]; }
    const float lam = expf(s1) - expf(s2) + lambda_init;
    const int m = idx / 6, h = idx % 6; const float* o1 = OT + ((size_t)idx * 2) * 64; const float* o2 = o1 + 64; float ss = 0.f;
    for (int i = 0; i < 64; ++i) { const float v = o1[i] - lam * o2[i]; ss += v * v; }
    const float r = 1.0f / sqrtf(ss * (1.f / 64.f) + EPS) * (1.f - lambda_init);
    for (int i = 0; i < 64; ++i) { const float v = (o1[i] - lam * o2[i]) * r * subg[i]; Y[(size_t)m * D + RW + 64 * h + i] = (bf16_t)(pk2(v, 0.f) & 0xffffu); }
}
__global__ void __launch_bounds__(64) nv_ret(const bf16_t* PROJ, bf16_t* Y) {
    const int t = blockIdx.x * 64 + threadIdx.x, h = blockIdx.y, b = blockIdx.z; const size_t m = (size_t)b * T + t;
    float q[64], o[64];
#pragma unroll
    for (int i = 0; i < 64; ++i) { q[i] = bf2f(PROJ[m * NINP + C_TQ + 64 * h + i]); o[i] = 0.f; }
    const float lg2 = log2f(1.0f - exp2f(-5.0f - (float)h)); const int tmax = blockIdx.x * 64 + 63;
    for (int j = 0; j <= tmax; ++j) {
        const bf16_t* kr = PROJ + ((size_t)b * T + j) * NINP + C_TK + 64 * h; const bf16_t* vr = PROJ + ((size_t)b * T + j) * NINP + C_TV + 64 * h;
        float s = 0.f;
#pragma unroll
        for (int i = 0; i < 64; ++i) s += q[i] * bf2f(kr[i]);
        if (j <= t) { const float p = s * exp2f(64.0f * (float)((t >> 6) - (j >> 6)) * lg2);
#pragma unroll
            for (int i = 0; i < 64; ++i) o[i] += p * bf2f(vr[i]); }
    }
    float ss = 0.f;
#pragma unroll
    for (int i = 0; i < 64; ++i) ss += o[i] * o[i];
    const float r = 1.0f / sqrtf(ss * (1.f / 64.f) + EPS);
#pragma unroll
    for (int i = 0; i < 64; ++i) { const float g = bf2f(PROJ[m * NINP + C_TG + 64 * h + i]); const float v = g / (1.f + expf(-g)) * o[i] * r; Y[m * D + 768 + 64 * h + i] = (bf16_t)(pk2(v, 0.f) & 0xffffu); }
}

extern "C" void kernel_launch(void* const* d_in, const int* in_sizes, int n_in, void* d_out, int out_size, void* d_ws, size_t ws_size, hipStream_t stream) {
    static int grid = 0;
    if (grid == 0) {
        if (n_in != 27 || in_sizes[0] != M * D || out_size != M * D || ws_size < WS_END) { fprintf(stderr, "kernel_launch: unexpected shapes (n_in %d, ws %zu < %zu)\n", n_in, ws_size, (size_t)WS_END); grid = -1; return; }
        int dev = 0, cus = 0;
        if (hipGetDevice(&dev) != hipSuccess || hipDeviceGetAttribute(&cus, hipDeviceAttributeMultiprocessorCount, dev) != hipSuccess) { grid = -1; return; }
        if (hipFuncSetAttribute((const void*)mega, hipFuncAttributeMaxDynamicSharedMemorySize, LDS_BYTES) != hipSuccess) { fprintf(stderr, "kernel_launch: hipFuncSetAttribute failed\n"); grid = -1; return; }
        int per_cu = 0;
        if (hipOccupancyMaxActiveBlocksPerMultiprocessor(&per_cu, (const void*)mega, NWAVES * 64, LDS_BYTES) != hipSuccess || per_cu < 1) fprintf(stderr, "kernel_launch: occupancy query says %d\n", per_cu);
        (void)hipGetLastError();
        grid = cus;
        if (grid != 256) { fprintf(stderr, "kernel_launch: built for 256 CUs, got %d\n", grid); }
    }
    if (grid < 0) return;
    (void)hipMemsetAsync((char*)d_ws + WS_CTL, 0, CTL_ZERO_BYTES, stream);
    Args a{};
    for (int i = 0; i < 27; ++i) a.in[i] = (const float*)d_in[i];
    a.pos = (const int*)d_in[2]; a.out = (float*)d_out; a.ws = (unsigned char*)d_ws;
    for (int l = 0; l < NL; ++l) a.lam_init[l] = (float)(0.8 - 0.6 * exp(-0.3 * (double)l));
    unsigned char* ws = (unsigned char*)d_ws;
#if MK_ONE_LAUNCH
    a.ph_lo = 0; a.ph_hi = PH_END;
    hipLaunchKernelGGL(mega, dim3(grid), dim3(NWAVES * 64), LDS_BYTES, stream, a);
#else
    int nrun = 0; auto run = [&](int lo, int hi) { a.ph_lo = lo; a.ph_hi = hi; a.li = nrun++; hipLaunchKernelGGL(mega, dim3(grid), dim3(NWAVES * 64), LDS_BYTES, stream, a); };
    int seg_lo = 0;
    for (int l = 0; l < NL; ++l) {
        const int pb = PH_L0 + l * NPH;
        run(seg_lo, pb + 3); seg_lo = pb + 5;
#if !MK_NAIVE_MIX
        run(pb + 3, pb + 4); run(pb + 4, pb + 5);
#endif
        if (MK_NAIVE_MASK) {
            const bf16_t* PROJ = (const bf16_t*)(ws + WS_PROJ); bf16_t* Y = (bf16_t*)(ws + WS_Y);
            float* xc = (float*)(ws + WS_TMP); float* av = xc + (size_t)M * RW; float* bv = av + (size_t)M * RW; float* OT = (float*)(ws + WS_TMP);
            if (MK_NAIVE_MASK & 1) {
                hipLaunchKernelGGL(nv_conv, dim3(M * RW / 256), dim3(256), 0, stream, PROJ, a.in[14] + l * 4 * RW, a.in[15] + l * RW, xc);
                hipLaunchKernelGGL(nv_gates, dim3(M * RW / 256), dim3(256), 0, stream, xc, a.in[16] + l * 6 * 64 * 64, a.in[17] + l * RW, a.in[18] + l * 6 * 64 * 64, a.in[19] + l * RW, a.in[20] + l * RW, av, bv);
                hipLaunchKernelGGL(nv_scan, dim3(NB * RW / 64), dim3(64), 0, stream, av, bv, PROJ, Y); }
            if (MK_NAIVE_MASK & 2) {
                hipLaunchKernelGGL(nv_diff, dim3(T / 64, 12, NB), dim3(64), 0, stream, PROJ, OT);
                hipLaunchKernelGGL(nv_diff_fin, dim3(M * 6 / 256), dim3(256), 0, stream, OT, a.in[21] + l * 32, a.in[22] + l * 32, a.in[23] + l * 32, a.in[24] + l * 32, a.in[25] + l * 64, a.lam_init[l], Y); }
            if (MK_NAIVE_MASK & 4) hipLaunchKernelGGL(nv_ret, dim3(T / 64, 4, NB), dim3(64), 0, stream, PROJ, Y);
        }
    }
    run(seg_lo, PH_END);
#endif
}
```

```cpp
#include <hip/hip_runtime.h>
#include <cstdio>
#include <cstdint>
#include <cmath>

#ifndef MK_ONE_LAUNCH
#define MK_ONE_LAUNCH 1
#endif
#ifndef PROBE_REP5
#define PROBE_REP5 1
#endif
#ifndef PROBE_EPIR2
#define PROBE_EPIR2 0
#endif
#ifndef PROBE_EPI2
#define PROBE_EPI2 0
#endif
#ifndef PROBE_XEXP
#define PROBE_XEXP 0
#endif
#if PROBE_XEXP
#define PROBE_EXTRA_EXP(pa, pb) do { _Pragma("unroll") for (int r = 0; r < 16; ++r) { float d0_, d1_; asm volatile("v_exp_f32 %0, %2\n\tv_exp_f32 %1, %3" : "=v"(d0_), "=v"(d1_) : "v"(pa[r]), "v"(pb[r])); } } while (0)
#else
#define PROBE_EXTRA_EXP(pa, pb) do { } while (0)
#endif
#ifndef MK_SP2
#define MK_SP2 true
#endif
#ifndef PROBE_REPO
#define PROBE_REPO 1
#endif
#ifndef PROBE_REPP
#define PROBE_REPP 1
#endif
#ifndef PROBE_REPR
#define PROBE_REPR 1
#endif
#ifndef PROBE_BAR2
#define PROBE_BAR2 0
#endif
#ifndef PROBE_REPG
#define PROBE_REPG 1
#endif
#ifndef MK_NAIVE_MIX
#define MK_NAIVE_MIX 0
#endif
#ifndef MK_NAIVE_MASK
#define MK_NAIVE_MASK 0
#endif

constexpr int D = 1024, NB = 4, T = 4096, M = NB * T, NL = 4, F = 2816, NMOD = 9, NMD = NMOD * D;
constexpr int NIN = 2944, NINP = 3072;
constexpr int C_DQ = 0, C_DK = 384, C_TQ = 768, C_TK = 1024, C_DV = 1280, C_TV = 1664, C_TG = 1920, C_RX = 2176, C_RG = 2560;
constexpr int RW = 384;
constexpr float EPS = 1e-6f;
constexpr float QSCALE = 0.17677669529663687f * 1.4426950408889634f;
constexpr int KC = 32, NKC = D / KC;

constexpr size_t MiB = 1u << 20;
constexpr size_t WS_CTL = 0, CTL_ZERO_BYTES = 1 * MiB;
constexpr size_t WS_MODP = 1 * MiB;
constexpr size_t WS_MOD = 20 * MiB;
constexpr size_t WS_GW = 20 * MiB + 640 * 1024;
constexpr size_t WS_TABD = 21 * MiB;
constexpr size_t WS_TABR = 22 * MiB;
constexpr size_t WS_W = 26 * MiB;
constexpr size_t W_L = 41 * MiB, W_1IN = 0, W_1OUT = 11 * MiB, W_2IN = 16 * MiB + MiB / 2, W_2OUT = 27 * MiB + MiB / 2, W_IN = 33 * MiB, W_OUT = 39 * MiB;
constexpr size_t WS_X = WS_W + NL * W_L;
constexpr size_t WS_H = WS_X + 64 * MiB;
constexpr size_t WS_Y = WS_H + 32 * MiB;
constexpr size_t WS_ACT = WS_Y + 32 * MiB;
constexpr size_t WS_PROJ = WS_ACT;
constexpr size_t WS_TMP = WS_ACT + 96 * MiB;
constexpr size_t WS_SP8 = 21 * MiB + 512 * 1024;
constexpr size_t WS_LAMS = 21 * MiB + 520 * 1024;
constexpr size_t WS_ANORM = 21 * MiB + 528 * 1024;
constexpr size_t WS_BIAS = WS_TMP + 100 * MiB;
constexpr size_t WS_SSQ = WS_TMP + 104 * MiB;
constexpr size_t WS_AGGA = WS_TMP + 110 * MiB, WS_AGGB = WS_TMP + 111 * MiB;
constexpr size_t WS_END = WS_TMP + 112 * MiB;
constexpr int CW_TMO = 0, CW_CODE = 1, CW_Q = 2048  , CW_BAR = 4096;

#define GAS __attribute__((address_space(1)))
#define LAS __attribute__((address_space(3)))
typedef unsigned short bf16_t;
typedef short bf16x8 __attribute__((ext_vector_type(8)));
typedef float f32x4 __attribute__((ext_vector_type(4)));
typedef float f32x2 __attribute__((ext_vector_type(2)));
typedef unsigned u32x4 __attribute__((ext_vector_type(4)));
typedef unsigned u32x2 __attribute__((ext_vector_type(2)));
typedef __bf16 bf16x2_t __attribute__((ext_vector_type(2)));
typedef GAS unsigned gu32;
#define RLX_AGENT __ATOMIC_RELAXED, __HIP_MEMORY_SCOPE_AGENT
#define LDS_WAIT() asm volatile("s_waitcnt lgkmcnt(0)" ::: "memory")
#define VM_WAIT() asm volatile("s_waitcnt vmcnt(0)" ::: "memory")
__device__ __forceinline__ unsigned pk2(float lo, float hi) { f32x2 v = {lo, hi}; bf16x2_t b = __builtin_convertvector(v, bf16x2_t); return __builtin_bit_cast(unsigned, b); }
typedef _Float16 h16x2_t __attribute__((ext_vector_type(2)));
__device__ __forceinline__ unsigned pkh2(float lo, float hi) { f32x2 v = {lo, hi}; h16x2_t h = __builtin_convertvector(v, h16x2_t); return __builtin_bit_cast(unsigned, h); }
__device__ __forceinline__ float hlo(unsigned w) { const h16x2_t h = __builtin_bit_cast(h16x2_t, w); return (float)h[0]; }
__device__ __forceinline__ float hhi(unsigned w) { const h16x2_t h = __builtin_bit_cast(h16x2_t, w); return (float)h[1]; }
__device__ __forceinline__ float bf2f(bf16_t v) { return __uint_as_float((unsigned)v << 16); }
__device__ __forceinline__ float bflo(unsigned w) { return __uint_as_float(w << 16); }
__device__ __forceinline__ float bfhi(unsigned w) { return __uint_as_float(w & 0xffff0000u); }
__device__ __forceinline__ float fast_rcp(float x) { return __builtin_amdgcn_rcpf(x); }
__device__ __forceinline__ float sigmoidf_(float x) { return fast_rcp(1.f + __builtin_amdgcn_exp2f(-1.4426950408889634f * x)); }
__device__ __forceinline__ float siluf_(float x) { return x * sigmoidf_(x); }
__device__ __forceinline__ float gelu_tanh(float x) { const float u = 0.7978845608028654f * (x + 0.044715f * x * x * x); return x * sigmoidf_(2.f * u); }
__device__ __forceinline__ int lane_id() { int l; asm volatile("v_mbcnt_lo_u32_b32 %0, -1, 0\n\tv_mbcnt_hi_u32_b32 %0, -1, %0" : "=v"(l)); return l; }
template <int XM> __device__ __forceinline__ float swz_xor(float v) { return __int_as_float(__builtin_amdgcn_ds_swizzle(__float_as_int(v), (XM << 10) | 0x1F)); }
__device__ __forceinline__ float sum_x32(float v) { const auto r = __builtin_amdgcn_permlane32_swap(__float_as_uint(v), __float_as_uint(v), false, false); return __uint_as_float(r[0]) + __uint_as_float(r[1]); }
__device__ __forceinline__ int imax_x32(int v) { const auto r = __builtin_amdgcn_permlane32_swap((unsigned)v, (unsigned)v, false, false); const int a = (int)r[0], b = (int)r[1]; return a > b ? a : b; }
__device__ __forceinline__ float wave_sum(float v) {
    v += swz_xor<1>(v); v += swz_xor<2>(v); v += swz_xor<4>(v); v += swz_xor<8>(v); v += swz_xor<16>(v);
    return sum_x32(v);
}

__device__ __forceinline__ float lg2gamma(int hh) { return hh == 0 ? -0.04580368961312479f : hh == 1 ? -0.02272007650008353f : hh == 2 ? -0.011315313227834146f : -0.005646563141142063f; }

constexpr int RING_OFF = 0, RING_BYTES = 131072, LDSCTL_OFF = RING_BYTES, MISC_OFF = LDSCTL_OFF + 320, LDS_RSTD_OFF = RING_BYTES + 1024  , LDS_BYTES = 163840;
extern __shared__ __attribute__((aligned(16))) unsigned char lds_raw[];

namespace pg8 {
#define PG8_LAS __attribute__((address_space(3)))
constexpr int BM = 256, BK = 64, HALF = 128, HTB = HALF * BK * 2, STAGE_BYTES = 8 * HTB, NXCD = 8, WGM = 8;
__host__ __device__ __forceinline__ int lds_byte(int r, int c) { const int st = (r >> 4) * 2 + (c >> 5), rr = r & 15, cc = c & 31, ob = rr * 64 + cc * 2; return st * 1024 + (ob ^ (((ob >> 9) & 1) << 5)); }
__host__ __device__ __forceinline__ void stage_rc(int b, int& R, int& C) { const int st = b / 1024, sb = b % 1024, swz = sb ^ (((sb >> 9) & 1) << 5); R = (st >> 1) * 16 + swz / 64; C = (st & 1) * 32 + (swz % 64) / 2; }
__host__ __device__ __forceinline__ int perm32(int rho) { const int n = rho >> 4, i = rho & 15; return 8 * (i >> 2) + 4 * n + (i & 3); }
struct Unit { int pm, pn, idx; };
struct Gemm { const bf16_t* A; const bf16_t* Bt; int M, N, K, tiled; };
struct StaticOrder {
    int nM, nN, nwg, G, c;
    __host__ __device__ void init(int M_, int N_, int G_, int c_) { nM = M_ / BM; nN = N_ / BM; nwg = nM * nN; G = G_; c = c_;
#if defined(__HIP_DEVICE_COMPILE__)
        asm volatile("" : "+s"(c));
#endif
    }
    __host__ __device__ __forceinline__ bool next(int i, Unit& u) const {
        const long L = (long)i * G + c; if (L >= nwg) return false;
        int wgid = (int)L; { const int q = nwg / NXCD, r = nwg % NXCD, xcd = wgid % NXCD, off = wgid / NXCD; wgid = (xcd < r ? xcd * (q + 1) : r * (q + 1) + (xcd - r) * q) + off; }
        const int nig = WGM * nN, gid = wgid / nig, fm = gid * WGM, gsz = (nM - fm) < WGM ? (nM - fm) : WGM;
        u.pm = fm + ((wgid % nig) % gsz); u.pn = (wgid % nig) / gsz; u.idx = i; return true;
    }
    __device__ __forceinline__ void a_ready(const Unit&) const {}
    __device__ __forceinline__ void done(const Unit&) const {}
};

struct EpiSwiglu {
    static constexpr bool PERM = true, AFTER_DRAIN = false;
    unsigned char* ws; int lg;
    __device__ __forceinline__ void operator()(const f32x4 (&acc)[2][2][4][2], const Unit& u, int wr, int wc, int fr, int fq) const {
        bf16_t* O = (bf16_t*)(ws + WS_ACT); const float* bias = (const float*)(ws + WS_BIAS) + (size_t)lg * NB * (2 * F); const LAS float* rstd = (const LAS float*)((LAS unsigned char*)lds_raw + LDS_RSTD_OFF);
        const int row0 = u.pm * BM + wr * 64 + fr, col0 = u.pn * HALF + wc * 32 + 8 * fq;
        const float* bp = bias + (size_t)(u.pm >> 4) * (2 * F) + u.pn * BM + wc * 32 + 8 * fq;
        const f32x4 bg0 = *(const f32x4*)bp, bg1 = *(const f32x4*)(bp + 4), bu0 = *(const f32x4*)(bp + HALF), bu1 = *(const f32x4*)(bp + HALF + 4);
#pragma unroll
        for (int ai = 0; ai < 2; ++ai)
#pragma unroll
            for (int m = 0; m < 4; ++m) {
                const float rs = rstd[u.idx * BM + ai * HALF + m * 16 + wr * 64 + fr];
                const int row_ = row0 + ai * HALF + m * 16;
                bf16_t* rowp = O + ((((size_t)(row_ >> 8) * (F / 64) + (col0 >> 6)) * BM + (row_ & 255)) << 6) + (col0 & 63);
                const f32x4 g0 = acc[ai][0][m][0] * rs + bg0, g1 = acc[ai][0][m][1] * rs + bg1, u0 = acc[ai][1][m][0] * rs + bu0, u1 = acc[ai][1][m][1] * rs + bu1;
                u32x4 w;
                w.x = pk2(siluf_(g0[0]) * u0[0], siluf_(g0[1]) * u0[1]); w.y = pk2(siluf_(g0[2]) * u0[2], siluf_(g0[3]) * u0[3]);
                w.z = pk2(siluf_(g1[0]) * u1[0], siluf_(g1[1]) * u1[1]); w.w = pk2(siluf_(g1[2]) * u1[2], siluf_(g1[3]) * u1[3]);
                *(u32x4*)rowp = w;
            }
    }
};
struct EpiResid {
    static constexpr bool PERM = true, AFTER_DRAIN = false;
    unsigned char* ws; int l, gidx, an_idx, slot; float coef;
    __device__ __forceinline__ void operator()(const f32x4 (&acc)[2][2][4][2], const Unit& u, int wr, int wc, int fr, int fq) const {
        bf16_t* X = (bf16_t*)(ws + WS_X); bf16_t* XS = (bf16_t*)(ws + WS_H); float* SSQ = (float*)(ws + WS_SSQ) + (size_t)slot * M * 16;
        const float* gate = (const float*)(ws + WS_MOD) + (size_t)l * NB * NMD + gidx * D; const float* An = (const float*)(ws + WS_ANORM) + (size_t)(an_idx < 0 ? 0 : an_idx) * NB * D; const bool has_an = an_idx >= 0;
        const int row0 = u.pm * BM + wr * 64 + fr, col0 = u.pn * BM + wc * 32 + 8 * fq, b = u.pm >> 4;
        f32x4 gv[2][2], av[2][2];
#pragma unroll
        for (int bj = 0; bj < 2; ++bj)
#pragma unroll
            for (int n = 0; n < 2; ++n) { gv[bj][n] = *(const f32x4*)(gate + (size_t)b * NMD + col0 + bj * HALF + n * 4) * coef;
                av[bj][n] = *(const f32x4*)(An + (size_t)b * D + col0 + bj * HALF + n * 4); }
        u32x4 xin[2][2];
#define RES_LOAD(g_, buf) do { const size_t ro_ = (size_t)(row0 + ((g_) >> 2) * HALF + ((g_) & 3) * 16) * D + col0; \
            _Pragma("unroll") for (int bj = 0; bj < 2; ++bj) xin[buf][bj] = *(const u32x4*)(X + ro_ + bj * HALF); } while (0)
        RES_LOAD(0, 0);
#pragma unroll
        for (int g = 0; g < 8; ++g) { const int ai = g >> 2, m = g & 3, row = row0 + ai * HALF + m * 16; const size_t ro = (size_t)row * D + col0; float ss = 0.f;
            if (g + 1 < 8) RES_LOAD(g + 1, (g + 1) & 1);
#pragma unroll
            for (int bj = 0; bj < 2; ++bj) { const size_t o = ro + bj * HALF; const u32x4 xi = xin[g & 1][bj];
                const f32x4 x0 = (f32x4){hlo(xi.x), hhi(xi.x), hlo(xi.y), hhi(xi.y)} + gv[bj][0] * acc[ai][bj][m][0], x1 = (f32x4){hlo(xi.z), hhi(xi.z), hlo(xi.w), hhi(xi.w)} + gv[bj][1] * acc[ai][bj][m][1];
                { u32x4 w; w.x = pkh2(x0[0], x0[1]); w.y = pkh2(x0[2], x0[3]); w.z = pkh2(x1[0], x1[1]); w.w = pkh2(x1[2], x1[3]); *(u32x4*)(X + o) = w; }
                ss += ((x0[0] * x0[0] + x0[1] * x0[1]) + (x0[2] * x0[2] + x0[3] * x0[3])) + ((x1[0] * x1[0] + x1[1] * x1[1]) + (x1[2] * x1[2] + x1[3] * x1[3]));
                if (has_an) { const f32x4 s0 = x0 * av[bj][0], s1 = x1 * av[bj][1]; u32x4 w; w.x = pk2(s0[0], s0[1]); w.y = pk2(s0[2], s0[3]); w.z = pk2(s1[0], s1[1]); w.w = pk2(s1[2], s1[3]); *(u32x4*)(XS + o) = w; } }
            ss += swz_xor<16>(ss); ss = sum_x32(ss);
            if (fq == 0) SSQ[(size_t)row * 16 + u.pn * 4 + wc] = ss; }
#undef RES_LOAD
    }
};
struct EpiMixIn {
    static constexpr bool PERM = true, AFTER_DRAIN = false;
    unsigned char* ws; int l;
    __device__ __forceinline__ void operator()(const f32x4 (&acc)[2][2][4][2], const Unit& u, int wr, int wc, int fr, int fq) const {
        bf16_t* O = (bf16_t*)(ws + WS_PROJ); const float* tabD = (const float*)(ws + WS_TABD); const float* tabR = (const float*)(ws + WS_TABR);
        const float* bias = (const float*)(ws + WS_BIAS) + (size_t)(3 * l + 1) * NB * (2 * F); const LAS float* rstd = (const LAS float*)((LAS unsigned char*)lds_raw + LDS_RSTD_OFF);
        const int row0 = u.pm * BM + wr * 64 + fr;
#pragma unroll
        for (int bj = 0; bj < 2; ++bj) {
            const int kb = 2 * u.pn + bj, col0 = kb * HALF + wc * 32 + 8 * fq;
            const f32x4 b0 = *(const f32x4*)(bias + (size_t)(u.pm >> 4) * (2 * F) + col0), b1 = *(const f32x4*)(bias + (size_t)(u.pm >> 4) * (2 * F) + col0 + 4);
            if (kb < 6) {
                const float qs = (kb < 3) ? QSCALE : 1.f;
#pragma unroll
                for (int ai = 0; ai < 2; ++ai)
#pragma unroll
                    for (int m = 0; m < 4; ++m) { const int row = row0 + ai * HALF + m * 16; const float rs = rstd[u.idx * BM + ai * HALF + m * 16 + wr * 64 + fr];
                        f32x4 v0 = acc[ai][bj][m][0] * rs + b0, v1 = acc[ai][bj][m][1] * rs + b1;
                        if (fq == 0) { const f32x4 c = *(const f32x4*)(tabD + (size_t)row * 8), s = *(const f32x4*)(tabD + (size_t)row * 8 + 4); const f32x4 r0 = v0 * c - v1 * s, r1 = v1 * c + v0 * s; v0 = r0; v1 = r1; }
                        v0 = v0 * qs; v1 = v1 * qs;
                        u32x4 w; w.x = pk2(v0[0], v0[1]); w.y = pk2(v0[2], v0[3]); w.z = pk2(v1[0], v1[1]); w.w = pk2(v1[2], v1[3]);
                        *(u32x4*)(O + (size_t)row * NINP + col0) = w; }
            } else if (kb < 10) {
                const bool isk = (kb >= 8); const int i0 = 16 * (wc & 1) + 4 * fq; const float lg = lg2gamma(2 * (kb & 1) + (wc >> 1)) * (isk ? -1.f : 1.f);
#pragma unroll
                for (int ai = 0; ai < 2; ++ai)
#pragma unroll
                    for (int m = 0; m < 4; ++m) { const int row = row0 + ai * HALF + m * 16; const float rs = rstd[u.idx * BM + ai * HALF + m * 16 + wr * 64 + fr];
                        const f32x4 v0 = acc[ai][bj][m][0] * rs + b0, v1 = acc[ai][bj][m][1] * rs + b1;
                        const f32x4 c = *(const f32x4*)(tabR + (size_t)row * 64 + i0), s = *(const f32x4*)(tabR + (size_t)row * 64 + 32 + i0);
                        const float ks = __builtin_amdgcn_exp2f((float)(row & 63) * lg) * (isk ? 0.125f : 1.f);
                        const f32x4 r0 = (v0 * c - v1 * s) * ks, r1 = (v1 * c + v0 * s) * ks;
                        u32x4 w; w.x = pk2(r0[0], r0[1]); w.y = pk2(r0[2], r0[3]); w.z = pk2(r1[0], r1[1]); w.w = pk2(r1[2], r1[3]);
                        *(u32x4*)(O + (size_t)row * NINP + col0) = w; }
            } else {
#pragma unroll
                for (int ai = 0; ai < 2; ++ai)
#pragma unroll
                    for (int m = 0; m < 4; ++m) { const int row = row0 + ai * HALF + m * 16; const float rs = rstd[u.idx * BM + ai * HALF + m * 16 + wr * 64 + fr];
                        const f32x4 v0 = acc[ai][bj][m][0] * rs + b0, v1 = acc[ai][bj][m][1] * rs + b1;
                        u32x4 w; w.x = pk2(v0[0], v0[1]); w.y = pk2(v0[2], v0[3]); w.z = pk2(v1[0], v1[1]); w.w = pk2(v1[2], v1[3]);
                        *(u32x4*)(O + (size_t)row * NINP + col0) = w; }
            }
        }
    }
};

template <class Epi, class Sched, bool ALIGN_EPI = false, bool SP2 = false>
__device__ __forceinline__ void gemm_phase(PG8_LAS unsigned char* lds, const Gemm g, const Sched& S, const Epi& E) {
    int tid_ = threadIdx.x; asm volatile("" : "+v"(tid_));
    const int tid = tid_, wid = __builtin_amdgcn_readfirstlane(tid >> 6), lane = tid & 63, wr = wid >> 2, wc = wid & 3, fr = lane & 15, fq = lane >> 4;
    const int K = g.K, nt = K / BK, ld = g.tiled ? BK : K;
    unsigned voffA[2], voffB[2];
#pragma unroll
    for (int i = 0; i < 2; ++i) { int R, C; stage_rc(tid * 16 + i * 8192, R, C); const int Rb = Epi::PERM ? ((R & ~31) + perm32(R & 31)) : R;
        voffA[i] = (unsigned)(R * ld + C) * 2u; voffB[i] = (unsigned)(Rb * ld + C) * 2u; }
    const size_t kstep = g.tiled ? (size_t)(BM * BK * 2) : (size_t)(BK * 2);
    const size_t hstep = (size_t)HALF * ld * 2;
    const size_t tstep = g.tiled ? (size_t)nt * (BM * BK * 2) : 2 * hstep;
    const unsigned ldsw = (unsigned)wid * 1024u;
    const int aoff = lds_byte(wr * 64 + fr, fq * 8), boff = lds_byte(wc * 32 + fr, fq * 8);
#define PG8_SA(b, h) (((b) * 2 + (h)) * HTB)
#define PG8_SB(b, h) ((4 + (b) * 2 + (h)) * HTB)
#define PG8_STAGE(bufoff, gbase, voff) do { _Pragma("unroll") for (int _i = 0; _i < 2; ++_i) \
        __builtin_amdgcn_global_load_lds((const unsigned*)((const char*)(gbase) + (voff)[_i]), (PG8_LAS unsigned*)(lds + (bufoff) + ldsw + _i * 8192), 16, 0, 0); } while (0)
#define PG8_LDA(dst, b, h) do { _Pragma("unroll") for (int m = 0; m < 4; ++m) _Pragma("unroll") for (int k = 0; k < 2; ++k) dst[m][k] = *(const PG8_LAS bf16x8*)(lds + PG8_SA(b, h) + aoff + m * 2048 + k * 1024); } while (0)
#define PG8_LDB(dst, b, h) do { _Pragma("unroll") for (int n = 0; n < 2; ++n) _Pragma("unroll") for (int k = 0; k < 2; ++k) dst[n][k] = *(const PG8_LAS bf16x8*)(lds + PG8_SB(b, h) + boff + n * 2048 + k * 1024); } while (0)
#define PG8_MMA(ai, bj, At, Bt) do { __builtin_amdgcn_s_setprio(1); _Pragma("unroll") for (int m = 0; m < 4; ++m) _Pragma("unroll") for (int n = 0; n < 2; ++n) _Pragma("unroll") for (int k = 0; k < 2; ++k) \
        acc[ai][bj][m][n] = __builtin_amdgcn_mfma_f32_16x16x32_bf16(Bt[n][k], At[m][k], acc[ai][bj][m][n], 0, 0, 0); __builtin_amdgcn_s_setprio(0); } while (0)
#define PG8_WAIT_V(n) asm volatile("s_waitcnt vmcnt(" #n ")" ::: "memory")
#define PG8_WAIT_L(n) asm volatile("s_waitcnt lgkmcnt(" #n ")" ::: "memory")
#define PG8_BAR __builtin_amdgcn_s_barrier()
#define PG8_SCHED __builtin_amdgcn_sched_barrier(0)
    Unit cur, nxt; int ui = 0;
    if (!S.next(0, cur)) return;
    f32x4 acc[2][2][4][2];
#pragma unroll
    for (int a = 0; a < 2; ++a)
#pragma unroll
        for (int b = 0; b < 2; ++b)
#pragma unroll
            for (int m = 0; m < 4; ++m)
#pragma unroll
                for (int n = 0; n < 2; ++n) acc[a][b][m][n] = (f32x4){0.f, 0.f, 0.f, 0.f};
    bf16x8 At[4][2], B0[2][2], B1[2][2];
    const char* cA = (const char*)g.A + (size_t)cur.pm * tstep; const char* cB = (const char*)g.Bt + (size_t)cur.pn * tstep;
    S.a_ready(cur);
    if constexpr (SP2) {
        PG8_STAGE(PG8_SB(0, 0), cB, voffB); PG8_STAGE(PG8_SB(0, 1), cB + hstep, voffB); PG8_STAGE(PG8_SA(0, 0), cA, voffA); PG8_STAGE(PG8_SA(0, 1), cA + hstep, voffA);
        if (wr == 1) PG8_BAR;
        PG8_WAIT_V(2); PG8_BAR;
        PG8_STAGE(PG8_SB(1, 0), cB + kstep, voffB); PG8_STAGE(PG8_SA(1, 0), cA + kstep, voffA); PG8_STAGE(PG8_SB(1, 1), cB + hstep + kstep, voffB);
        PG8_WAIT_V(6); PG8_BAR;
    } else {
        PG8_STAGE(PG8_SB(0, 0), cB, voffB); PG8_STAGE(PG8_SA(0, 0), cA, voffA); PG8_STAGE(PG8_SB(0, 1), cB + hstep, voffB); PG8_STAGE(PG8_SA(0, 1), cA + hstep, voffA);
        if (wr == 1) PG8_BAR;
        PG8_WAIT_V(4); PG8_BAR;
        PG8_STAGE(PG8_SB(1, 0), cB + kstep, voffB); PG8_STAGE(PG8_SA(1, 0), cA + kstep, voffA); PG8_STAGE(PG8_SB(1, 1), cB + hstep + kstep, voffB);
        PG8_WAIT_V(6); PG8_BAR;
    }
    for (;;) {
        const bool has_next = S.next(ui + 1, nxt);
        const char* nA = has_next ? (const char*)g.A + (size_t)nxt.pm * tstep : cA; const char* nB = has_next ? (const char*)g.Bt + (size_t)nxt.pn * tstep : cB;
        for (int t = 0; t < nt; t += 2) {
            const bool last = (t == nt - 2);
            const char* a1 = cA + (size_t)(t + 1) * kstep;
            const char* a2 = last ? nA : cA + (size_t)(t + 2) * kstep; const char* b2 = last ? nB : cB + (size_t)(t + 2) * kstep;
            const char* a3 = a2 + kstep; const char* b3 = b2 + kstep;
            if (last && has_next) S.a_ready(nxt);
            if constexpr (SP2) {
            PG8_LDB(B0, 0, 0); PG8_LDB(B1, 0, 1); PG8_SCHED; PG8_LDA(At, 0, 0); PG8_STAGE(PG8_SA(1, 1), a1 + hstep, voffA);
            PG8_WAIT_V(8); PG8_WAIT_L(0); PG8_BAR; PG8_MMA(0, 0, At, B0); PG8_MMA(0, 1, At, B1); PG8_BAR; PG8_SCHED;
            PG8_LDA(At, 0, 1); PG8_STAGE(PG8_SB(0, 0), b2, voffB); PG8_STAGE(PG8_SB(0, 1), b2 + hstep, voffB); PG8_STAGE(PG8_SA(0, 0), a2, voffA);
            PG8_WAIT_V(8); PG8_WAIT_L(0); PG8_BAR; PG8_MMA(1, 0, At, B0); PG8_MMA(1, 1, At, B1); PG8_BAR; PG8_SCHED;
            PG8_LDB(B0, 1, 0); PG8_LDB(B1, 1, 1); PG8_SCHED; PG8_LDA(At, 1, 0); PG8_STAGE(PG8_SA(0, 1), a2 + hstep, voffA);
            PG8_WAIT_V(8); PG8_WAIT_L(0); PG8_BAR; PG8_MMA(0, 0, At, B0); PG8_MMA(0, 1, At, B1); PG8_BAR; PG8_SCHED;
            PG8_LDA(At, 1, 1); PG8_STAGE(PG8_SB(1, 0), b3, voffB); PG8_STAGE(PG8_SB(1, 1), b3 + hstep, voffB); PG8_STAGE(PG8_SA(1, 0), a3, voffA);
            PG8_WAIT_V(8); PG8_WAIT_L(0); PG8_BAR; PG8_MMA(1, 0, At, B0); PG8_MMA(1, 1, At, B1); PG8_BAR; PG8_SCHED;
            } else {
            PG8_LDB(B0, 0, 0); PG8_SCHED; PG8_LDA(At, 0, 0); PG8_STAGE(PG8_SA(1, 1), a1 + hstep, voffA);
            PG8_WAIT_L(8); PG8_BAR; PG8_WAIT_L(0); PG8_MMA(0, 0, At, B0); PG8_BAR; PG8_SCHED;
            PG8_LDB(B1, 0, 1); PG8_STAGE(PG8_SB(0, 0), b2, voffB);
            PG8_BAR; PG8_WAIT_L(0); PG8_MMA(0, 1, At, B1); PG8_BAR;
            PG8_LDA(At, 0, 1); PG8_STAGE(PG8_SA(0, 0), a2, voffA);
            PG8_BAR; PG8_WAIT_L(0); PG8_MMA(1, 0, At, B0); PG8_BAR; PG8_SCHED;
            PG8_STAGE(PG8_SB(0, 1), b2 + hstep, voffB);
            PG8_WAIT_V(6); PG8_BAR; PG8_MMA(1, 1, At, B1); PG8_BAR;
            PG8_LDB(B0, 1, 0); PG8_SCHED; PG8_LDA(At, 1, 0); PG8_STAGE(PG8_SA(0, 1), a2 + hstep, voffA);
            PG8_WAIT_L(8); PG8_BAR; PG8_WAIT_L(0); PG8_MMA(0, 0, At, B0); PG8_BAR; PG8_SCHED;
            PG8_LDB(B1, 1, 1); PG8_STAGE(PG8_SB(1, 0), b3, voffB);
            PG8_BAR; PG8_WAIT_L(0); PG8_MMA(0, 1, At, B1); PG8_BAR;
            PG8_LDA(At, 1, 1); PG8_STAGE(PG8_SA(1, 0), a3, voffA);
            PG8_BAR; PG8_WAIT_L(0); PG8_MMA(1, 0, At, B0); PG8_BAR; PG8_SCHED;
            PG8_STAGE(PG8_SB(1, 1), b3 + hstep, voffB);
            PG8_WAIT_V(6); PG8_BAR; PG8_MMA(1, 1, At, B1); PG8_BAR;
            }
        }
        if constexpr (ALIGN_EPI) { if (wr == 0) PG8_BAR; }
        if constexpr (!Epi::AFTER_DRAIN) { E(acc, cur, wr, wc, fr, fq);
#if PROBE_EPI2
            if constexpr (Epi::PERM) { asm volatile("" ::: "memory"); E(acc, cur, wr, wc, fr, fq); }
#elif PROBE_EPIR2
            if constexpr (!Epi::PERM) { asm volatile("s_waitcnt vmcnt(0)" ::: "memory"); Epi E2 = E; E2.coef = 0.f; E2(acc, cur, wr, wc, fr, fq); }
#endif
            S.done(cur); }
        if (!has_next) break;
#pragma unroll
        for (int a = 0; a < 2; ++a)
#pragma unroll
            for (int b = 0; b < 2; ++b)
#pragma unroll
                for (int m = 0; m < 4; ++m)
#pragma unroll
                    for (int n = 0; n < 2; ++n) acc[a][b][m][n] = (f32x4){0.f, 0.f, 0.f, 0.f};
        cur = nxt; cA = nA; cB = nB; ++ui;
        if constexpr (ALIGN_EPI) { if (wr == 1) PG8_BAR; }
    }
    PG8_WAIT_V(0);
    if constexpr (!ALIGN_EPI) { if (wr == 0) PG8_BAR; }
    PG8_BAR;
#undef PG8_SA
#undef PG8_SB
#undef PG8_STAGE
#undef PG8_LDA
#undef PG8_LDB
#undef PG8_MMA
#undef PG8_WAIT_V
#undef PG8_WAIT_L
#undef PG8_BAR
#undef PG8_SCHED
}
}

#define XB_TMO      128
#define XB_XCNT(j)  (256  + 64 * (j))
#define XB_XSUB(j)  (1280 + 64 * (j))
#define XB_XGEN(j)  (2304 + 64 * (j))
#define XB_TOP      3328
#define XB_TOPGEN   3392
#define XCD_BAR_WORDS 3456
#define XB_SPIN_CAP (1u << 18)
__device__ __forceinline__ unsigned xb_ld(unsigned* p)              { return __hip_atomic_load(p, __ATOMIC_RELAXED, __HIP_MEMORY_SCOPE_AGENT); }
__device__ __forceinline__ unsigned xb_add(unsigned* p, unsigned v) { return __hip_atomic_fetch_add(p, v, __ATOMIC_RELAXED, __HIP_MEMORY_SCOPE_AGENT); }
__device__ __forceinline__ unsigned xb_xcc_id() { return (unsigned)__builtin_amdgcn_s_getreg((3 << 11) | 20) & 0xFu; }
#define XB_SPIN(cond, bar) do { unsigned _sp = 0; while (cond) { __builtin_amdgcn_s_sleep(1); \
    if ((++_sp & 255u) == 0u) { if (xb_ld(&(bar)[XB_TMO])) break; if (_sp > XB_SPIN_CAP) { atomicAdd(&(bar)[XB_TMO], 1u); break; } } } } while (0)
struct XcdBarrier { unsigned* bar; unsigned x; volatile LAS unsigned* st; };
__device__ __forceinline__ XcdBarrier xcd_barrier_post(unsigned* bar, volatile LAS unsigned* st) {
    XcdBarrier b; b.bar = bar; b.x = xb_xcc_id(); b.st = st;
    if (threadIdx.x == 0) (void)xb_add(&bar[XB_XCNT(b.x)], 1u);
    return b;
}
__device__ __forceinline__ void xcd_barrier_complete(unsigned* bar, unsigned x, unsigned& nloc, unsigned& nx) {
    const unsigned G = gridDim.x * gridDim.y * gridDim.z;
    unsigned sum, cnt, mine, sp = 0u;
    for (;;) {
        sum = 0u; cnt = 0u; mine = 0u;
#pragma unroll
        for (unsigned j = 0; j < 16; ++j) { const unsigned c = xb_ld(&bar[XB_XCNT(j)]); sum += c; cnt += (c > 0u) ? 1u : 0u; mine = (j == x) ? c : mine; }
        if (sum == G) break;
        __builtin_amdgcn_s_sleep(1);
        if ((++sp & 255u) == 0u) { if (xb_ld(&bar[XB_TMO])) break; if (sp > XB_SPIN_CAP) { atomicAdd(&bar[XB_TMO], 1u); break; } }
    }
    nloc = mine > 0u ? mine : 1u; nx = cnt > 0u ? cnt : 1u;
}
__device__ __forceinline__ void xcd_barrier(const XcdBarrier& b) {
    asm volatile("s_waitcnt vmcnt(0)" ::: "memory");
    __syncthreads();
    if (threadIdx.x == 0) {
        unsigned* bar = b.bar; asm volatile("" : "+s"(bar));
        __builtin_amdgcn_s_waitcnt(0);
        unsigned nloc = b.st[0], nx = b.st[1];
        if (nloc == 0u) { xcd_barrier_complete(bar, b.x, nloc, nx); b.st[0] = nloc; b.st[1] = nx; }
        const unsigned old = xb_add(&bar[XB_XSUB(b.x)], 1u);
        const unsigned gen = old / nloc;
        if (old + 1u == (gen + 1u) * nloc) {
            __builtin_amdgcn_fence(__ATOMIC_RELEASE, "agent");
            asm volatile("s_waitcnt vmcnt(0)" ::: "memory");
            const unsigned og = xb_add(&bar[XB_TOP], 1u);
            const unsigned tg = og / nx;
            if (og + 1u == (tg + 1u) * nx) xb_add(&bar[XB_TOPGEN], 1u);
            else XB_SPIN(xb_ld(&bar[XB_TOPGEN]) == tg, bar);
            __builtin_amdgcn_fence(__ATOMIC_ACQUIRE, "agent");
            xb_add(&bar[XB_XGEN(b.x)], 1u);
            asm volatile("s_waitcnt vmcnt(0)" ::: "memory");
        } else {
            XB_SPIN(xb_ld(&bar[XB_XGEN(b.x)]) == gen, bar);
            __builtin_amdgcn_fence(__ATOMIC_ACQUIRE, "agent");
            asm volatile("s_waitcnt vmcnt(0)" ::: "memory");
        }
    }
    __syncthreads();
}

namespace mix {
typedef float f32x16 __attribute__((ext_vector_type(16)));
typedef short s16x4 __attribute__((ext_vector_type(4)));
typedef short v4i16_t __attribute__((ext_vector_type(4)));
typedef LAS const char* lds_cptr;
constexpr int SLOTB = 8192, LDS_K = 0, LDS_V = 2 * SLOTB, LDS_QW = 4 * SLOTB, LDS_QF = 4 * SLOTB + 1024;
constexpr int N_DIFF = 24 * 16, N_RET = 16, N_ITEMS = N_DIFF + N_RET;
__device__ __forceinline__ int crow(int r, int hi) { return (r & 3) + 8 * (r >> 2) + 4 * hi; }
__device__ __forceinline__ int imax(int a, int b) { return a > b ? a : b; }
__device__ __forceinline__ void glds16(const void* g, unsigned lds_base) { unsigned sv; asm volatile("s_mov_b32 %0, m0\n\ts_mov_b32 m0, %2\n\ts_nop 0\n\tglobal_load_lds_dwordx4 %1, off\n\ts_mov_b32 m0, %0" : "=&s"(sv) : "v"(g), "s"(lds_base) : "memory"); }
__device__ __forceinline__ s16x4 vtr(lds_cptr p) { return __builtin_bit_cast(s16x4, __builtin_amdgcn_ds_read_tr16_b64_v4i16((LAS v4i16_t*)p)); }
#define MFMA32(a, b, c) __builtin_amdgcn_mfma_f32_32x32x16_bf16(a, b, c, 0, 0, 0)
#define MFMA16(a, b, c) __builtin_amdgcn_mfma_f32_16x16x32_bf16(a, b, c, 0, 0, 0)

struct ItemTab { unsigned short v[N_ITEMS]; };
constexpr ItemTab make_items() {
    ItemTab t{}; int n = 0;
    for (int bh = 0; bh < 16; ++bh) t.v[n++] = (unsigned short)(0x8000 | bh);
    for (int qb = 15; qb >= 0; --qb) for (int bh = 0; bh < 24; ++bh) t.v[n++] = (unsigned short)((qb << 8) | bh);
    return t;
}
__device__ const ItemTab g_items = make_items();

template <int MODE>
__device__ __forceinline__ void attn_unit(int b, int h, int qb, const bf16_t* PROJ, bf16_t* Y, LAS unsigned char* lds, float lam, float lam_init, const float* subg) {
    int tid_ = threadIdx.x; asm volatile("" : "+v"(tid_));
    const int tid = tid_, lane = tid & 63, r32 = lane & 31, hi = lane >> 5; const int wid = __builtin_amdgcn_readfirstlane(tid >> 6);
    constexpr int CQ = MODE == 0 ? C_DQ : C_TQ, CK = MODE == 0 ? C_DK : C_TK, CV = MODE == 0 ? C_DV : C_TV;
    const size_t rowbase = (size_t)b * T; const int q0 = qb * 256, NT = 4 * (qb + 1), my_last = 4 * qb + (wid >> 1);
    const bf16_t* Qw = PROJ + (rowbase + q0 + wid * 32) * NINP + CQ + 64 * h;
    const bf16_t* ksrc = PROJ + (rowbase + lane) * NINP + CK + 64 * h + wid * 8;
    const bf16_t* vsrc = PROJ + (rowbase + 16 * (wid & 3) + (lane >> 2)) * NINP + CV + 64 * h + (wid >> 2) * 32 + (lane & 3) * 8;
    const unsigned lds0 = (unsigned)(uintptr_t)lds;
    const unsigned kdst = lds0 + LDS_K + wid * 1024, vdst = lds0 + LDS_V + wid * 1024;
    const lds_cptr kp0 = (lds_cptr)lds + LDS_K + hi * 1024 + r32 * 16;
    const lds_cptr vp0 = (lds_cptr)lds + LDS_V + ((lane >> 4) & 1) * 32 + (lane & 3) * 8 + (4 * hi + ((lane & 15) >> 2)) * 64;
#define DMA_K(t, slot) glds16(ksrc + (size_t)(t) * 64 * NINP, (unsigned)__builtin_amdgcn_readfirstlane(kdst + (slot)))
#define DMA_V(t, slot) glds16(vsrc + (size_t)(t) * 64 * NINP, (unsigned)__builtin_amdgcn_readfirstlane(vdst + (slot)))
    DMA_K(0, 0); DMA_V(0, 0);
#pragma unroll
    for (int p = 0; p < 4; ++p) glds16(Qw + (size_t)(lane & 31) * NINP + (2 * p + (lane >> 5)) * 8, (unsigned)__builtin_amdgcn_readfirstlane(lds0 + LDS_QF + wid * 4096 + p * 1024));
    const lds_cptr qp0 = (lds_cptr)lds + LDS_QF + wid * 4096 + hi * 512 + r32 * 16;
    f32x16 oA[2], oB[2];
    oA[0] = f32x16{}; oA[1] = f32x16{}; oB[0] = f32x16{}; oB[1] = f32x16{};
    float mref = 0.f, lA = 0.f, lB = 0.f; f32x16 nm = f32x16{};
    const int qabs = q0 + wid * 32 + r32;
    const float lg2 = lg2gamma(h);
    for (int t = 0; t < NT; ++t) {
        asm volatile("s_waitcnt vmcnt(0) lgkmcnt(0)\n\ts_barrier" ::: "memory");
        const int sl = (t & 1) * SLOTB;
        if (t + 1 < NT) { DMA_K(t + 1, SLOTB - sl); DMA_V(t + 1, SLOTB - sl); }
        if (t <= my_last) {
            bf16x8 kf[8], vf[8], qr[4];
#pragma unroll
            for (int d0 = 0; d0 < 4; ++d0) { qr[d0] = *(const LAS bf16x8*)(qp0 + d0 * 1024); kf[2 * d0] = *(const LAS bf16x8*)(kp0 + sl + d0 * 2048); kf[2 * d0 + 1] = *(const LAS bf16x8*)(kp0 + sl + d0 * 2048 + 512); }
#define LOAD_VF() do { _Pragma("unroll") for (int i = 0; i < 8; ++i) { const s16x4 lo = vtr(vp0 + sl + (i >> 2) * 4096 + (i & 3) * 1024), hh = vtr(vp0 + sl + (i >> 2) * 4096 + (i & 3) * 1024 + 512); \
                vf[i] = (bf16x8){lo[0], lo[1], lo[2], lo[3], hh[0], hh[1], hh[2], hh[3]}; } } while (0)
            const bool diag = (t == my_last);
            const int kv0 = 64 * t + 4 * hi;
            const f32x16 z16 = f32x16{};
            if constexpr (MODE == 0) {
                f32x16 paA = MFMA32(kf[0], qr[0], nm); paA = MFMA32(kf[2], qr[1], paA);
                f32x16 pbA = MFMA32(kf[1], qr[0], nm); pbA = MFMA32(kf[3], qr[1], pbA);
                f32x16 paB = MFMA32(kf[4], qr[2], nm); paB = MFMA32(kf[6], qr[3], paB);
                f32x16 pbB = MFMA32(kf[5], qr[2], nm); pbB = MFMA32(kf[7], qr[3], pbB);
                if ((t & 7) == 0) {
                int ti = imax(imax(__float_as_int(paA[0]), __float_as_int(pbA[0])), imax(__float_as_int(paB[0]), __float_as_int(pbB[0])));
#pragma unroll
                for (int r = 1; r < 16; ++r) ti = imax(imax(ti, imax(__float_as_int(paA[r]), __float_as_int(pbA[r]))), imax(__float_as_int(paB[r]), __float_as_int(pbB[r])));
                ti = imax_x32(ti);
                if (t == 0 || __any(ti > 0x41000000)) {
                    const float tmf = __int_as_float(ti); const float dl = (t == 0) ? tmf : fmaxf(tmf, 0.f); mref += dl;
#pragma unroll
                    for (int r = 0; r < 16; ++r) { paA[r] -= dl; pbA[r] -= dl; paB[r] -= dl; pbB[r] -= dl; nm[r] = -mref; }
                    if (t > 0) { const float f = __builtin_amdgcn_exp2f(-dl); lA *= f; lB *= f; oA[0] = oA[0] * f; oA[1] = oA[1] * f; oB[0] = oB[0] * f; oB[1] = oB[1] * f; } }
                }
                if (diag) {
#pragma unroll
                    for (int r = 0; r < 16; ++r) { const int kv = kv0 + (r & 3) + 8 * (r >> 2); if (kv > qabs) { paA[r] = -1e30f; paB[r] = -1e30f; } if (kv + 32 > qabs) { pbA[r] = -1e30f; pbB[r] = -1e30f; } } }
#define EXP_PACK(pa, pb, L_, pf) do { \
                float rs0 = 0.f, rs1 = 0.f; \
                _Pragma("unroll") for (int r = 0; r < 16; ++r) { pa[r] = __builtin_amdgcn_exp2f(pa[r]); pb[r] = __builtin_amdgcn_exp2f(pb[r]); rs0 += pa[r]; rs1 += pb[r]; } \
                L_ += rs0 + rs1; \
                PROBE_EXTRA_EXP(pa, pb); \
                _Pragma("unroll") for (int s = 0; s < 2; ++s) { \
                    u32x4 w0, w1; \
                    w0.x = pk2(pa[8 * s + 0], pa[8 * s + 1]); w0.y = pk2(pa[8 * s + 2], pa[8 * s + 3]); w0.z = pk2(pa[8 * s + 4], pa[8 * s + 5]); w0.w = pk2(pa[8 * s + 6], pa[8 * s + 7]); \
                    w1.x = pk2(pb[8 * s + 0], pb[8 * s + 1]); w1.y = pk2(pb[8 * s + 2], pb[8 * s + 3]); w1.z = pk2(pb[8 * s + 4], pb[8 * s + 5]); w1.w = pk2(pb[8 * s + 6], pb[8 * s + 7]); \
                    pf[s] = __builtin_bit_cast(bf16x8, w0); pf[2 + s] = __builtin_bit_cast(bf16x8, w1); } } while (0)
#define PV_ACC(O, pf) do { _Pragma("unroll") for (int dh = 0; dh < 2; ++dh) _Pragma("unroll") for (int s = 0; s < 4; ++s) O[dh] = MFMA32(vf[4 * dh + s], pf[s], O[dh]); } while (0)
                __builtin_amdgcn_sched_barrier(0);
                LOAD_VF();
                bf16x8 pfA[4], pfB[4];
                EXP_PACK(paA, pbA, lA, pfA);
                __builtin_amdgcn_sched_barrier(0);
                PV_ACC(oA, pfA);
                EXP_PACK(paB, pbB, lB, pfB);
#pragma unroll
                for (int i = 0; i < 8; ++i) { __builtin_amdgcn_sched_group_barrier(0x008, 1, 0); __builtin_amdgcn_sched_group_barrier(0x402, 10, 0); }
                __builtin_amdgcn_sched_barrier(0);
                PV_ACC(oB, pfB);
#undef EXP_PACK
#undef PV_ACC
            } else {
                f32x16 pa = MFMA32(kf[0], qr[0], z16), pb = MFMA32(kf[1], qr[0], z16);
#pragma unroll
                for (int d0 = 1; d0 < 4; ++d0) { pa = MFMA32(kf[2 * d0], qr[d0], pa); pb = MFMA32(kf[2 * d0 + 1], qr[d0], pb); }
                const int qt = (q0 + wid * 32) >> 6;
                const float tf = __builtin_amdgcn_exp2f(64.0f * (float)(qt - t) * lg2);
#pragma unroll
                for (int r = 0; r < 16; ++r) { pa[r] *= tf; pb[r] *= tf; }
                if (diag) {
#pragma unroll
                    for (int r = 0; r < 16; ++r) { const int kv = kv0 + (r & 3) + 8 * (r >> 2); if (kv > qabs) pa[r] = 0.f; if (kv + 32 > qabs) pb[r] = 0.f; } }
                LOAD_VF();
                bf16x8 pf[4];
#pragma unroll
                for (int s = 0; s < 2; ++s) {
                    u32x4 w0, w1;
                    w0.x = pk2(pa[8 * s + 0], pa[8 * s + 1]); w0.y = pk2(pa[8 * s + 2], pa[8 * s + 3]); w0.z = pk2(pa[8 * s + 4], pa[8 * s + 5]); w0.w = pk2(pa[8 * s + 6], pa[8 * s + 7]);
                    w1.x = pk2(pb[8 * s + 0], pb[8 * s + 1]); w1.y = pk2(pb[8 * s + 2], pb[8 * s + 3]); w1.z = pk2(pb[8 * s + 4], pb[8 * s + 5]); w1.w = pk2(pb[8 * s + 6], pb[8 * s + 7]);
                    pf[s] = __builtin_bit_cast(bf16x8, w0); pf[2 + s] = __builtin_bit_cast(bf16x8, w1); }
#pragma unroll
                for (int dh = 0; dh < 2; ++dh)
#pragma unroll
                    for (int s = 0; s < 4; ++s) oA[dh] = MFMA32(vf[4 * dh + s], pf[s], oA[dh]);
            }
        }
    }
#undef DMA_K
#undef DMA_V
#undef LOAD_VF
    const size_t mrow = rowbase + qabs;
    if constexpr (MODE == 0) {
        lA = sum_x32(lA); lB = sum_x32(lB);
        const float rA = 1.0f / lA, rB = lam / lB;
        float ss = 0.f;
#pragma unroll
        for (int dh = 0; dh < 2; ++dh)
#pragma unroll
            for (int r = 0; r < 16; ++r) { const float v = oA[dh][r] * rA - oB[dh][r] * rB; oA[dh][r] = v; ss += v * v; }
        ss = sum_x32(ss);
        float li_ = lam_init; asm volatile("" : "+v"(li_));
        const float rn = (1.0f / sqrtf(ss * (1.f / 64.f) + EPS)) * (1.0f - li_);
#pragma unroll
        for (int dh = 0; dh < 2; ++dh)
#pragma unroll
            for (int g = 0; g < 4; ++g) { const int d = 32 * dh + 8 * g + 4 * hi; const f32x4 sg = *(const f32x4*)(subg + d);
                u32x2 w; w.x = pk2(oA[dh][4 * g] * rn * sg[0], oA[dh][4 * g + 1] * rn * sg[1]); w.y = pk2(oA[dh][4 * g + 2] * rn * sg[2], oA[dh][4 * g + 3] * rn * sg[3]);
                *(u32x2*)(Y + mrow * D + RW + 64 * h + d) = w; }
    } else {
        float ss = 0.f;
#pragma unroll
        for (int dh = 0; dh < 2; ++dh)
#pragma unroll
            for (int r = 0; r < 16; ++r) ss += oA[dh][r] * oA[dh][r];
        ss = sum_x32(ss);
        const float rn = 1.0f / sqrtf(ss * (1.f / 64.f) + EPS);
#pragma unroll
        for (int dh = 0; dh < 2; ++dh)
#pragma unroll
            for (int g = 0; g < 4; ++g) { const int d = 32 * dh + 8 * g + 4 * hi; const u32x2 tg = *(const u32x2*)(PROJ + mrow * NINP + C_TG + 64 * h + d);
                u32x2 w; w.x = pk2(siluf_(bflo(tg.x)) * oA[dh][4 * g] * rn, siluf_(bfhi(tg.x)) * oA[dh][4 * g + 1] * rn); w.y = pk2(siluf_(bflo(tg.y)) * oA[dh][4 * g + 2] * rn, siluf_(bfhi(tg.y)) * oA[dh][4 * g + 3] * rn);
                *(u32x2*)(Y + mrow * D + 768 + 64 * h + d) = w; }
    }
}

namespace rseq { constexpr int SLOT = 40960, KB_ = 0, KT_ = 8192, VT_ = 16384, QB_ = 24576, TG_ = 32768, RS_ = 139264, RSB = 8192; }
__device__ __forceinline__ void ret_seq(int b, int h, const bf16_t* PROJ, bf16_t* Y, LAS unsigned char* lds) {
    using namespace rseq;
    int tid_ = threadIdx.x; asm volatile("" : "+v"(tid_));
    const int tid = tid_, lane = tid & 63, r32 = lane & 31, hi = lane >> 5; const int wid = __builtin_amdgcn_readfirstlane(tid >> 6);
    const size_t rowbase = (size_t)b * T;
    const unsigned lds0 = (unsigned)(uintptr_t)lds;
    const bf16_t* kb_src = PROJ + (rowbase + lane) * NINP + C_TK + 64 * h + wid * 8;
    const bf16_t* qb_src = PROJ + (rowbase + lane) * NINP + C_TQ + 64 * h + wid * 8;
    const size_t tr_off = (size_t)(16 * (wid & 3) + (lane >> 2)) * NINP + (wid >> 2) * 32 + (lane & 3) * 8;
    const bf16_t* kt_src = PROJ + rowbase * NINP + C_TK + 64 * h + tr_off;
    const bf16_t* vt_src = PROJ + rowbase * NINP + C_TV + 64 * h + tr_off;
    const bf16_t* tg_src = PROJ + (rowbase + 8 * wid + (lane >> 3)) * NINP + C_TG + 64 * h + (lane & 7) * 8;
#define RS_DMA(blk, slot_) do { const size_t go_ = (size_t)(blk) * 64 * NINP; const unsigned d_ = lds0 + (slot_) * SLOT + wid * 1024; \
        glds16(kb_src + go_, (unsigned)__builtin_amdgcn_readfirstlane(d_ + KB_)); glds16(kt_src + go_, (unsigned)__builtin_amdgcn_readfirstlane(d_ + KT_)); \
        glds16(vt_src + go_, (unsigned)__builtin_amdgcn_readfirstlane(d_ + VT_)); glds16(qb_src + go_, (unsigned)__builtin_amdgcn_readfirstlane(d_ + QB_)); \
        glds16(tg_src + go_, (unsigned)__builtin_amdgcn_readfirstlane(d_ + TG_)); } while (0)
    RS_DMA(0, 0); RS_DMA(1, 1);
    { unsigned z = 0u; asm volatile("" : "+v"(z)); for (int i = tid; i < RSB / 16; i += 512) ((LAS u32x4*)(lds + RS_))[i] = (u32x4){z, z, z, z}; }
    const int qh = wid & 1;
    const int dvh = (wid >> 1) & 1, dkh = wid & 1;
    f32x16 Rq = f32x16{};
    const float g64 = __builtin_amdgcn_exp2f(64.0f * lg2gamma(h));
    const lds_cptr trb = (lds_cptr)lds + ((lane >> 4) & 1) * 32 + (lane & 3) * 8 + (4 * hi + ((lane & 15) >> 2)) * 64;
    for (int i = 0; i < T / 64; ++i) {
        if (i + 1 < T / 64) { if (wid < 2 && i > 0) asm volatile("s_waitcnt vmcnt(13) lgkmcnt(0)\n\ts_barrier" ::: "memory"); else asm volatile("s_waitcnt vmcnt(5) lgkmcnt(0)\n\ts_barrier" ::: "memory"); }
        else asm volatile("s_waitcnt vmcnt(0) lgkmcnt(0)\n\ts_barrier" ::: "memory");
        const int sl = (i % 3) * SLOT, rb = (i & 1) * RSB;
        if (i + 2 < T / 64) RS_DMA(i + 2, (i + 2) % 3);
        if (wid < 2) {
            bf16x8 kf[8], qr[4];
#pragma unroll
            for (int d0 = 0; d0 < 4; ++d0) { qr[d0] = *(const LAS bf16x8*)((lds_cptr)lds + sl + QB_ + (2 * d0 + hi) * 1024 + (32 * qh + r32) * 16);
                kf[2 * d0] = *(const LAS bf16x8*)((lds_cptr)lds + sl + KB_ + (2 * d0 + hi) * 1024 + r32 * 16); kf[2 * d0 + 1] = *(const LAS bf16x8*)((lds_cptr)lds + sl + KB_ + (2 * d0 + hi) * 1024 + 512 + r32 * 16); }
            const f32x16 z16 = f32x16{};
            f32x16 pa = MFMA32(kf[0], qr[0], z16), pb = z16;
#pragma unroll
            for (int d0 = 1; d0 < 4; ++d0) pa = MFMA32(kf[2 * d0], qr[d0], pa);
            if (qh) {
#pragma unroll
                for (int d0 = 0; d0 < 4; ++d0) pb = MFMA32(kf[2 * d0 + 1], qr[d0], pb); }
#pragma unroll
            for (int r = 0; r < 16; ++r) { const int kv = (r & 3) + 8 * (r >> 2) + 4 * hi;
                if (qh == 0) { if (kv > r32) pa[r] = 0.f; }
                else { if (kv > r32) pb[r] = 0.f; } }
            bf16x8 pf[4];
#pragma unroll
            for (int s = 0; s < 2; ++s) { u32x4 w0, w1;
                w0.x = pk2(pa[8 * s + 0], pa[8 * s + 1]); w0.y = pk2(pa[8 * s + 2], pa[8 * s + 3]); w0.z = pk2(pa[8 * s + 4], pa[8 * s + 5]); w0.w = pk2(pa[8 * s + 6], pa[8 * s + 7]);
                w1.x = pk2(pb[8 * s + 0], pb[8 * s + 1]); w1.y = pk2(pb[8 * s + 2], pb[8 * s + 3]); w1.z = pk2(pb[8 * s + 4], pb[8 * s + 5]); w1.w = pk2(pb[8 * s + 6], pb[8 * s + 7]);
                pf[s] = __builtin_bit_cast(bf16x8, w0); pf[2 + s] = __builtin_bit_cast(bf16x8, w1); }
            f32x16 o[2]; o[0] = z16; o[1] = z16;
#pragma unroll
            for (int dh = 0; dh < 2; ++dh)
#pragma unroll
                for (int s = 0; s < 4; ++s) {
                    if (s < 2 || qh) { const s16x4 lo = vtr(trb + sl + VT_ + dh * 4096 + s * 1024), hh = vtr(trb + sl + VT_ + dh * 4096 + s * 1024 + 512);
                        o[dh] = MFMA32(((bf16x8){lo[0], lo[1], lo[2], lo[3], hh[0], hh[1], hh[2], hh[3]}), pf[s], o[dh]); }
                    const bf16x8 rf = *(const LAS bf16x8*)((lds_cptr)lds + RS_ + rb + (2 * s + hi) * 1024 + (32 * dh + r32) * 16);
                    o[dh] = MFMA32(rf, qr[s], o[dh]); }
            const size_t mrow = rowbase + (size_t)i * 64 + 32 * qh + r32;
            float ss = 0.f;
#pragma unroll
            for (int dh = 0; dh < 2; ++dh)
#pragma unroll
                for (int r = 0; r < 16; ++r) ss += o[dh][r] * o[dh][r];
            ss = sum_x32(ss);
            const float rn = 1.0f / sqrtf(ss * (1.f / 64.f) + EPS);
#pragma unroll
            for (int dh = 0; dh < 2; ++dh)
#pragma unroll
                for (int g = 0; g < 4; ++g) { const int d = 32 * dh + 8 * g + 4 * hi; const u32x2 tg = *(const LAS u32x2*)((lds_cptr)lds + sl + TG_ + (32 * qh + r32) * 128 + d * 2);
                    u32x2 w; w.x = pk2(siluf_(bflo(tg.x)) * o[dh][4 * g] * rn, siluf_(bfhi(tg.x)) * o[dh][4 * g + 1] * rn); w.y = pk2(siluf_(bflo(tg.y)) * o[dh][4 * g + 2] * rn, siluf_(bfhi(tg.y)) * o[dh][4 * g + 3] * rn);
                    *(u32x2*)(Y + mrow * D + 768 + 64 * h + d) = w; }
        } else if (wid >= 4) {
#pragma unroll
            for (int s = 0; s < 4; ++s) {
                const s16x4 vl = vtr(trb + sl + VT_ + dvh * 4096 + s * 1024), vh = vtr(trb + sl + VT_ + dvh * 4096 + s * 1024 + 512);
                const s16x4 kl = vtr(trb + sl + KT_ + dkh * 4096 + s * 1024), kh = vtr(trb + sl + KT_ + dkh * 4096 + s * 1024 + 512);
                Rq = MFMA32(((bf16x8){vl[0], vl[1], vl[2], vl[3], vh[0], vh[1], vh[2], vh[3]}), ((bf16x8){kl[0], kl[1], kl[2], kl[3], kh[0], kh[1], kh[2], kh[3]}), Rq); }
            Rq = Rq * g64;
            LAS bf16_t* rs = (LAS bf16_t*)(lds + RS_ + (RSB - rb));
            const int dk = 32 * dkh + r32;
#pragma unroll
            for (int r = 0; r < 16; ++r) { const int dv = 32 * dvh + (r & 3) + 8 * (r >> 2) + 4 * hi; rs[(dk >> 3) * 512 + dv * 8 + (dk & 7)] = (bf16_t)(pk2(Rq[r], 0.f) & 0xffffu); }
        }
    }
    asm volatile("s_waitcnt lgkmcnt(0)\n\ts_barrier" ::: "memory");
#undef RS_DMA
}

__device__ __forceinline__ float em1(float x) {
    if (x > -0.25f) { float p = 1.f / 720.f; p = p * x + 1.f / 120.f; p = p * x + 1.f / 24.f; p = p * x + 1.f / 6.f; p = p * x + 0.5f; p = p * x + 1.f; return p * x; }
    return expm1f(x);
}
template <int DD> __device__ __forceinline__ float dpp_shr(float v) { return __int_as_float(__builtin_amdgcn_update_dpp(__float_as_int(v), __float_as_int(v), 0x110 + DD, 0xF, 0xF, false)); }
template <int DD> __device__ __forceinline__ f32x4 shup4(f32x4 v) { f32x4 r; r[0] = dpp_shr<DD>(v[0]); r[1] = dpp_shr<DD>(v[1]); r[2] = dpp_shr<DD>(v[2]); r[3] = dpp_shr<DD>(v[3]); return r; }
__device__ __forceinline__ float bc15f(float v) { return __int_as_float(__builtin_amdgcn_ds_swizzle(__float_as_int(v), (0x0F << 5) | 0x10)); }
__device__ __forceinline__ f32x4 bc15(f32x4 v) { f32x4 r; r[0] = bc15f(v[0]); r[1] = bc15f(v[1]); r[2] = bc15f(v[2]); r[3] = bc15f(v[3]); return r; }
template <int PASS>
__device__ __forceinline__ void rglru_item(int wi, const bf16_t* PROJ, const bf16_t* GWl, const float* SP8l, const float* cw, const float* cb, const float* ba, const float* bx, float* AGGA, float* AGGB, bf16_t* Y, int lane_in) {
    int lane = lane_in; asm volatile("" : "+v"(lane));
    const int fr = lane & 15, fq = lane >> 4;
    const int h = wi % 6, chunk = (wi / 6) & 63, b = wi / 384;
    const long m0 = (long)b * T + chunk * 64;
    const int chb = 64 * h + 4 * fq;
    bf16x8 wf[2][4][2];
#pragma unroll
    for (int g = 0; g < 2; ++g)
#pragma unroll
        for (int nbo = 0; nbo < 4; ++nbo)
#pragma unroll
            for (int ks = 0; ks < 2; ++ks) { const bf16_t* p = GWl + (((size_t)g * 6 + h) * 64 + 16 * nbo + fr) * 64 + 32 * ks + 4 * fq; const u32x2 lo = *(const u32x2*)p, hi2 = *(const u32x2*)(p + 16);
                wf[g][nbo][ks] = __builtin_bit_cast(bf16x8, (u32x4){lo.x, lo.y, hi2.x, hi2.y}); }
    f32x4 bav[4], bxv[4], spv[4], hc[4], At[4];
#pragma unroll
    for (int nb = 0; nb < 4; ++nb) { bav[nb] = *(const f32x4*)(ba + chb + 16 * nb); bxv[nb] = *(const f32x4*)(bx + chb + 16 * nb); spv[nb] = *(const f32x4*)(SP8l + chb + 16 * nb);
        hc[nb] = (f32x4){0.f, 0.f, 0.f, 0.f}; At[nb] = (f32x4){1.f, 1.f, 1.f, 1.f}; }
#define KS_STEP(DD, A_, B_) do { const f32x4 As = shup4<DD>(A_), Bs = shup4<DD>(B_); if (fr >= DD) { B_ = A_ * Bs + B_; A_ = A_ * As; } } while (0)
    if constexpr (PASS == 2) {
        f32x4 FA[4], FB[4];
#pragma unroll
        for (int nb = 0; nb < 4; ++nb) { FA[nb] = (f32x4){1.f, 1.f, 1.f, 1.f}; FB[nb] = (f32x4){0.f, 0.f, 0.f, 0.f}; }
#pragma unroll
        for (int k = 0; k < 4; ++k) { const int ci = 4 * fr + k;
            if (ci < chunk) {
#pragma unroll
                for (int nb = 0; nb < 4; ++nb) { const size_t o = ((size_t)(b * 64 + ci)) * RW + chb + 16 * nb; const f32x4 a = *(const f32x4*)(AGGA + o), bb = *(const f32x4*)(AGGB + o);
                    FB[nb] = a * FB[nb] + bb; FA[nb] = a * FA[nb]; } } }
#pragma unroll
        for (int nb = 0; nb < 4; ++nb) { KS_STEP(1, FA[nb], FB[nb]); KS_STEP(2, FA[nb], FB[nb]); KS_STEP(4, FA[nb], FB[nb]); KS_STEP(8, FA[nb], FB[nb]); }
#pragma unroll
        for (int nb = 0; nb < 4; ++nb) hc[nb] = bc15(FB[nb]);
    }
#pragma unroll 1
    for (int mb = 0; mb < 4; ++mb) {
        const int tl = 16 * mb + fr;
        f32x4 xc[4];
#pragma unroll
        for (int nb = 0; nb < 4; ++nb) { f32x4 acc = *(const f32x4*)(cb + chb + 16 * nb);
#pragma unroll
            for (int j = 0; j < 4; ++j) { const int tj = tl - 3 + j;
                if (chunk > 0 || tj >= 0) { const u32x2 w = *(const u32x2*)(PROJ + (size_t)(m0 + tj) * NINP + C_RX + chb + 16 * nb); const f32x4 cwv = *(const f32x4*)(cw + j * RW + chb + 16 * nb);
                    acc += cwv * (f32x4){bflo(w.x), bfhi(w.x), bflo(w.y), bfhi(w.y)}; } }
            xc[nb] = acc; }
        bf16x8 bfr[2];
#pragma unroll
        for (int ks = 0; ks < 2; ++ks) { u32x4 w; w.x = pk2(xc[2 * ks][0], xc[2 * ks][1]); w.y = pk2(xc[2 * ks][2], xc[2 * ks][3]); w.z = pk2(xc[2 * ks + 1][0], xc[2 * ks + 1][1]); w.w = pk2(xc[2 * ks + 1][2], xc[2 * ks + 1][3]);
            bfr[ks] = __builtin_bit_cast(bf16x8, w); }
#pragma unroll
        for (int nb = 0; nb < 4; ++nb) {
            f32x4 ra = bav[nb], ia = bxv[nb];
#pragma unroll
            for (int ks = 0; ks < 2; ++ks) { ra = MFMA16(wf[0][nb][ks], bfr[ks], ra); ia = MFMA16(wf[1][nb][ks], bfr[ks], ia); }
            f32x4 A, B;
#pragma unroll
            for (int r = 0; r < 4; ++r) { const float rg = sigmoidf_(ra[r]), ig = sigmoidf_(ia[r]); const float la = spv[nb][r] * rg;
                A[r] = 1.0f + em1(la); B[r] = sqrtf(-em1(2.0f * la)) * ig * xc[nb][r]; }
            KS_STEP(1, A, B); KS_STEP(2, A, B); KS_STEP(4, A, B); KS_STEP(8, A, B);
            const f32x4 hv = B + A * hc[nb];
            hc[nb] = bc15(hv);
            if constexpr (PASS == 1) { At[nb] = At[nb] * bc15(A); }
            else { const size_t mr = (size_t)(m0 + tl); const u32x2 gw = *(const u32x2*)(PROJ + mr * NINP + C_RG + chb + 16 * nb);
                u32x2 w; w.x = pk2(gelu_tanh(bflo(gw.x)) * hv[0], gelu_tanh(bfhi(gw.x)) * hv[1]); w.y = pk2(gelu_tanh(bflo(gw.y)) * hv[2], gelu_tanh(bfhi(gw.y)) * hv[3]);
                *(u32x2*)(Y + mr * D + chb + 16 * nb) = w; }
        }
    }
    if constexpr (PASS == 1) {
        if (fr == 15) {
#pragma unroll
            for (int nb = 0; nb < 4; ++nb) { const size_t o = ((size_t)(b * 64 + chunk)) * RW + chb + 16 * nb; *(f32x4*)(AGGA + o) = At[nb]; *(f32x4*)(AGGB + o) = hc[nb]; } }
    }
}
#undef KS_STEP
#undef MFMA32
#undef MFMA16
}

constexpr int NWAVES = 8;
struct Args { const float* in[27]; const int* pos; float* out; unsigned char* ws; float lam_init[4]; int ph_lo, ph_hi, li, pad; };
constexpr int PH_L0 = 3, NPH = 8, PH_FINAL = PH_L0 + NL * NPH, PH_END = PH_FINAL + 1;

struct Frame { LAS unsigned char* lds; int wave, vcu, G, gw, NGW; };

template <class Map>
__device__ __forceinline__ void transpose_item(const float* W, int K, int Nsrc, bf16_t* WT, int NT, LAS float* scr, int item, int lane, Map src, bool tiled = false) {
    const int nblk = NT / 32, kb = item / nblk, nb = item % nblk, k0 = 64 * kb, n0 = 32 * nb;
    const int sc = src(n0 + (lane & 31));
    float wv_[32];
#pragma unroll
    for (int i = 0; i < 32; ++i) { const int kk = 2 * i + (lane >> 5); wv_[i] = sc >= 0 ? __builtin_nontemporal_load(W + (size_t)(k0 + kk) * Nsrc + sc) : 0.f; }
#pragma unroll
    for (int i = 0; i < 32; ++i) { const int kk = 2 * i + (lane >> 5); scr[kk * 33 + (lane & 31)] = wv_[i]; }
    LDS_WAIT(); asm volatile("" ::: "memory");
    const int c = lane & 7;
#pragma unroll
    for (int j = 0; j < 4; ++j) { const int n = (lane >> 3) + 8 * j; const LAS float* s = scr + (8 * c) * 33 + n;
        u32x4 o; o.x = pk2(s[0 * 33], s[1 * 33]); o.y = pk2(s[2 * 33], s[3 * 33]); o.z = pk2(s[4 * 33], s[5 * 33]); o.w = pk2(s[6 * 33], s[7 * 33]);
        const size_t off = tiled ? (((size_t)((n0 + n) >> 8) * (K / 64) + kb) * 256 + ((n0 + n) & 255)) * 64 + 8 * c : (size_t)(n0 + n) * K + k0 + 8 * c;
        *(GAS u32x4*)(WT + off) = o; }
    LDS_WAIT(); asm volatile("" ::: "memory");
}
struct MapId { __device__ __forceinline__ int operator()(int n) const { return n; } };
struct MapFfnIn { __device__ __forceinline__ int operator()(int n) const { const int pn = n >> 8, bj = (n >> 7) & 1, cc = n & 127; return bj * F + pn * 128 + cc; } };
__device__ __forceinline__ int ret_dim(int pos) { const int w = pos >> 5, rem = pos & 31, fq = rem >> 3, n = (rem >> 2) & 1, j = rem & 3; return 32 * n + 16 * w + 4 * fq + j; }
struct MapMixIn { __device__ __forceinline__ int operator()(int p) const {
    if (p < C_DK) return 768 + p;
    if (p < C_TQ) return 1152 + (p - C_DK);
    if (p < C_TK) { const int q = p - C_TQ; return 1920 + (q & ~63) + ret_dim(q & 63); }
    if (p < C_DV) { const int q = p - C_TK; return 2176 + (q & ~63) + ret_dim(q & 63); }
    if (p < C_TV) return 1536 + (p - C_DV);
    if (p < C_TG) return 2432 + (p - C_TV);
    if (p < C_RX) return 2688 + (p - C_TG);
    if (p < C_RG) return p - C_RX;
    if (p < NIN) return 384 + (p - C_RG);
    return -1; } };

constexpr int I_FI = (D / 64) * (2 * F / 32), I_FO = (F / 64) * (D / 32), I_MI = (D / 64) * (NINP / 32), I_MO = (D / 64) * (D / 32), CONV_ITEMS_L = 2 * I_FI + 2 * I_FO + I_MI + I_MO;
constexpr int CONV_WG_ITEMS = (CONV_ITEMS_L + NWAVES - 1) / NWAVES;
struct ConvSrc { const float *f1i, *f1o, *f2i, *f2o, *mi, *mo; };
__device__ __forceinline__ void conv_item(const ConvSrc cs, unsigned char* ws, int l, int r, LAS float* scr, int lane) {
    unsigned char* wl = ws + WS_W + (size_t)l * W_L;
    if (r < I_FI) { transpose_item(cs.f1i + (size_t)l * D * 2 * F, D, 2 * F, (bf16_t*)(wl + W_1IN), 2 * F, scr, r, lane, MapFfnIn()); return; } r -= I_FI;
    if (r < I_FI) { transpose_item(cs.f2i + (size_t)l * D * 2 * F, D, 2 * F, (bf16_t*)(wl + W_2IN), 2 * F, scr, r, lane, MapFfnIn()); return; } r -= I_FI;
    if (r < I_FO) { transpose_item(cs.f1o + (size_t)l * F * D, F, D, (bf16_t*)(wl + W_1OUT), D, scr, r, lane, MapId(), true); return; } r -= I_FO;
    if (r < I_FO) { transpose_item(cs.f2o + (size_t)l * F * D, F, D, (bf16_t*)(wl + W_2OUT), D, scr, r, lane, MapId(), true); return; } r -= I_FO;
    if (r < I_MI) { transpose_item(cs.mi + (size_t)l * D * NIN, D, NIN, (bf16_t*)(wl + W_IN), NINP, scr, r, lane, MapMixIn()); return; } r -= I_MI;
    transpose_item(cs.mo + (size_t)l * D * D, D, D, (bf16_t*)(wl + W_OUT), D, scr, r, lane, MapId());
}
__device__ __forceinline__ void bias_layer(unsigned char* ws, int l, int gw, int ngw, int lane) {
    const float* MOD = (const float*)(ws + WS_MOD); float* BIAS = (float*)(ws + WS_BIAS);
    for (int g = 0; g < 3; ++g) {
        const int lg = l * 3 + g; const int Nw = (g == 1) ? NINP : 2 * F;
        const bf16_t* Wt = (const bf16_t*)(ws + WS_W + (size_t)l * W_L + (g == 0 ? W_1IN : g == 1 ? W_IN : W_2IN));
        f32x4 Sv[4][4];
#pragma unroll
        for (int b = 0; b < 4; ++b)
#pragma unroll
            for (int q = 0; q < 4; ++q) Sv[b][q] = *(const f32x4*)(MOD + ((size_t)l * NB + b) * NMD + (3 * g) * D + 16 * lane + 4 * q);
        for (int n = gw; n < Nw; n += ngw) {
            const u32x4 w0 = *(const u32x4*)(Wt + (size_t)n * D + 16 * lane), w1 = *(const u32x4*)(Wt + (size_t)n * D + 16 * lane + 8);
            const f32x4 wv[4] = {{bflo(w0.x), bfhi(w0.x), bflo(w0.y), bfhi(w0.y)}, {bflo(w0.z), bfhi(w0.z), bflo(w0.w), bfhi(w0.w)}, {bflo(w1.x), bfhi(w1.x), bflo(w1.y), bfhi(w1.y)}, {bflo(w1.z), bfhi(w1.z), bflo(w1.w), bfhi(w1.w)}};
            float acc4[4];
#pragma unroll
            for (int b = 0; b < 4; ++b) { f32x4 a = Sv[b][0] * wv[0] + Sv[b][1] * wv[1] + Sv[b][2] * wv[2] + Sv[b][3] * wv[3]; acc4[b] = wave_sum((a[0] + a[1]) + (a[2] + a[3])); }
            if (lane < 4) BIAS[((size_t)lg * NB + lane) * (2 * F) + n] = lane == 0 ? acc4[0] : lane == 1 ? acc4[1] : lane == 2 ? acc4[2] : acc4[3];
        }
    }
}

__global__ void __launch_bounds__(NWAVES * 64, 2) mega(Args args) {
    Frame FR;
    FR.lds = (LAS unsigned char*)lds_raw;
    volatile LAS unsigned* MISC = (volatile LAS unsigned*)(FR.lds + MISC_OFF);
    FR.wave = __builtin_amdgcn_readfirstlane((int)threadIdx.x >> 6);
    FR.G = gridDim.x; { const int bx = blockIdx.x; FR.vcu = (FR.G % 8 == 0) ? (bx % 8) * (FR.G / 8) + bx / 8 : bx; }
    FR.gw = FR.vcu * NWAVES + FR.wave; FR.NGW = FR.G * NWAVES;
    unsigned char* ws = args.ws;
    gu32* ctl = (gu32*)(ws + WS_CTL);
    for (int u = (int)threadIdx.x; u < (LDS_BYTES - LDSCTL_OFF) / 4; u += NWAVES * 64) ((LAS unsigned*)(FR.lds + LDSCTL_OFF))[u] = 0u;
    __syncthreads();
    const int lo = args.ph_lo, hi = args.ph_hi;
    if (MK_ONE_LAUNCH || hi - lo > 1) (void)xcd_barrier_post((unsigned*)(ctl + CW_BAR) + args.li * XCD_BAR_WORDS, MISC + 8);
#define bar (XcdBarrier{(unsigned*)((gu32*)(args.ws + WS_CTL) + CW_BAR) + args.li * XCD_BAR_WORDS, xb_xcc_id(), (volatile LAS unsigned*)((LAS unsigned char*)lds_raw + MISC_OFF) + 8})
#if MK_ONE_LAUNCH
#define IN(k) true
#if PROBE_BAR2
#define SEAM(k) do { xcd_barrier(bar); xcd_barrier(bar); } while (0)
#else
#define SEAM(k) xcd_barrier(bar)
#endif
#else
#define IN(k) (lo <= (k) && (k) < hi)
#define SEAM(k) do { if (IN(k) && IN((k) + 1)) xcd_barrier(bar); } while (0)
#endif
    float* X = (float*)(ws + WS_X); bf16_t* H = (bf16_t*)(ws + WS_H); bf16_t* Y = (bf16_t*)(ws + WS_Y); bf16_t* ACT = (bf16_t*)(ws + WS_ACT); bf16_t* PROJ = (bf16_t*)(ws + WS_PROJ);
    float* MODP = (float*)(ws + WS_MODP); float* MOD = (float*)(ws + WS_MOD); float* TABD = (float*)(ws + WS_TABD); float* TABR = (float*)(ws + WS_TABR);

    float* ANORM = (float*)(ws + WS_ANORM); float* BIAS = (float*)(ws + WS_BIAS); float* SSQ = (float*)(ws + WS_SSQ); bf16_t* XS = H;
    for (int repp = 0; repp < PROBE_REPP; ++repp) {
    if (IN(0)) {
        for (int i = FR.gw * 64 + lane_id(); i < M * 36; i += FR.NGW * 64) {
            const int m = i / 36, f = i % 36; const float p = (float)args.pos[m];
            if (f < 4) { const float inv = powf(500000.0f, -0.25f * (float)f); float s, c; sincosf(p * (f == 0 ? 1.0f : inv), &s, &c); TABD[m * 8 + f] = c; TABD[m * 8 + 4 + f] = s; }
            else { const int g = f - 4; const float inv = powf(10000.0f, -(float)g * (2.0f / 64.0f)); float s, c; sincosf(p * inv, &s, &c); TABR[m * 64 + g] = c; TABR[m * 64 + 32 + g] = s; }
        }
        LAS float* sc = (LAS float*)(FR.lds + RING_OFF);
        for (int i = (int)threadIdx.x; i < NB * D; i += NWAVES * 64) sc[i] = siluf_(args.in[1][i]);
        __syncthreads();
        for (int it = FR.gw; it < NL * NKC * (NMD / 256); it += FR.NGW) {
            const int nb = it % (NMD / 256), kc = (it / (NMD / 256)) % NKC, l = it / ((NMD / 256) * NKC);
            const float* W = args.in[6] + ((size_t)l * D + kc * KC) * NMD + nb * 256 + lane_id() * 4;
            f32x4 a0 = {0, 0, 0, 0}, a1 = a0, a2 = a0, a3 = a0;
#pragma unroll 8
            for (int k = 0; k < KC; ++k) { const f32x4 w = __builtin_nontemporal_load((const GAS f32x4*)(W + (size_t)k * NMD)); const int kk = kc * KC + k;
                a0 += w * sc[kk]; a1 += w * sc[D + kk]; a2 += w * sc[2 * D + kk]; a3 += w * sc[3 * D + kk]; }
            float* P = MODP + ((size_t)(kc * NL + l) * NB) * NMD + nb * 256 + lane_id() * 4;
            *(f32x4*)(P) = a0; *(f32x4*)(P + NMD) = a1; *(f32x4*)(P + 2 * NMD) = a2; *(f32x4*)(P + 3 * NMD) = a3;
        }
        __syncthreads();
        { LAS float* scr = (LAS float*)(FR.lds + RING_OFF + FR.wave * 16384);
          for (int it = FR.gw; it < CONV_ITEMS_L; it += FR.NGW) conv_item(ConvSrc{args.in[8], args.in[9], args.in[10], args.in[11], args.in[12], args.in[13]}, ws, 0, it, scr, lane_id()); }
        __syncthreads();
    }
    SEAM(0);
    if (IN(1)) {
        for (int i = FR.gw * 64 + lane_id(); i < NL * NB * NMD; i += FR.NGW * 64) {
            const int l = i / (NB * NMD), b = (i / NMD) % NB, n = i % NMD; float s = args.in[7][l * NMD + n];
            for (int kc = 0; kc < NKC; ++kc) s += MODP[(size_t)kc * NL * NB * NMD + i];
            MOD[i] = s;
            const int part = n / D, k = n % D;
            if (part % 3 == 1) { const int j = part / 3; ANORM[(((size_t)l * 3 + j) * NB + b) * D + k] = args.in[3 + j][l * D + k] * (1.0f + s); } }
        { bf16_t* GW = (bf16_t*)(ws + WS_GW); float* SP8 = (float*)(ws + WS_SP8); float* LAMS = (float*)(ws + WS_LAMS);
          for (int i = FR.gw * 64 + lane_id(); i < NL * 2 * 6 * 64 * 64; i += FR.NGW * 64) { const int in_ = i & 63, out = (i >> 6) & 63, h = (i >> 12) % 6, g = ((i >> 12) / 6) & 1, l = (i >> 12) / 12;
              const float v = args.in[g ? 18 : 16][(((size_t)l * 6 + h) * 64 + in_) * 64 + out]; GW[i] = (bf16_t)(pk2(v, 0.f) & 0xffffu); }
          for (int i = FR.gw * 64 + lane_id(); i < NL * RW; i += FR.NGW * 64) SP8[i] = -8.0f * log1pf(expf(-args.in[20][i]));
          if (FR.gw < NL) { const int l = FR.gw; float s1 = 0.f, s2 = 0.f; if (lane_id() < 32) { s1 = args.in[21][l * 32 + lane_id()] * args.in[22][l * 32 + lane_id()]; s2 = args.in[23][l * 32 + lane_id()] * args.in[24][l * 32 + lane_id()]; }
              s1 = wave_sum(s1); s2 = wave_sum(s2); if (lane_id() == 0) LAMS[l] = expf(s1) - expf(s2) + args.lam_init[l]; } }
    }
    SEAM(1);
    if (IN(2)) {
        { const int b = FR.gw >> 9; const float* ap = ANORM + (size_t)b * D; f32x4 Av[4];
#pragma unroll
          for (int jj = 0; jj < 4; ++jj) Av[jj] = *(const f32x4*)(ap + 4 * lane_id() + 256 * jj);
          for (int rr = 0; rr < 8; ++rr) { const int m = FR.gw * 8 + rr; const GAS f32x4* xr = (const GAS f32x4*)(args.in[0] + (size_t)m * D) + lane_id(); f32x4 v[4]; float s2 = 0.f;
#pragma unroll
              for (int jj = 0; jj < 4; ++jj) { v[jj] = __builtin_nontemporal_load(xr + 64 * jj); s2 += (v[jj].x * v[jj].x + v[jj].y * v[jj].y) + (v[jj].z * v[jj].z + v[jj].w * v[jj].w); }
              s2 = wave_sum(s2);
              if (lane_id() < 16) SSQ[(size_t)m * 16 + lane_id()] = lane_id() == 0 ? s2 : 0.f;
              GAS u32x2* o8 = (GAS u32x2*)(XS + (size_t)m * D) + lane_id();
#pragma unroll
              for (int jj = 0; jj < 4; ++jj) { const f32x4 h = v[jj] * Av[jj]; u32x2 w; w.x = pk2(h.x, h.y); w.y = pk2(h.z, h.w); o8[64 * jj] = w;
                  u32x2 xw; xw.x = pkh2(v[jj].x, v[jj].y); xw.y = pkh2(v[jj].z, v[jj].w); ((GAS u32x2*)((bf16_t*)(ws + WS_X) + (size_t)m * D) + lane_id())[64 * jj] = xw; } } }
        bias_layer(ws, 0, FR.gw, FR.NGW, lane_id());
        __syncthreads();
    }
    SEAM(2);

    }
    LAS float* rstd_lds = (LAS float*)(FR.lds + LDS_RSTD_OFF);
    for (int l = 0; l < NL; ++l) {
        const int pb = PH_L0 + l * NPH;
        unsigned char* wl = ws + WS_W + (size_t)l * W_L;
        const float* modl = MOD + (size_t)l * NB * NMD;
#define RSTD_TABLE(Ncols, slot) do { int tl_ = (int)threadIdx.x; asm volatile("" : "+v"(tl_)); pg8::StaticOrder S_; S_.init(M, (Ncols), FR.G, (int)blockIdx.x); const float* sq_ = SSQ + (size_t)(slot) * M * 16; \
            for (int i_ = 0; i_ < 6; ++i_) { pg8::Unit u_; if (!S_.next(i_, u_)) break; if (tl_ < 256) { const f32x4* q_ = (const f32x4*)(sq_ + ((size_t)u_.pm * 256 + tl_) * 16); \
                const f32x4 a_ = (q_[0] + q_[1]) + (q_[2] + q_[3]); rstd_lds[i_ * 256 + tl_] = 1.0f / sqrtf(((a_[0] + a_[1]) + (a_[2] + a_[3])) * (1.f / D) + EPS); } } \
            __syncthreads(); } while (0)
#define FFN_IN_PHASE(k, c, WOFF, g) do { if (IN(pb + (k))) { RSTD_TABLE(2 * F, (c) & 1); \
            pg8::Gemm g_{XS, (const bf16_t*)(wl + (WOFF)), M, 2 * F, D, 0}; pg8::StaticOrder S; S.init(M, 2 * F, FR.G, (int)blockIdx.x); pg8::EpiSwiglu E{ws, l * 3 + (g)}; \
            pg8::gemm_phase<pg8::EpiSwiglu, pg8::StaticOrder, true, MK_SP2>(FR.lds + RING_OFF, g_, S, E); } } while (0)
#define OUT_PHASE(k, c, Aop, WOFF, Kdim, gidx, coef_, jn) do { if (IN(pb + (k))) { \
            const bool last_ = (l == NL - 1) && ((jn) == 3); \
            pg8::Gemm g_{Aop, (const bf16_t*)(wl + (WOFF)), M, D, (Kdim), (Kdim) == F ? 1 : 0}; pg8::StaticOrder S; S.init(M, D, FR.G, (int)blockIdx.x); \
            pg8::EpiResid E{ws, l, (gidx), last_ ? -1 : ((jn) == 3 ? (l + 1) * 3 : l * 3 + (jn)), ((c) + 1) & 1, (coef_)}; \
            pg8::gemm_phase<pg8::EpiResid, pg8::StaticOrder, true, MK_SP2>(FR.lds + RING_OFF, g_, S, E); } } while (0)
        const int c0 = 3 * l;
        FFN_IN_PHASE(0, c0, W_1IN, 0);
#if PROBE_REPG > 1
        if (IN(pb + 0)) xcd_barrier(bar);
        FFN_IN_PHASE(0, c0, W_1IN, 0);
#endif
        SEAM(pb + 0);
        OUT_PHASE(1, c0, ACT, W_1OUT, F, 2, 0.5f, 1);
#if PROBE_REPO > 1
        xcd_barrier(bar); OUT_PHASE(1, (c0) + 2, ACT, W_1OUT, F, 2, 0.0f, 1);
#endif
        SEAM(pb + 1);
        if (IN(pb + 2)) { RSTD_TABLE(NINP, (c0 + 1) & 1);
            pg8::Gemm g{XS, (const bf16_t*)(wl + W_IN), M, NINP, D, 0}; pg8::StaticOrder S; S.init(M, NINP, FR.G, (int)blockIdx.x); pg8::EpiMixIn E{ws, l};
            pg8::gemm_phase<pg8::EpiMixIn, pg8::StaticOrder, true, MK_SP2>(FR.lds + RING_OFF, g, S, E); }
        SEAM(pb + 2);
#if !MK_NAIVE_MIX
        for (int rep5 = 0; rep5 < PROBE_REP5; ++rep5) { if (rep5) xcd_barrier(bar);
        if (IN(pb + 3)) {
            const bf16_t* GWl = (const bf16_t*)(ws + WS_GW) + (size_t)l * 2 * 6 * 64 * 64;
            const float lam = ((const float*)(ws + WS_LAMS))[l], lam_init = args.lam_init[l];
            LAS unsigned* qw = (LAS unsigned*)(FR.lds + LDSCTL_OFF + 256);
            for (;;) {
                if ((int)threadIdx.x == 0) *qw = __hip_atomic_fetch_add((unsigned*)(ctl + CW_Q + 64 * (l + NL * rep5)), 1u, RLX_AGENT);
                __syncthreads();
                const unsigned it = __builtin_amdgcn_readfirstlane(*qw);
                constexpr unsigned N_R1 = NB * 64 * 6 / NWAVES;
                if (it >= (unsigned)mix::N_ITEMS && it < (unsigned)mix::N_ITEMS + N_R1) { const int wi = (int)(it - (unsigned)mix::N_ITEMS) * NWAVES + FR.wave;
                mix::rglru_item<1>(wi, PROJ, GWl, (const float*)(ws + WS_SP8) + l * RW, args.in[14] + l * 4 * RW, args.in[15] + l * RW, args.in[17] + l * RW, args.in[19] + l * RW, (float*)(ws + WS_AGGA), (float*)(ws + WS_AGGB), Y, lane_id());
                    continue; }
                if (it >= (unsigned)mix::N_ITEMS + N_R1) {
                    const int cw = (int)(it - (unsigned)mix::N_ITEMS - N_R1);
                    if (l + 1 >= NL || cw >= CONV_WG_ITEMS) break;
                    const int r = cw * NWAVES + FR.wave;
                    if (r < CONV_ITEMS_L) conv_item(ConvSrc{args.in[8], args.in[9], args.in[10], args.in[11], args.in[12], args.in[13]}, ws, l + 1, r, (LAS float*)(FR.lds + RING_OFF + FR.wave * 16384), lane_id());
                    continue; }
                const unsigned code = mix::g_items.v[it]; const int qb = (code >> 8) & 15, bh = code & 31;
                if (code & 0x8000u) mix::ret_seq(bh >> 2, bh & 3, PROJ, Y, FR.lds + RING_OFF);
                else mix::attn_unit<0>(bh / 6, bh % 6, qb, PROJ, Y, FR.lds + RING_OFF, lam, lam_init, args.in[25] + l * 64);
            }
        } }
#endif
        SEAM(pb + 3);
#if !MK_NAIVE_MIX
        if (IN(pb + 4)) {
            const bf16_t* GWl = (const bf16_t*)(ws + WS_GW) + (size_t)l * 2 * 6 * 64 * 64;
            for (int wi = FR.gw; wi < NB * 64 * 6; wi += FR.NGW)
                mix::rglru_item<2>(wi, PROJ, GWl, (const float*)(ws + WS_SP8) + l * RW, args.in[14] + l * 4 * RW, args.in[15] + l * RW, args.in[17] + l * RW, args.in[19] + l * RW, (float*)(ws + WS_AGGA), (float*)(ws + WS_AGGB), Y, lane_id());
            if (l + 1 < NL) bias_layer(ws, l + 1, FR.gw, FR.NGW, lane_id());
        }
#endif
#if PROBE_REPR > 1
        xcd_barrier(bar);
#if !MK_NAIVE_MIX
        if (IN(pb + 4)) {
            const bf16_t* GWl = (const bf16_t*)(ws + WS_GW) + (size_t)l * 2 * 6 * 64 * 64;
            for (int wi = FR.gw; wi < NB * 64 * 6; wi += FR.NGW)
                mix::rglru_item<2>(wi, PROJ, GWl, (const float*)(ws + WS_SP8) + l * RW, args.in[14] + l * 4 * RW, args.in[15] + l * RW, args.in[17] + l * RW, args.in[19] + l * RW, (float*)(ws + WS_AGGA), (float*)(ws + WS_AGGB), Y, lane_id());
        }
#endif
#endif
        SEAM(pb + 4);
        OUT_PHASE(5, c0 + 1, Y, W_OUT, D, 5, 1.0f, 2);
#if PROBE_REPO > 1
        xcd_barrier(bar); OUT_PHASE(5, (c0 + 1) + 2, Y, W_OUT, D, 5, 0.0f, 2);
#endif
        SEAM(pb + 5);
        FFN_IN_PHASE(6, c0 + 2, W_2IN, 2);
        SEAM(pb + 6);
        OUT_PHASE(7, c0 + 2, ACT, W_2OUT, F, 8, 0.5f, 3);
#if PROBE_REPO > 1
        xcd_barrier(bar); OUT_PHASE(7, (c0 + 2) + 2, ACT, W_2OUT, F, 8, 0.0f, 3);
#endif
        SEAM(pb + 7);
    }
    if (IN(PH_FINAL)) {
        int lnf = lane_id(); asm volatile("" : "+v"(lnf));
        const float* gp = args.in[26]; f32x4 Gv[4];
#pragma unroll
        for (int jj = 0; jj < 4; ++jj) Gv[jj] = *(const f32x4*)(gp + 4 * lnf + 256 * jj);
        for (int rr = 0; rr < 8; ++rr) { const int m = FR.gw * 8 + rr; const GAS u32x2* xr = (const GAS u32x2*)((const bf16_t*)(ws + WS_X) + (size_t)m * D) + lnf; f32x4 v[4]; float s2 = 0.f;
#pragma unroll
            for (int jj = 0; jj < 4; ++jj) { const u32x2 xw = xr[64 * jj]; v[jj] = (f32x4){hlo(xw.x), hhi(xw.x), hlo(xw.y), hhi(xw.y)}; s2 += (v[jj].x * v[jj].x + v[jj].y * v[jj].y) + (v[jj].z * v[jj].z + v[jj].w * v[jj].w); }
            const float rstd = 1.0f / sqrtf(wave_sum(s2) * (1.f / D) + EPS);
            GAS f32x4* o = (GAS f32x4*)(args.out + (size_t)m * D) + lnf;
#pragma unroll
            for (int jj = 0; jj < 4; ++jj) o[64 * jj] = v[jj] * rstd * Gv[jj]; }
    }
#undef IN
#undef SEAM
#undef bar
}

__global__ void nv_conv(const bf16_t* PROJ, const float* cw, const float* cb, float* xc) {
    const int idx = blockIdx.x * 256 + threadIdx.x; if (idx >= M * RW) return;
    const int m = idx / RW, c = idx % RW, t = m & (T - 1); float s = cb[c];
    for (int j = 0; j < 4; ++j) { const int tt = t - 3 + j; if (tt >= 0) s += cw[j * RW + c] * bf2f(PROJ[(size_t)(m - 3 + j) * NINP + C_RX + c]); }
    xc[idx] = s;
}
__global__ void nv_gates(const float* xc, const float* wa, const float* ba, const float* wx, const float* bx, const float* lam, float* av, float* bv) {
    const int idx = blockIdx.x * 256 + threadIdx.x; if (idx >= M * RW) return;
    const int m = idx / RW, c = idx % RW, h = c >> 6, cc = c & 63; float sr = ba[c], si = bx[c];
    for (int i = 0; i < 64; ++i) { const float xv = xc[(size_t)m * RW + 64 * h + i]; sr += xv * wa[(h * 64 + i) * 64 + cc]; si += xv * wx[(h * 64 + i) * 64 + cc]; }
    const float r = 1.f / (1.f + expf(-sr)), ig = 1.f / (1.f + expf(-si)); const float sp = log1pf(expf(-lam[c])); const float la = -8.0f * r * sp;
    av[idx] = expf(la); bv[idx] = sqrtf(-expm1f(2.f * la)) * ig * xc[idx];
}
__global__ void nv_scan(const float* av, const float* bv, const bf16_t* PROJ, bf16_t* Y) {
    const int idx = blockIdx.x * 64 + threadIdx.x; if (idx >= NB * RW) return;
    const int b = idx / RW, c = idx % RW; float h = 0.f;
    for (int t = 0; t < T; ++t) { const size_t m = (size_t)b * T + t; h = av[m * RW + c] * h + bv[m * RW + c];
        const float g = bf2f(PROJ[m * NINP + C_RG + c]); const float u = 0.7978845608028654f * (g + 0.044715f * g * g * g); const float y = 0.5f * g * (1.f + tanhf(u)) * h;
        Y[m * D + c] = (bf16_t)(pk2(y, 0.f) & 0xffffu); }
}
__global__ void __launch_bounds__(64) nv_diff(const bf16_t* PROJ, float* OT) {
    const int t = blockIdx.x * 64 + threadIdx.x, hc = blockIdx.y, h = hc >> 1, comp = hc & 1, b = blockIdx.z;
    const size_t m = (size_t)b * T + t;
    float q[32], o[64];
#pragma unroll
    for (int i = 0; i < 32; ++i) q[i] = bf2f(PROJ[m * NINP + C_DQ + 64 * h + 32 * comp + i]);
#pragma unroll
    for (int i = 0; i < 64; ++i) o[i] = 0.f;
    float mx = -INFINITY, lsum = 0.f; const int tmax = blockIdx.x * 64 + 63;
    for (int j = 0; j <= tmax; ++j) {
        const bf16_t* kr = PROJ + ((size_t)b * T + j) * NINP + C_DK + 64 * h + 32 * comp; const bf16_t* vr = PROJ + ((size_t)b * T + j) * NINP + C_DV + 64 * h;
        float s = 0.f;
#pragma unroll
        for (int i = 0; i < 32; ++i) s += q[i] * bf2f(kr[i]);
        if (j <= t) { const float mn = fmaxf(mx, s); const float al = exp2f(mx - mn), p = exp2f(s - mn); lsum = lsum * al + p; mx = mn;
#pragma unroll
            for (int i = 0; i < 64; ++i) o[i] = o[i] * al + p * bf2f(vr[i]); }
    }
    const float il = 1.f / lsum; float* op = OT + ((m * 6 + h) * 2 + comp) * 64;
#pragma unroll
    for (int i = 0; i < 64; ++i) op[i] = o[i] * il;
}
__global__ void nv_diff_fin(const float* OT, const float* lq1, const float* lk1, const float* lq2, const float* lk2, const float* subg, float lambda_init, bf16_t* Y) {
    const int idx = blockIdx.x * 256 + threadIdx.x; if (idx >= M * 6) return;
    float s1 = 0.f, s2 = 0.f; for (int i = 0; i < 32; ++i) { s1 += lq1[i] * lk1[i]; s2 += lq2[i] * lk2[i]; }
    const float lam = expf(s1) - expf(s2) + lambda_init;
    const int m = idx / 6, h = idx % 6; const float* o1 = OT + ((size_t)idx * 2) * 64; const float* o2 = o1 + 64; float ss = 0.f;
    for (int i = 0; i < 64; ++i) { const float v = o1[i] - lam * o2[i]; ss += v * v; }
    const float r = 1.0f / sqrtf(ss * (1.f / 64.f) + EPS) * (1.f - lambda_init);
    for (int i = 0; i < 64; ++i) { const float v = (o1[i] - lam * o2[i]) * r * subg[i]; Y[(size_t)m * D + RW + 64 * h + i] = (bf16_t)(pk2(v, 0.f) & 0xffffu); }
}
__global__ void __launch_bounds__(64) nv_ret(const bf16_t* PROJ, bf16_t* Y) {
    const int t = blockIdx.x * 64 + threadIdx.x, h = blockIdx.y, b = blockIdx.z; const size_t m = (size_t)b * T + t;
    float q[64], o[64];
#pragma unroll
    for (int i = 0; i < 64; ++i) { q[i] = bf2f(PROJ[m * NINP + C_TQ + 64 * h + i]); o[i] = 0.f; }
    const float lg2 = log2f(1.0f - exp2f(-5.0f - (float)h)); const int tmax = blockIdx.x * 64 + 63;
    for (int j = 0; j <= tmax; ++j) {
        const bf16_t* kr = PROJ + ((size_t)b * T + j) * NINP + C_TK + 64 * h; const bf16_t* vr = PROJ + ((size_t)b * T + j) * NINP + C_TV + 64 * h;
        float s = 0.f;
#pragma unroll
        for (int i = 0; i < 64; ++i) s += q[i] * bf2f(kr[i]);
        if (j <= t) { const float p = s * exp2f(64.0f * (float)((t >> 6) - (j >> 6)) * lg2);
#pragma unroll
            for (int i = 0; i < 64; ++i) o[i] += p * bf2f(vr[i]); }
    }
    float ss = 0.f;
#pragma unroll
    for (int i = 0; i < 64; ++i) ss += o[i] * o[i];
    const float r = 1.0f / sqrtf(ss * (1.f / 64.f) + EPS);
#pragma unroll
    for (int i = 0; i < 64; ++i) { const float g = bf2f(PROJ[m * NINP + C_TG + 64 * h + i]); const float v = g / (1.f + expf(-g)) * o[i] * r; Y[m * D + 768 + 64 * h + i] = (bf16_t)(pk2(v, 0.f) & 0xffffu); }
}

extern "C" void kernel_launch(void* const* d_in, const int* in_sizes, int n_in, void* d_out, int out_size, void* d_ws, size_t ws_size, hipStream_t stream) {
    static int grid = 0;
    if (grid == 0) {
        if (n_in != 27 || in_sizes[0] != M * D || out_size != M * D || ws_size < WS_END) { fprintf(stderr, "kernel_launch: unexpected shapes (n_in %d, ws %zu < %zu)\n", n_in, ws_size, (size_t)WS_END); grid = -1; return; }
        int dev = 0, cus = 0;
        if (hipGetDevice(&dev) != hipSuccess || hipDeviceGetAttribute(&cus, hipDeviceAttributeMultiprocessorCount, dev) != hipSuccess) { grid = -1; return; }
        if (hipFuncSetAttribute((const void*)mega, hipFuncAttributeMaxDynamicSharedMemorySize, LDS_BYTES) != hipSuccess) { fprintf(stderr, "kernel_launch: hipFuncSetAttribute failed\n"); grid = -1; return; }
        int per_cu = 0;
        if (hipOccupancyMaxActiveBlocksPerMultiprocessor(&per_cu, (const void*)mega, NWAVES * 64, LDS_BYTES) != hipSuccess || per_cu < 1) fprintf(stderr, "kernel_launch: occupancy query says %d\n", per_cu);
        (void)hipGetLastError();
        grid = cus;
        if (grid != 256) { fprintf(stderr, "kernel_launch: built for 256 CUs, got %d\n", grid); }
    }
    if (grid < 0) return;
    (void)hipMemsetAsync((char*)d_ws + WS_CTL, 0, CTL_ZERO_BYTES, stream);
    Args a{};
    for (int i = 0; i < 27; ++i) a.in[i] = (const float*)d_in[i];
    a.pos = (const int*)d_in[2]; a.out = (float*)d_out; a.ws = (unsigned char*)d_ws;
    for (int l = 0; l < NL; ++l) a.lam_init[l] = (float)(0.8 - 0.6 * exp(-0.3 * (double)l));
    unsigned char* ws = (unsigned char*)d_ws;
#if MK_ONE_LAUNCH
    a.ph_lo = 0; a.ph_hi = PH_END;
    hipLaunchKernelGGL(mega, dim3(grid), dim3(NWAVES * 64), LDS_BYTES, stream, a);
#else
    int nrun = 0; auto run = [&](int lo, int hi) { a.ph_lo = lo; a.ph_hi = hi; a.li = nrun++; hipLaunchKernelGGL(mega, dim3(grid), dim3(NWAVES * 64), LDS_BYTES, stream, a); };
    int seg_lo = 0;
    for (int l = 0; l < NL; ++l) {
        const int pb = PH_L0 + l * NPH;
        run(seg_lo, pb + 3); seg_lo = pb + 5;
#if !MK_NAIVE_MIX
        run(pb + 3, pb + 4); run(pb + 4, pb + 5);
#endif
        if (MK_NAIVE_MASK) {
            const bf16_t* PROJ = (const bf16_t*)(ws + WS_PROJ); bf16_t* Y = (bf16_t*)(ws + WS_Y);
            float* xc = (float*)(ws + WS_TMP); float* av = xc + (size_t)M * RW; float* bv = av + (size_t)M * RW; float* OT = (float*)(ws + WS_TMP);
            if (MK_NAIVE_MASK & 1) {
                hipLaunchKernelGGL(nv_conv, dim3(M * RW / 256), dim3(256), 0, stream, PROJ, a.in[14] + l * 4 * RW, a.in[15] + l * RW, xc);
                hipLaunchKernelGGL(nv_gates, dim3(M * RW / 256), dim3(256), 0, stream, xc, a.in[16] + l * 6 * 64 * 64, a.in[17] + l * RW, a.in[18] + l * 6 * 64 * 64, a.in[19] + l * RW, a.in[20] + l * RW, av, bv);
                hipLaunchKernelGGL(nv_scan, dim3(NB * RW / 64), dim3(64), 0, stream, av, bv, PROJ, Y); }
            if (MK_NAIVE_MASK & 2) {
                hipLaunchKernelGGL(nv_diff, dim3(T / 64, 12, NB), dim3(64), 0, stream, PROJ, OT);
                hipLaunchKernelGGL(nv_diff_fin, dim3(M * 6 / 256), dim3(256), 0, stream, OT, a.in[21] + l * 32, a.in[22] + l * 32, a.in[23] + l * 32, a.in[24] + l * 32, a.in[25] + l * 64, a.lam_init[l], Y); }
            if (MK_NAIVE_MASK & 4) hipLaunchKernelGGL(nv_ret, dim3(T / 64, 4, NB), dim3(64), 0, stream, PROJ, Y);
        }
    }
    run(seg_lo, PH_END);
#endif
}
```

```cpp
#include <hip/hip_runtime.h>
#include <cstdio>
#include <cstdint>
#include <cmath>

#ifndef MK_ONE_LAUNCH
#define MK_ONE_LAUNCH 1
#endif
#ifndef PROBE_REP5
#define PROBE_REP5 1
#endif
#ifndef PROBE_EPIR2
#define PROBE_EPIR2 0
#endif
#ifndef PROBE_EPI2
#define PROBE_EPI2 0
#endif
#ifndef PROBE_XEXP
#define PROBE_XEXP 0
#endif
#if PROBE_XEXP
#define PROBE_EXTRA_EXP(pa, pb) do { _Pragma("unroll") for (int r = 0; r < 16; ++r) { float d0_, d1_; asm volatile("v_exp_f32 %0, %2\n\tv_exp_f32 %1, %3" : "=v"(d0_), "=v"(d1_) : "v"(pa[r]), "v"(pb[r])); } } while (0)
#else
#define PROBE_EXTRA_EXP(pa, pb) do { } while (0)
#endif
#ifndef MK_SP2
#define MK_SP2 true
#endif
#ifndef PROBE_REPO
#define PROBE_REPO 1
#endif
#ifndef PROBE_REPP
#define PROBE_REPP 1
#endif
#ifndef PROBE_REPR
#define PROBE_REPR 1
#endif
#ifndef PROBE_BAR2
#define PROBE_BAR2 0
#endif
#ifndef PROBE_REPG
#define PROBE_REPG 1
#endif
#ifndef MK_NAIVE_MIX
#define MK_NAIVE_MIX 0
#endif
#ifndef MK_NAIVE_MASK
#define MK_NAIVE_MASK 0
#endif

constexpr int D = 1024, NB = 4, T = 4096, M = NB * T, NL = 4, F = 2816, NMOD = 9, NMD = NMOD * D;
constexpr int NIN = 2944, NINP = 3072;
constexpr int C_DQ = 0, C_DK = 384, C_TQ = 768, C_TK = 1024, C_DV = 1280, C_TV = 1664, C_TG = 1920, C_RX = 2176, C_RG = 2560;
constexpr int RW = 384;
constexpr float EPS = 1e-6f;
constexpr float QSCALE = 0.17677669529663687f * 1.4426950408889634f;
constexpr int KC = 32, NKC = D / KC;

constexpr size_t MiB = 1u << 20;
constexpr size_t WS_CTL = 0, CTL_ZERO_BYTES = 1 * MiB;
constexpr size_t WS_MODP = 1 * MiB;
constexpr size_t WS_MOD = 20 * MiB;
constexpr size_t WS_GW = 20 * MiB + 640 * 1024;
constexpr size_t WS_TABD = 21 * MiB;
constexpr size_t WS_TABR = 22 * MiB;
constexpr size_t WS_W = 26 * MiB;
constexpr size_t W_L = 41 * MiB, W_1IN = 0, W_1OUT = 11 * MiB, W_2IN = 16 * MiB + MiB / 2, W_2OUT = 27 * MiB + MiB / 2, W_IN = 33 * MiB, W_OUT = 39 * MiB;
constexpr size_t WS_X = WS_W + NL * W_L;
constexpr size_t WS_H = WS_X + 64 * MiB;
constexpr size_t WS_Y = WS_H + 32 * MiB;
constexpr size_t WS_ACT = WS_Y + 32 * MiB;
constexpr size_t WS_PROJ = WS_ACT;
constexpr size_t WS_TMP = WS_ACT + 96 * MiB;
constexpr size_t WS_SP8 = 21 * MiB + 512 * 1024;
constexpr size_t WS_LAMS = 21 * MiB + 520 * 1024;
constexpr size_t WS_ANORM = 21 * MiB + 528 * 1024;
constexpr size_t WS_BIAS = WS_TMP + 100 * MiB;
constexpr size_t WS_SSQ = WS_TMP + 104 * MiB;
constexpr size_t WS_AGGA = WS_TMP + 110 * MiB, WS_AGGB = WS_TMP + 111 * MiB;
constexpr size_t WS_END = WS_TMP + 112 * MiB;
constexpr int CW_TMO = 0, CW_CODE = 1, CW_Q = 2048  , CW_BAR = 4096;

#define GAS __attribute__((address_space(1)))
#define LAS __attribute__((address_space(3)))
typedef unsigned short bf16_t;
typedef short bf16x8 __attribute__((ext_vector_type(8)));
typedef float f32x4 __attribute__((ext_vector_type(4)));
typedef float f32x2 __attribute__((ext_vector_type(2)));
typedef unsigned u32x4 __attribute__((ext_vector_type(4)));
typedef unsigned u32x2 __attribute__((ext_vector_type(2)));
typedef __bf16 bf16x2_t __attribute__((ext_vector_type(2)));
typedef GAS unsigned gu32;
#define RLX_AGENT __ATOMIC_RELAXED, __HIP_MEMORY_SCOPE_AGENT
#define LDS_WAIT() asm volatile("s_waitcnt lgkmcnt(0)" ::: "memory")
#define VM_WAIT() asm volatile("s_waitcnt vmcnt(0)" ::: "memory")
__device__ __forceinline__ unsigned pk2(float lo, float hi) { f32x2 v = {lo, hi}; bf16x2_t b = __builtin_convertvector(v, bf16x2_t); return __builtin_bit_cast(unsigned, b); }
typedef _Float16 h16x2_t __attribute__((ext_vector_type(2)));
__device__ __forceinline__ unsigned pkh2(float lo, float hi) { f32x2 v = {lo, hi}; h16x2_t h = __builtin_convertvector(v, h16x2_t); return __builtin_bit_cast(unsigned, h); }
__device__ __forceinline__ float hlo(unsigned w) { const h16x2_t h = __builtin_bit_cast(h16x2_t, w); return (float)h[0]; }
__device__ __forceinline__ float hhi(unsigned w) { const h16x2_t h = __builtin_bit_cast(h16x2_t, w); return (float)h[1]; }
__device__ __forceinline__ float bf2f(bf16_t v) { return __uint_as_float((unsigned)v << 16); }
__device__ __forceinline__ float bflo(unsigned w) { return __uint_as_float(w << 16); }
__device__ __forceinline__ float bfhi(unsigned w) { return __uint_as_float(w & 0xffff0000u); }
__device__ __forceinline__ float fast_rcp(float x) { return __builtin_amdgcn_rcpf(x); }
__device__ __forceinline__ float sigmoidf_(float x) { return fast_rcp(1.f + __builtin_amdgcn_exp2f(-1.4426950408889634f * x)); }
__device__ __forceinline__ float siluf_(float x) { return x * sigmoidf_(x); }
__device__ __forceinline__ float gelu_tanh(float x) { const float u = 0.7978845608028654f * (x + 0.044715f * x * x * x); return x * sigmoidf_(2.f * u); }
__device__ __forceinline__ int lane_id() { int l; asm volatile("v_mbcnt_lo_u32_b32 %0, -1, 0\n\tv_mbcnt_hi_u32_b32 %0, -1, %0" : "=v"(l)); return l; }
template <int XM> __device__ __forceinline__ float swz_xor(float v) { return __int_as_float(__builtin_amdgcn_ds_swizzle(__float_as_int(v), (XM << 10) | 0x1F)); }
__device__ __forceinline__ float sum_x32(float v) { const auto r = __builtin_amdgcn_permlane32_swap(__float_as_uint(v), __float_as_uint(v), false, false); return __uint_as_float(r[0]) + __uint_as_float(r[1]); }
__device__ __forceinline__ int imax_x32(int v) { const auto r = __builtin_amdgcn_permlane32_swap((unsigned)v, (unsigned)v, false, false); const int a = (int)r[0], b = (int)r[1]; return a > b ? a : b; }
__device__ __forceinline__ float wave_sum(float v) {
    v += swz_xor<1>(v); v += swz_xor<2>(v); v += swz_xor<4>(v); v += swz_xor<8>(v); v += swz_xor<16>(v);
    return sum_x32(v);
}

__device__ __forceinline__ float lg2gamma(int hh) { return hh == 0 ? -0.04580368961312479f : hh == 1 ? -0.02272007650008353f : hh == 2 ? -0.011315313227834146f : -0.005646563141142063f; }

constexpr int RING_OFF = 0, RING_BYTES = 131072, LDSCTL_OFF = RING_BYTES, MISC_OFF = LDSCTL_OFF + 320, LDS_RSTD_OFF = RING_BYTES + 1024  , LDS_BYTES = 163840;
extern __shared__ __attribute__((aligned(16))) unsigned char lds_raw[];

namespace pg8 {
#define PG8_LAS __attribute__((address_space(3)))
constexpr int BM = 256, BK = 64, HALF = 128, HTB = HALF * BK * 2, STAGE_BYTES = 8 * HTB, NXCD = 8, WGM = 8;
__host__ __device__ __forceinline__ int lds_byte(int r, int c) { const int st = (r >> 4) * 2 + (c >> 5), rr = r & 15, cc = c & 31, ob = rr * 64 + cc * 2; return st * 1024 + (ob ^ (((ob >> 9) & 1) << 5)); }
__host__ __device__ __forceinline__ void stage_rc(int b, int& R, int& C) { const int st = b / 1024, sb = b % 1024, swz = sb ^ (((sb >> 9) & 1) << 5); R = (st >> 1) * 16 + swz / 64; C = (st & 1) * 32 + (swz % 64) / 2; }
__host__ __device__ __forceinline__ int perm32(int rho) { const int n = rho >> 4, i = rho & 15; return 8 * (i >> 2) + 4 * n + (i & 3); }
struct Unit { int pm, pn, idx; };
struct Gemm { const bf16_t* A; const bf16_t* Bt; int M, N, K, tiled; };
struct StaticOrder {
    int nM, nN, nwg, G, c;
    __host__ __device__ void init(int M_, int N_, int G_, int c_) { nM = M_ / BM; nN = N_ / BM; nwg = nM * nN; G = G_; c = c_;
#if defined(__HIP_DEVICE_COMPILE__)
        asm volatile("" : "+s"(c));
#endif
    }
    __host__ __device__ __forceinline__ bool next(int i, Unit& u) const {
        const long L = (long)i * G + c; if (L >= nwg) return false;
        int wgid = (int)L; { const int q = nwg / NXCD, r = nwg % NXCD, xcd = wgid % NXCD, off = wgid / NXCD; wgid = (xcd < r ? xcd * (q + 1) : r * (q + 1) + (xcd - r) * q) + off; }
        const int nig = WGM * nN, gid = wgid / nig, fm = gid * WGM, gsz = (nM - fm) < WGM ? (nM - fm) : WGM;
        u.pm = fm + ((wgid % nig) % gsz); u.pn = (wgid % nig) / gsz; u.idx = i; return true;
    }
    __device__ __forceinline__ void a_ready(const Unit&) const {}
    __device__ __forceinline__ void done(const Unit&) const {}
};

struct EpiSwiglu {
    static constexpr bool PERM = true, AFTER_DRAIN = false;
    unsigned char* ws; int lg;
    __device__ __forceinline__ void operator()(const f32x4 (&acc)[2][2][4][2], const Unit& u, int wr, int wc, int fr, int fq) const {
        bf16_t* O = (bf16_t*)(ws + WS_ACT); const float* bias = (const float*)(ws + WS_BIAS) + (size_t)lg * NB * (2 * F); const LAS float* rstd = (const LAS float*)((LAS unsigned char*)lds_raw + LDS_RSTD_OFF);
        const int row0 = u.pm * BM + wr * 64 + fr, col0 = u.pn * HALF + wc * 32 + 8 * fq;
        const float* bp = bias + (size_t)(u.pm >> 4) * (2 * F) + u.pn * BM + wc * 32 + 8 * fq;
        const f32x4 bg0 = *(const f32x4*)bp, bg1 = *(const f32x4*)(bp + 4), bu0 = *(const f32x4*)(bp + HALF), bu1 = *(const f32x4*)(bp + HALF + 4);
#pragma unroll
        for (int ai = 0; ai < 2; ++ai)
#pragma unroll
            for (int m = 0; m < 4; ++m) {
                const float rs = rstd[u.idx * BM + ai * HALF + m * 16 + wr * 64 + fr];
                const int row_ = row0 + ai * HALF + m * 16;
                bf16_t* rowp = O + ((((size_t)(row_ >> 8) * (F / 64) + (col0 >> 6)) * BM + (row_ & 255)) << 6) + (col0 & 63);
                const f32x4 g0 = acc[ai][0][m][0] * rs + bg0, g1 = acc[ai][0][m][1] * rs + bg1, u0 = acc[ai][1][m][0] * rs + bu0, u1 = acc[ai][1][m][1] * rs + bu1;
                u32x4 w;
                w.x = pk2(siluf_(g0[0]) * u0[0], siluf_(g0[1]) * u0[1]); w.y = pk2(siluf_(g0[2]) * u0[2], siluf_(g0[3]) * u0[3]);
                w.z = pk2(siluf_(g1[0]) * u1[0], siluf_(g1[1]) * u1[1]); w.w = pk2(siluf_(g1[2]) * u1[2], siluf_(g1[3]) * u1[3]);
                *(u32x4*)rowp = w;
            }
    }
};
struct EpiResid {
    static constexpr bool PERM = true, AFTER_DRAIN = false;
    unsigned char* ws; int l, gidx, an_idx, slot; float coef;
    __device__ __forceinline__ void operator()(const f32x4 (&acc)[2][2][4][2], const Unit& u, int wr, int wc, int fr, int fq) const {
        bf16_t* X = (bf16_t*)(ws + WS_X); bf16_t* XS = (bf16_t*)(ws + WS_H); float* SSQ = (float*)(ws + WS_SSQ) + (size_t)slot * M * 16;
        const float* gate = (const float*)(ws + WS_MOD) + (size_t)l * NB * NMD + gidx * D; const float* An = (const float*)(ws + WS_ANORM) + (size_t)(an_idx < 0 ? 0 : an_idx) * NB * D; const bool has_an = an_idx >= 0;
        const int row0 = u.pm * BM + wr * 64 + fr, col0 = u.pn * BM + wc * 32 + 8 * fq, b = u.pm >> 4;
        f32x4 gv[2][2], av[2][2];
#pragma unroll
        for (int bj = 0; bj < 2; ++bj)
#pragma unroll
            for (int n = 0; n < 2; ++n) { gv[bj][n] = *(const f32x4*)(gate + (size_t)b * NMD + col0 + bj * HALF + n * 4) * coef;
                av[bj][n] = *(const f32x4*)(An + (size_t)b * D + col0 + bj * HALF + n * 4); }
        u32x4 xin[2][2];
#define RES_LOAD(g_, buf) do { const size_t ro_ = (size_t)(row0 + ((g_) >> 2) * HALF + ((g_) & 3) * 16) * D + col0; \
            _Pragma("unroll") for (int bj = 0; bj < 2; ++bj) xin[buf][bj] = *(const u32x4*)(X + ro_ + bj * HALF); } while (0)
        RES_LOAD(0, 0);
#pragma unroll
        for (int g = 0; g < 8; ++g) { const int ai = g >> 2, m = g & 3, row = row0 + ai * HALF + m * 16; const size_t ro = (size_t)row * D + col0; float ss = 0.f;
            if (g + 1 < 8) RES_LOAD(g + 1, (g + 1) & 1);
#pragma unroll
            for (int bj = 0; bj < 2; ++bj) { const size_t o = ro + bj * HALF; const u32x4 xi = xin[g & 1][bj];
                const f32x4 x0 = (f32x4){hlo(xi.x), hhi(xi.x), hlo(xi.y), hhi(xi.y)} + gv[bj][0] * acc[ai][bj][m][0], x1 = (f32x4){hlo(xi.z), hhi(xi.z), hlo(xi.w), hhi(xi.w)} + gv[bj][1] * acc[ai][bj][m][1];
                { u32x4 w; w.x = pkh2(x0[0], x0[1]); w.y = pkh2(x0[2], x0[3]); w.z = pkh2(x1[0], x1[1]); w.w = pkh2(x1[2], x1[3]); *(u32x4*)(X + o) = w; }
                ss += ((x0[0] * x0[0] + x0[1] * x0[1]) + (x0[2] * x0[2] + x0[3] * x0[3])) + ((x1[0] * x1[0] + x1[1] * x1[1]) + (x1[2] * x1[2] + x1[3] * x1[3]));
                if (has_an) { const f32x4 s0 = x0 * av[bj][0], s1 = x1 * av[bj][1]; u32x4 w; w.x = pk2(s0[0], s0[1]); w.y = pk2(s0[2], s0[3]); w.z = pk2(s1[0], s1[1]); w.w = pk2(s1[2], s1[3]); *(u32x4*)(XS + o) = w; } }
            ss += swz_xor<16>(ss); ss = sum_x32(ss);
            if (fq == 0) SSQ[(size_t)row * 16 + u.pn * 4 + wc] = ss; }
#undef RES_LOAD
    }
};
struct EpiMixIn {
    static constexpr bool PERM = true, AFTER_DRAIN = false;
    unsigned char* ws; int l;
    __device__ __forceinline__ void operator()(const f32x4 (&acc)[2][2][4][2], const Unit& u, int wr, int wc, int fr, int fq) const {
        bf16_t* O = (bf16_t*)(ws + WS_PROJ); const float* tabD = (const float*)(ws + WS_TABD); const float* tabR = (const float*)(ws + WS_TABR);
        const float* bias = (const float*)(ws + WS_BIAS) + (size_t)(3 * l + 1) * NB * (2 * F); const LAS float* rstd = (const LAS float*)((LAS unsigned char*)lds_raw + LDS_RSTD_OFF);
        const int row0 = u.pm * BM + wr * 64 + fr;
#pragma unroll
        for (int bj = 0; bj < 2; ++bj) {
            const int kb = 2 * u.pn + bj, col0 = kb * HALF + wc * 32 + 8 * fq;
            const f32x4 b0 = *(const f32x4*)(bias + (size_t)(u.pm >> 4) * (2 * F) + col0), b1 = *(const f32x4*)(bias + (size_t)(u.pm >> 4) * (2 * F) + col0 + 4);
            if (kb < 6) {
                const float qs = (kb < 3) ? QSCALE : 1.f;
#pragma unroll
                for (int ai = 0; ai < 2; ++ai)
#pragma unroll
                    for (int m = 0; m < 4; ++m) { const int row = row0 + ai * HALF + m * 16; const float rs = rstd[u.idx * BM + ai * HALF + m * 16 + wr * 64 + fr];
                        f32x4 v0 = acc[ai][bj][m][0] * rs + b0, v1 = acc[ai][bj][m][1] * rs + b1;
                        if (fq == 0) { const f32x4 c = *(const f32x4*)(tabD + (size_t)row * 8), s = *(const f32x4*)(tabD + (size_t)row * 8 + 4); const f32x4 r0 = v0 * c - v1 * s, r1 = v1 * c + v0 * s; v0 = r0; v1 = r1; }
                        v0 = v0 * qs; v1 = v1 * qs;
                        u32x4 w; w.x = pk2(v0[0], v0[1]); w.y = pk2(v0[2], v0[3]); w.z = pk2(v1[0], v1[1]); w.w = pk2(v1[2], v1[3]);
                        *(u32x4*)(O + (size_t)row * NINP + col0) = w; }
            } else if (kb < 10) {
                const bool isk = (kb >= 8); const int i0 = 16 * (wc & 1) + 4 * fq; const float lg = lg2gamma(2 * (kb & 1) + (wc >> 1)) * (isk ? -1.f : 1.f);
#pragma unroll
                for (int ai = 0; ai < 2; ++ai)
#pragma unroll
                    for (int m = 0; m < 4; ++m) { const int row = row0 + ai * HALF + m * 16; const float rs = rstd[u.idx * BM + ai * HALF + m * 16 + wr * 64 + fr];
                        const f32x4 v0 = acc[ai][bj][m][0] * rs + b0, v1 = acc[ai][bj][m][1] * rs + b1;
                        const f32x4 c = *(const f32x4*)(tabR + (size_t)row * 64 + i0), s = *(const f32x4*)(tabR + (size_t)row * 64 + 32 + i0);
                        const float ks = __builtin_amdgcn_exp2f((float)(row & 63) * lg) * (isk ? 0.125f : 1.f);
                        const f32x4 r0 = (v0 * c - v1 * s) * ks, r1 = (v1 * c + v0 * s) * ks;
                        u32x4 w; w.x = pk2(r0[0], r0[1]); w.y = pk2(r0[2], r0[3]); w.z = pk2(r1[0], r1[1]); w.w = pk2(r1[2], r1[3]);
                        *(u32x4*)(O + (size_t)row * NINP + col0) = w; }
            } else {
#pragma unroll
                for (int ai = 0; ai < 2; ++ai)
#pragma unroll
                    for (int m = 0; m < 4; ++m) { const int row = row0 + ai * HALF + m * 16; const float rs = rstd[u.idx * BM + ai * HALF + m * 16 + wr * 64 + fr];
                        const f32x4 v0 = acc[ai][bj][m][0] * rs + b0, v1 = acc[ai][bj][m][1] * rs + b1;
                        u32x4 w; w.x = pk2(v0[0], v0[1]); w.y = pk2(v0[2], v0[3]); w.z = pk2(v1[0], v1[1]); w.w = pk2(v1[2], v1[3]);
                        *(u32x4*)(O + (size_t)row * NINP + col0) = w; }
            }
        }
    }
};

template <class Epi, class Sched, bool ALIGN_EPI = false, bool SP2 = false>
__device__ __forceinline__ void gemm_phase(PG8_LAS unsigned char* lds, const Gemm g, const Sched& S, const Epi& E) {
    int tid_ = threadIdx.x; asm volatile("" : "+v"(tid_));
    const int tid = tid_, wid = __builtin_amdgcn_readfirstlane(tid >> 6), lane = tid & 63, wr = wid >> 2, wc = wid & 3, fr = lane & 15, fq = lane >> 4;
    const int K = g.K, nt = K / BK, ld = g.tiled ? BK : K;
    unsigned voffA[2], voffB[2];
#pragma unroll
    for (int i = 0; i < 2; ++i) { int R, C; stage_rc(tid * 16 + i * 8192, R, C); const int Rb = Epi::PERM ? ((R & ~31) + perm32(R & 31)) : R;
        voffA[i] = (unsigned)(R * ld + C) * 2u; voffB[i] = (unsigned)(Rb * ld + C) * 2u; }
    const size_t kstep = g.tiled ? (size_t)(BM * BK * 2) : (size_t)(BK * 2);
    const size_t hstep = (size_t)HALF * ld * 2;
    const size_t tstep = g.tiled ? (size_t)nt * (BM * BK * 2) : 2 * hstep;
    const unsigned ldsw = (unsigned)wid * 1024u;
    const int aoff = lds_byte(wr * 64 + fr, fq * 8), boff = lds_byte(wc * 32 + fr, fq * 8);
#define PG8_SA(b, h) (((b) * 2 + (h)) * HTB)
#define PG8_SB(b, h) ((4 + (b) * 2 + (h)) * HTB)
#define PG8_STAGE(bufoff, gbase, voff) do { _Pragma("unroll") for (int _i = 0; _i < 2; ++_i) \
        __builtin_amdgcn_global_load_lds((const unsigned*)((const char*)(gbase) + (voff)[_i]), (PG8_LAS unsigned*)(lds + (bufoff) + ldsw + _i * 8192), 16, 0, 0); } while (0)
#define PG8_LDA(dst, b, h) do { _Pragma("unroll") for (int m = 0; m < 4; ++m) _Pragma("unroll") for (int k = 0; k < 2; ++k) dst[m][k] = *(const PG8_LAS bf16x8*)(lds + PG8_SA(b, h) + aoff + m * 2048 + k * 1024); } while (0)
#define PG8_LDB(dst, b, h) do { _Pragma("unroll") for (int n = 0; n < 2; ++n) _Pragma("unroll") for (int k = 0; k < 2; ++k) dst[n][k] = *(const PG8_LAS bf16x8*)(lds + PG8_SB(b, h) + boff + n * 2048 + k * 1024); } while (0)
#define PG8_MMA(ai, bj, At, Bt) do { __builtin_amdgcn_s_setprio(1); _Pragma("unroll") for (int m = 0; m < 4; ++m) _Pragma("unroll") for (int n = 0; n < 2; ++n) _Pragma("unroll") for (int k = 0; k < 2; ++k) \
        acc[ai][bj][m][n] = __builtin_amdgcn_mfma_f32_16x16x32_bf16(Bt[n][k], At[m][k], acc[ai][bj][m][n], 0, 0, 0); __builtin_amdgcn_s_setprio(0); } while (0)
#define PG8_WAIT_V(n) asm volatile("s_waitcnt vmcnt(" #n ")" ::: "memory")
#define PG8_WAIT_L(n) asm volatile("s_waitcnt lgkmcnt(" #n ")" ::: "memory")
#define PG8_BAR __builtin_amdgcn_s_barrier()
#define PG8_SCHED __builtin_amdgcn_sched_barrier(0)
    Unit cur, nxt; int ui = 0;
    if (!S.next(0, cur)) return;
    f32x4 acc[2][2][4][2];
#pragma unroll
    for (int a = 0; a < 2; ++a)
#pragma unroll
        for (int b = 0; b < 2; ++b)
#pragma unroll
            for (int m = 0; m < 4; ++m)
#pragma unroll
                for (int n = 0; n < 2; ++n) acc[a][b][m][n] = (f32x4){0.f, 0.f, 0.f, 0.f};
    bf16x8 At[4][2], B0[2][2], B1[2][2];
    const char* cA = (const char*)g.A + (size_t)cur.pm * tstep; const char* cB = (const char*)g.Bt + (size_t)cur.pn * tstep;
    S.a_ready(cur);
    if constexpr (SP2) {
        PG8_STAGE(PG8_SB(0, 0), cB, voffB); PG8_STAGE(PG8_SB(0, 1), cB + hstep, voffB); PG8_STAGE(PG8_SA(0, 0), cA, voffA); PG8_STAGE(PG8_SA(0, 1), cA + hstep, voffA);
        if (wr == 1) PG8_BAR;
        PG8_WAIT_V(2); PG8_BAR;
        PG8_STAGE(PG8_SB(1, 0), cB + kstep, voffB); PG8_STAGE(PG8_SA(1, 0), cA + kstep, voffA); PG8_STAGE(PG8_SB(1, 1), cB + hstep + kstep, voffB);
        PG8_WAIT_V(6); PG8_BAR;
    } else {
        PG8_STAGE(PG8_SB(0, 0), cB, voffB); PG8_STAGE(PG8_SA(0, 0), cA, voffA); PG8_STAGE(PG8_SB(0, 1), cB + hstep, voffB); PG8_STAGE(PG8_SA(0, 1), cA + hstep, voffA);
        if (wr == 1) PG8_BAR;
        PG8_WAIT_V(4); PG8_BAR;
        PG8_STAGE(PG8_SB(1, 0), cB + kstep, voffB); PG8_STAGE(PG8_SA(1, 0), cA + kstep, voffA); PG8_STAGE(PG8_SB(1, 1), cB + hstep + kstep, voffB);
        PG8_WAIT_V(6); PG8_BAR;
    }
    for (;;) {
        const bool has_next = S.next(ui + 1, nxt);
        const char* nA = has_next ? (const char*)g.A + (size_t)nxt.pm * tstep : cA; const char* nB = has_next ? (const char*)g.Bt + (size_t)nxt.pn * tstep : cB;
        for (int t = 0; t < nt; t += 2) {
            const bool last = (t == nt - 2);
            const char* a1 = cA + (size_t)(t + 1) * kstep;
            const char* a2 = last ? nA : cA + (size_t)(t + 2) * kstep; const char* b2 = last ? nB : cB + (size_t)(t + 2) * kstep;
            const char* a3 = a2 + kstep; const char* b3 = b2 + kstep;
            if (last && has_next) S.a_ready(nxt);
            if constexpr (SP2) {
            PG8_LDB(B0, 0, 0); PG8_LDB(B1, 0, 1); PG8_SCHED; PG8_LDA(At, 0, 0); PG8_STAGE(PG8_SA(1, 1), a1 + hstep, voffA);
            PG8_WAIT_V(8); PG8_WAIT_L(0); PG8_BAR; PG8_MMA(0, 0, At, B0); PG8_MMA(0, 1, At, B1); PG8_BAR; PG8_SCHED;
            PG8_LDA(At, 0, 1); PG8_STAGE(PG8_SB(0, 0), b2, voffB); PG8_STAGE(PG8_SB(0, 1), b2 + hstep, voffB); PG8_STAGE(PG8_SA(0, 0), a2, voffA);
            PG8_WAIT_V(8); PG8_WAIT_L(0); PG8_BAR; PG8_MMA(1, 0, At, B0); PG8_MMA(1, 1, At, B1); PG8_BAR; PG8_SCHED;
            PG8_LDB(B0, 1, 0); PG8_LDB(B1, 1, 1); PG8_SCHED; PG8_LDA(At, 1, 0); PG8_STAGE(PG8_SA(0, 1), a2 + hstep, voffA);
            PG8_WAIT_V(8); PG8_WAIT_L(0); PG8_BAR; PG8_MMA(0, 0, At, B0); PG8_MMA(0, 1, At, B1); PG8_BAR; PG8_SCHED;
            PG8_LDA(At, 1, 1); PG8_STAGE(PG8_SB(1, 0), b3, voffB); PG8_STAGE(PG8_SB(1, 1), b3 + hstep, voffB); PG8_STAGE(PG8_SA(1, 0), a3, voffA);
            PG8_WAIT_V(8); PG8_WAIT_L(0); PG8_BAR; PG8_MMA(1, 0, At, B0); PG8_MMA(1, 1, At, B1); PG8_BAR; PG8_SCHED;
            } else {
            PG8_LDB(B0, 0, 0); PG8_SCHED; PG8_LDA(At, 0, 0); PG8_STAGE(PG8_SA(1, 1), a1 + hstep, voffA);
            PG8_WAIT_L(8); PG8_BAR; PG8_WAIT_L(0); PG8_MMA(0, 0, At, B0); PG8_BAR; PG8_SCHED;
            PG8_LDB(B1, 0, 1); PG8_STAGE(PG8_SB(0, 0), b2, voffB);
            PG8_BAR; PG8_WAIT_L(0); PG8_MMA(0, 1, At, B1); PG8_BAR;
            PG8_LDA(At, 0, 1); PG8_STAGE(PG8_SA(0, 0), a2, voffA);
            PG8_BAR; PG8_WAIT_L(0); PG8_MMA(1, 0, At, B0); PG8_BAR; PG8_SCHED;
            PG8_STAGE(PG8_SB(0, 1), b2 + hstep, voffB);
            PG8_WAIT_V(6); PG8_BAR; PG8_MMA(1, 1, At, B1); PG8_BAR;
            PG8_LDB(B0, 1, 0); PG8_SCHED; PG8_LDA(At, 1, 0); PG8_STAGE(PG8_SA(0, 1), a2 + hstep, voffA);
            PG8_WAIT_L(8); PG8_BAR; PG8_WAIT_L(0); PG8_MMA(0, 0, At, B0); PG8_BAR; PG8_SCHED;
            PG8_LDB(B1, 1, 1); PG8_STAGE(PG8_SB(1, 0), b3, voffB);
            PG8_BAR; PG8_WAIT_L(0); PG8_MMA(0, 1, At, B1); PG8_BAR;
            PG8_LDA(At, 1, 1); PG8_STAGE(PG8_SA(1, 0), a3, voffA);
            PG8_BAR; PG8_WAIT_L(0); PG8_MMA(1, 0, At, B0); PG8_BAR; PG8_SCHED;
            PG8_STAGE(PG8_SB(1, 1), b3 + hstep, voffB);
            PG8_WAIT_V(6); PG8_BAR; PG8_MMA(1, 1, At, B1); PG8_BAR;
            }
        }
        if constexpr (ALIGN_EPI) { if (wr == 0) PG8_BAR; }
        if constexpr (!Epi::AFTER_DRAIN) { E(acc, cur, wr, wc, fr, fq);
#if PROBE_EPI2
            if constexpr (Epi::PERM) { asm volatile("" ::: "memory"); E(acc, cur, wr, wc, fr, fq); }
#elif PROBE_EPIR2
            if constexpr (!Epi::PERM) { asm volatile("s_waitcnt vmcnt(0)" ::: "memory"); Epi E2 = E; E2.coef = 0.f; E2(acc, cur, wr, wc, fr, fq); }
#endif
            S.done(cur); }
        if (!has_next) break;
#pragma unroll
        for (int a = 0; a < 2; ++a)
#pragma unroll
            for (int b = 0; b < 2; ++b)
#pragma unroll
                for (int m = 0; m < 4; ++m)
#pragma unroll
                    for (int n = 0; n < 2; ++n) acc[a][b][m][n] = (f32x4){0.f, 0.f, 0.f, 0.f};
        cur = nxt; cA = nA; cB = nB; ++ui;
        if constexpr (ALIGN_EPI) { if (wr == 1) PG8_BAR; }
    }
    PG8_WAIT_V(0);
    if constexpr (!ALIGN_EPI) { if (wr == 0) PG8_BAR; }
    PG8_BAR;
#undef PG8_SA
#undef PG8_SB
#undef PG8_STAGE
#undef PG8_LDA
#undef PG8_LDB
#undef PG8_MMA
#undef PG8_WAIT_V
#undef PG8_WAIT_L
#undef PG8_BAR
#undef PG8_SCHED
}
}

#define XB_TMO      128
#define XB_XCNT(j)  (256  + 64 * (j))
#define XB_XSUB(j)  (1280 + 64 * (j))
#define XB_XGEN(j)  (2304 + 64 * (j))
#define XB_TOP      3328
#define XB_TOPGEN   3392
#define XCD_BAR_WORDS 3456
#define XB_SPIN_CAP (1u << 18)
__device__ __forceinline__ unsigned xb_ld(unsigned* p)              { return __hip_atomic_load(p, __ATOMIC_RELAXED, __HIP_MEMORY_SCOPE_AGENT); }
__device__ __forceinline__ unsigned xb_add(unsigned* p, unsigned v) { return __hip_atomic_fetch_add(p, v, __ATOMIC_RELAXED, __HIP_MEMORY_SCOPE_AGENT); }
__device__ __forceinline__ unsigned xb_xcc_id() { return (unsigned)__builtin_amdgcn_s_getreg((3 << 11) | 20) & 0xFu; }
#define XB_SPIN(cond, bar) do { unsigned _sp = 0; while (cond) { __builtin_amdgcn_s_sleep(1); \
    if ((++_sp & 255u) == 0u) { if (xb_ld(&(bar)[XB_TMO])) break; if (_sp > XB_SPIN_CAP) { atomicAdd(&(bar)[XB_TMO], 1u); break; } } } } while (0)
struct XcdBarrier { unsigned* bar; unsigned x; volatile LAS unsigned* st; };
__device__ __forceinline__ XcdBarrier xcd_barrier_post(unsigned* bar, volatile LAS unsigned* st) {
    XcdBarrier b; b.bar = bar; b.x = xb_xcc_id(); b.st = st;
    if (threadIdx.x == 0) (void)xb_add(&bar[XB_XCNT(b.x)], 1u);
    return b;
}
__device__ __forceinline__ void xcd_barrier_complete(unsigned* bar, unsigned x, unsigned& nloc, unsigned& nx) {
    const unsigned G = gridDim.x * gridDim.y * gridDim.z;
    unsigned sum, cnt, mine, sp = 0u;
    for (;;) {
        sum = 0u; cnt = 0u; mine = 0u;
#pragma unroll
        for (unsigned j = 0; j < 16; ++j) { const unsigned c = xb_ld(&bar[XB_XCNT(j)]); sum += c; cnt += (c > 0u) ? 1u : 0u; mine = (j == x) ? c : mine; }
        if (sum == G) break;
        __builtin_amdgcn_s_sleep(1);
        if ((++sp & 255u) == 0u) { if (xb_ld(&bar[XB_TMO])) break; if (sp > XB_SPIN_CAP) { atomicAdd(&bar[XB_TMO], 1u); break; } }
    }
    nloc = mine > 0u ? mine : 1u; nx = cnt > 0u ? cnt : 1u;
}
__device__ __forceinline__ void xcd_barrier(const XcdBarrier& b) {
    asm volatile("s_waitcnt vmcnt(0)" ::: "memory");
    __syncthreads();
    if (threadIdx.x == 0) {
        unsigned* bar = b.bar; asm volatile("" : "+s"(bar));
        __builtin_amdgcn_s_waitcnt(0);
        unsigned nloc = b.st[0], nx = b.st[1];
        if (nloc == 0u) { xcd_barrier_complete(bar, b.x, nloc, nx); b.st[0] = nloc; b.st[1] = nx; }
        const unsigned old = xb_add(&bar[XB_XSUB(b.x)], 1u);
        const unsigned gen = old / nloc;
        if (old + 1u == (gen + 1u) * nloc) {
            __builtin_amdgcn_fence(__ATOMIC_RELEASE, "agent");
            asm volatile("s_waitcnt vmcnt(0)" ::: "memory");
            const unsigned og = xb_add(&bar[XB_TOP], 1u);
            const unsigned tg = og / nx;
            if (og + 1u == (tg + 1u) * nx) xb_add(&bar[XB_TOPGEN], 1u);
            else XB_SPIN(xb_ld(&bar[XB_TOPGEN]) == tg, bar);
            __builtin_amdgcn_fence(__ATOMIC_ACQUIRE, "agent");
            xb_add(&bar[XB_XGEN(b.x)], 1u);
            asm volatile("s_waitcnt vmcnt(0)" ::: "memory");
        } else {
            XB_SPIN(xb_ld(&bar[XB_XGEN(b.x)]) == gen, bar);
            __builtin_amdgcn_fence(__ATOMIC_ACQUIRE, "agent");
            asm volatile("s_waitcnt vmcnt(0)" ::: "memory");
        }
    }
    __syncthreads();
}

namespace mix {
typedef float f32x16 __attribute__((ext_vector_type(16)));
typedef short s16x4 __attribute__((ext_vector_type(4)));
typedef short v4i16_t __attribute__((ext_vector_type(4)));
typedef LAS const char* lds_cptr;
constexpr int SLOTB = 8192, LDS_K = 0, LDS_V = 2 * SLOTB, LDS_QW = 4 * SLOTB, LDS_QF = 4 * SLOTB + 1024;
constexpr int N_DIFF = 24 * 16, N_RET = 16, N_ITEMS = N_DIFF + N_RET;
__device__ __forceinline__ int crow(int r, int hi) { return (r & 3) + 8 * (r >> 2) + 4 * hi; }
__device__ __forceinline__ int imax(int a, int b) { return a > b ? a : b; }
__device__ __forceinline__ void glds16(const void* g, unsigned lds_base) { unsigned sv; asm volatile("s_mov_b32 %0, m0\n\ts_mov_b32 m0, %2\n\ts_nop 0\n\tglobal_load_lds_dwordx4 %1, off\n\ts_mov_b32 m0, %0" : "=&s"(sv) : "v"(g), "s"(lds_base) : "memory"); }
__device__ __forceinline__ s16x4 vtr(lds_cptr p) { return __builtin_bit_cast(s16x4, __builtin_amdgcn_ds_read_tr16_b64_v4i16((LAS v4i16_t*)p)); }
#define MFMA32(a, b, c) __builtin_amdgcn_mfma_f32_32x32x16_bf16(a, b, c, 0, 0, 0)
#define MFMA16(a, b, c) __builtin_amdgcn_mfma_f32_16x16x32_bf16(a, b, c, 0, 0, 0)

struct ItemTab { unsigned short v[N_ITEMS]; };
constexpr ItemTab make_items() {
    ItemTab t{}; int n = 0;
    for (int bh = 0; bh < 16; ++bh) t.v[n++] = (unsigned short)(0x8000 | bh);
    for (int qb = 15; qb >= 0; --qb) for (int bh = 0; bh < 24; ++bh) t.v[n++] = (unsigned short)((qb << 8) | bh);
    return t;
}
__device__ const ItemTab g_items = make_items();

template <int MODE>
__device__ __forceinline__ void attn_unit(int b, int h, int qb, const bf16_t* PROJ, bf16_t* Y, LAS unsigned char* lds, float lam, float lam_init, const float* subg) {
    int tid_ = threadIdx.x; asm volatile("" : "+v"(tid_));
    const int tid = tid_, lane = tid & 63, r32 = lane & 31, hi = lane >> 5; const int wid = __builtin_amdgcn_readfirstlane(tid >> 6);
    constexpr int CQ = MODE == 0 ? C_DQ : C_TQ, CK = MODE == 0 ? C_DK : C_TK, CV = MODE == 0 ? C_DV : C_TV;
    const size_t rowbase = (size_t)b * T; const int q0 = qb * 256, NT = 4 * (qb + 1), my_last = 4 * qb + (wid >> 1);
    const bf16_t* Qw = PROJ + (rowbase + q0 + wid * 32) * NINP + CQ + 64 * h;
    const bf16_t* ksrc = PROJ + (rowbase + lane) * NINP + CK + 64 * h + wid * 8;
    const bf16_t* vsrc = PROJ + (rowbase + 16 * (wid & 3) + (lane >> 2)) * NINP + CV + 64 * h + (wid >> 2) * 32 + (lane & 3) * 8;
    const unsigned lds0 = (unsigned)(uintptr_t)lds;
    const unsigned kdst = lds0 + LDS_K + wid * 1024, vdst = lds0 + LDS_V + wid * 1024;
    const lds_cptr kp0 = (lds_cptr)lds + LDS_K + hi * 1024 + r32 * 16;
    const lds_cptr vp0 = (lds_cptr)lds + LDS_V + ((lane >> 4) & 1) * 32 + (lane & 3) * 8 + (4 * hi + ((lane & 15) >> 2)) * 64;
#define DMA_K(t, slot) glds16(ksrc + (size_t)(t) * 64 * NINP, (unsigned)__builtin_amdgcn_readfirstlane(kdst + (slot)))
#define DMA_V(t, slot) glds16(vsrc + (size_t)(t) * 64 * NINP, (unsigned)__builtin_amdgcn_readfirstlane(vdst + (slot)))
    DMA_K(0, 0); DMA_V(0, 0);
#pragma unroll
    for (int p = 0; p < 4; ++p) glds16(Qw + (size_t)(lane & 31) * NINP + (2 * p + (lane >> 5)) * 8, (unsigned)__builtin_amdgcn_readfirstlane(lds0 + LDS_QF + wid * 4096 + p * 1024));
    const lds_cptr qp0 = (lds_cptr)lds + LDS_QF + wid * 4096 + hi * 512 + r32 * 16;
    f32x16 oA[2], oB[2];
    oA[0] = f32x16{}; oA[1] = f32x16{}; oB[0] = f32x16{}; oB[1] = f32x16{};
    float mref = 0.f, lA = 0.f, lB = 0.f; f32x16 nm = f32x16{};
    const int qabs = q0 + wid * 32 + r32;
    const float lg2 = lg2gamma(h);
    for (int t = 0; t < NT; ++t) {
        asm volatile("s_waitcnt vmcnt(0) lgkmcnt(0)\n\ts_barrier" ::: "memory");
        const int sl = (t & 1) * SLOTB;
        if (t + 1 < NT) { DMA_K(t + 1, SLOTB - sl); DMA_V(t + 1, SLOTB - sl); }
        if (t <= my_last) {
            bf16x8 kf[8], vf[8], qr[4];
#pragma unroll
            for (int d0 = 0; d0 < 4; ++d0) { qr[d0] = *(const LAS bf16x8*)(qp0 + d0 * 1024); kf[2 * d0] = *(const LAS bf16x8*)(kp0 + sl + d0 * 2048); kf[2 * d0 + 1] = *(const LAS bf16x8*)(kp0 + sl + d0 * 2048 + 512); }
#define LOAD_VF() do { _Pragma("unroll") for (int i = 0; i < 8; ++i) { const s16x4 lo = vtr(vp0 + sl + (i >> 2) * 4096 + (i & 3) * 1024), hh = vtr(vp0 + sl + (i >> 2) * 4096 + (i & 3) * 1024 + 512); \
                vf[i] = (bf16x8){lo[0], lo[1], lo[2], lo[3], hh[0], hh[1], hh[2], hh[3]}; } } while (0)
            const bool diag = (t == my_last);
            const int kv0 = 64 * t + 4 * hi;
            const f32x16 z16 = f32x16{};
            if constexpr (MODE == 0) {
                f32x16 paA = MFMA32(kf[0], qr[0], nm); paA = MFMA32(kf[2], qr[1], paA);
                f32x16 pbA = MFMA32(kf[1], qr[0], nm); pbA = MFMA32(kf[3], qr[1], pbA);
                f32x16 paB = MFMA32(kf[4], qr[2], nm); paB = MFMA32(kf[6], qr[3], paB);
                f32x16 pbB = MFMA32(kf[5], qr[2], nm); pbB = MFMA32(kf[7], qr[3], pbB);
                if ((t & 7) == 0) {
                int ti = imax(imax(__float_as_int(paA[0]), __float_as_int(pbA[0])), imax(__float_as_int(paB[0]), __float_as_int(pbB[0])));
#pragma unroll
                for (int r = 1; r < 16; ++r) ti = imax(imax(ti, imax(__float_as_int(paA[r]), __float_as_int(pbA[r]))), imax(__float_as_int(paB[r]), __float_as_int(pbB[r])));
                ti = imax_x32(ti);
                if (t == 0 || __any(ti > 0x41000000)) {
                    const float tmf = __int_as_float(ti); const float dl = (t == 0) ? tmf : fmaxf(tmf, 0.f); mref += dl;
#pragma unroll
                    for (int r = 0; r < 16; ++r) { paA[r] -= dl; pbA[r] -= dl; paB[r] -= dl; pbB[r] -= dl; nm[r] = -mref; }
                    if (t > 0) { const float f = __builtin_amdgcn_exp2f(-dl); lA *= f; lB *= f; oA[0] = oA[0] * f; oA[1] = oA[1] * f; oB[0] = oB[0] * f; oB[1] = oB[1] * f; } }
                }
                if (diag) {
#pragma unroll
                    for (int r = 0; r < 16; ++r) { const int kv = kv0 + (r & 3) + 8 * (r >> 2); if (kv > qabs) { paA[r] = -1e30f; paB[r] = -1e30f; } if (kv + 32 > qabs) { pbA[r] = -1e30f; pbB[r] = -1e30f; } } }
#define EXP_PACK(pa, pb, L_, pf) do { \
                float rs0 = 0.f, rs1 = 0.f; \
                  \
                _Pragma("unroll") for (int r = 0; r < 16; ++r) { pa[r] = __builtin_amdgcn_exp2f(pa[r]); pb[r] = __builtin_amdgcn_exp2f(pb[r]); rs0 += pa[r]; asm("" : "+v"(rs0)); rs1 += pb[r]; asm("" : "+v"(rs1)); } \
                L_ += rs0 + rs1; \
                PROBE_EXTRA_EXP(pa, pb); \
                _Pragma("unroll") for (int s = 0; s < 2; ++s) { \
                    u32x4 w0, w1; \
                    w0.x = pk2(pa[8 * s + 0], pa[8 * s + 1]); w0.y = pk2(pa[8 * s + 2], pa[8 * s + 3]); w0.z = pk2(pa[8 * s + 4], pa[8 * s + 5]); w0.w = pk2(pa[8 * s + 6], pa[8 * s + 7]); \
                    w1.x = pk2(pb[8 * s + 0], pb[8 * s + 1]); w1.y = pk2(pb[8 * s + 2], pb[8 * s + 3]); w1.z = pk2(pb[8 * s + 4], pb[8 * s + 5]); w1.w = pk2(pb[8 * s + 6], pb[8 * s + 7]); \
                    pf[s] = __builtin_bit_cast(bf16x8, w0); pf[2 + s] = __builtin_bit_cast(bf16x8, w1); } } while (0)
#define PV_ACC(O, pf) do { _Pragma("unroll") for (int dh = 0; dh < 2; ++dh) _Pragma("unroll") for (int s = 0; s < 4; ++s) O[dh] = MFMA32(vf[4 * dh + s], pf[s], O[dh]); } while (0)
                __builtin_amdgcn_sched_barrier(0);
                LOAD_VF();
                bf16x8 pfA[4], pfB[4];
                EXP_PACK(paA, pbA, lA, pfA);
                __builtin_amdgcn_sched_barrier(0);
                PV_ACC(oA, pfA);
                EXP_PACK(paB, pbB, lB, pfB);
#pragma unroll
                for (int i = 0; i < 8; ++i) { __builtin_amdgcn_sched_group_barrier(0x008, 1, 0); __builtin_amdgcn_sched_group_barrier(0x402, 10, 0); }
                __builtin_amdgcn_sched_barrier(0);
                PV_ACC(oB, pfB);
#undef EXP_PACK
#undef PV_ACC
            } else {
                f32x16 pa = MFMA32(kf[0], qr[0], z16), pb = MFMA32(kf[1], qr[0], z16);
#pragma unroll
                for (int d0 = 1; d0 < 4; ++d0) { pa = MFMA32(kf[2 * d0], qr[d0], pa); pb = MFMA32(kf[2 * d0 + 1], qr[d0], pb); }
                const int qt = (q0 + wid * 32) >> 6;
                const float tf = __builtin_amdgcn_exp2f(64.0f * (float)(qt - t) * lg2);
#pragma unroll
                for (int r = 0; r < 16; ++r) { pa[r] *= tf; pb[r] *= tf; }
                if (diag) {
#pragma unroll
                    for (int r = 0; r < 16; ++r) { const int kv = kv0 + (r & 3) + 8 * (r >> 2); if (kv > qabs) pa[r] = 0.f; if (kv + 32 > qabs) pb[r] = 0.f; } }
                LOAD_VF();
                bf16x8 pf[4];
#pragma unroll
                for (int s = 0; s < 2; ++s) {
                    u32x4 w0, w1;
                    w0.x = pk2(pa[8 * s + 0], pa[8 * s + 1]); w0.y = pk2(pa[8 * s + 2], pa[8 * s + 3]); w0.z = pk2(pa[8 * s + 4], pa[8 * s + 5]); w0.w = pk2(pa[8 * s + 6], pa[8 * s + 7]);
                    w1.x = pk2(pb[8 * s + 0], pb[8 * s + 1]); w1.y = pk2(pb[8 * s + 2], pb[8 * s + 3]); w1.z = pk2(pb[8 * s + 4], pb[8 * s + 5]); w1.w = pk2(pb[8 * s + 6], pb[8 * s + 7]);
                    pf[s] = __builtin_bit_cast(bf16x8, w0); pf[2 + s] = __builtin_bit_cast(bf16x8, w1); }
#pragma unroll
                for (int dh = 0; dh < 2; ++dh)
#pragma unroll
                    for (int s = 0; s < 4; ++s) oA[dh] = MFMA32(vf[4 * dh + s], pf[s], oA[dh]);
            }
        }
    }
#undef DMA_K
#undef DMA_V
#undef LOAD_VF
    const size_t mrow = rowbase + qabs;
    if constexpr (MODE == 0) {
        lA = sum_x32(lA); lB = sum_x32(lB);
        const float rA = 1.0f / lA, rB = lam / lB;
        float ss = 0.f;
#pragma unroll
        for (int dh = 0; dh < 2; ++dh)
#pragma unroll
            for (int r = 0; r < 16; ++r) { const float v = oA[dh][r] * rA - oB[dh][r] * rB; oA[dh][r] = v; ss += v * v; }
        ss = sum_x32(ss);
        float li_ = lam_init; asm volatile("" : "+v"(li_));
        const float rn = (1.0f / sqrtf(ss * (1.f / 64.f) + EPS)) * (1.0f - li_);
#pragma unroll
        for (int dh = 0; dh < 2; ++dh)
#pragma unroll
            for (int g = 0; g < 4; ++g) { const int d = 32 * dh + 8 * g + 4 * hi; const f32x4 sg = *(const f32x4*)(subg + d);
                u32x2 w; w.x = pk2(oA[dh][4 * g] * rn * sg[0], oA[dh][4 * g + 1] * rn * sg[1]); w.y = pk2(oA[dh][4 * g + 2] * rn * sg[2], oA[dh][4 * g + 3] * rn * sg[3]);
                *(u32x2*)(Y + mrow * D + RW + 64 * h + d) = w; }
    } else {
        float ss = 0.f;
#pragma unroll
        for (int dh = 0; dh < 2; ++dh)
#pragma unroll
            for (int r = 0; r < 16; ++r) ss += oA[dh][r] * oA[dh][r];
        ss = sum_x32(ss);
        const float rn = 1.0f / sqrtf(ss * (1.f / 64.f) + EPS);
#pragma unroll
        for (int dh = 0; dh < 2; ++dh)
#pragma unroll
            for (int g = 0; g < 4; ++g) { const int d = 32 * dh + 8 * g + 4 * hi; const u32x2 tg = *(const u32x2*)(PROJ + mrow * NINP + C_TG + 64 * h + d);
                u32x2 w; w.x = pk2(siluf_(bflo(tg.x)) * oA[dh][4 * g] * rn, siluf_(bfhi(tg.x)) * oA[dh][4 * g + 1] * rn); w.y = pk2(siluf_(bflo(tg.y)) * oA[dh][4 * g + 2] * rn, siluf_(bfhi(tg.y)) * oA[dh][4 * g + 3] * rn);
                *(u32x2*)(Y + mrow * D + 768 + 64 * h + d) = w; }
    }
}

namespace rseq { constexpr int SLOT = 40960, KB_ = 0, KT_ = 8192, VT_ = 16384, QB_ = 24576, TG_ = 32768, RS_ = 139264, RSB = 8192; }
__device__ __forceinline__ void ret_seq(int b, int h, const bf16_t* PROJ, bf16_t* Y, LAS unsigned char* lds) {
    using namespace rseq;
    int tid_ = threadIdx.x; asm volatile("" : "+v"(tid_));
    const int tid = tid_, lane = tid & 63, r32 = lane & 31, hi = lane >> 5; const int wid = __builtin_amdgcn_readfirstlane(tid >> 6);
    const size_t rowbase = (size_t)b * T;
    const unsigned lds0 = (unsigned)(uintptr_t)lds;
    const bf16_t* kb_src = PROJ + (rowbase + lane) * NINP + C_TK + 64 * h + wid * 8;
    const bf16_t* qb_src = PROJ + (rowbase + lane) * NINP + C_TQ + 64 * h + wid * 8;
    const size_t tr_off = (size_t)(16 * (wid & 3) + (lane >> 2)) * NINP + (wid >> 2) * 32 + (lane & 3) * 8;
    const bf16_t* kt_src = PROJ + rowbase * NINP + C_TK + 64 * h + tr_off;
    const bf16_t* vt_src = PROJ + rowbase * NINP + C_TV + 64 * h + tr_off;
    const bf16_t* tg_src = PROJ + (rowbase + 8 * wid + (lane >> 3)) * NINP + C_TG + 64 * h + (lane & 7) * 8;
#define RS_DMA(blk, slot_) do { const size_t go_ = (size_t)(blk) * 64 * NINP; const unsigned d_ = lds0 + (slot_) * SLOT + wid * 1024; \
        glds16(kb_src + go_, (unsigned)__builtin_amdgcn_readfirstlane(d_ + KB_)); glds16(kt_src + go_, (unsigned)__builtin_amdgcn_readfirstlane(d_ + KT_)); \
        glds16(vt_src + go_, (unsigned)__builtin_amdgcn_readfirstlane(d_ + VT_)); glds16(qb_src + go_, (unsigned)__builtin_amdgcn_readfirstlane(d_ + QB_)); \
        glds16(tg_src + go_, (unsigned)__builtin_amdgcn_readfirstlane(d_ + TG_)); } while (0)
    RS_DMA(0, 0); RS_DMA(1, 1);
    { unsigned z = 0u; asm volatile("" : "+v"(z)); for (int i = tid; i < RSB / 16; i += 512) ((LAS u32x4*)(lds + RS_))[i] = (u32x4){z, z, z, z}; }
    const int qh = wid & 1;
    const int dvh = (wid >> 1) & 1, dkh = wid & 1;
    f32x16 Rq = f32x16{};
    const float g64 = __builtin_amdgcn_exp2f(64.0f * lg2gamma(h));
    const lds_cptr trb = (lds_cptr)lds + ((lane >> 4) & 1) * 32 + (lane & 3) * 8 + (4 * hi + ((lane & 15) >> 2)) * 64;
    for (int i = 0; i < T / 64; ++i) {
        if (i + 1 < T / 64) { if (wid < 2 && i > 0) asm volatile("s_waitcnt vmcnt(13) lgkmcnt(0)\n\ts_barrier" ::: "memory"); else asm volatile("s_waitcnt vmcnt(5) lgkmcnt(0)\n\ts_barrier" ::: "memory"); }
        else asm volatile("s_waitcnt vmcnt(0) lgkmcnt(0)\n\ts_barrier" ::: "memory");
        const int sl = (i % 3) * SLOT, rb = (i & 1) * RSB;
        if (i + 2 < T / 64) RS_DMA(i + 2, (i + 2) % 3);
        if (wid < 2) {
            bf16x8 kf[8], qr[4];
#pragma unroll
            for (int d0 = 0; d0 < 4; ++d0) { qr[d0] = *(const LAS bf16x8*)((lds_cptr)lds + sl + QB_ + (2 * d0 + hi) * 1024 + (32 * qh + r32) * 16);
                kf[2 * d0] = *(const LAS bf16x8*)((lds_cptr)lds + sl + KB_ + (2 * d0 + hi) * 1024 + r32 * 16); kf[2 * d0 + 1] = *(const LAS bf16x8*)((lds_cptr)lds + sl + KB_ + (2 * d0 + hi) * 1024 + 512 + r32 * 16); }
            const f32x16 z16 = f32x16{};
            f32x16 pa = MFMA32(kf[0], qr[0], z16), pb = z16;
#pragma unroll
            for (int d0 = 1; d0 < 4; ++d0) pa = MFMA32(kf[2 * d0], qr[d0], pa);
            if (qh) {
#pragma unroll
                for (int d0 = 0; d0 < 4; ++d0) pb = MFMA32(kf[2 * d0 + 1], qr[d0], pb); }
#pragma unroll
            for (int r = 0; r < 16; ++r) { const int kv = (r & 3) + 8 * (r >> 2) + 4 * hi;
                if (qh == 0) { if (kv > r32) pa[r] = 0.f; }
                else { if (kv > r32) pb[r] = 0.f; } }
            bf16x8 pf[4];
#pragma unroll
            for (int s = 0; s < 2; ++s) { u32x4 w0, w1;
                w0.x = pk2(pa[8 * s + 0], pa[8 * s + 1]); w0.y = pk2(pa[8 * s + 2], pa[8 * s + 3]); w0.z = pk2(pa[8 * s + 4], pa[8 * s + 5]); w0.w = pk2(pa[8 * s + 6], pa[8 * s + 7]);
                w1.x = pk2(pb[8 * s + 0], pb[8 * s + 1]); w1.y = pk2(pb[8 * s + 2], pb[8 * s + 3]); w1.z = pk2(pb[8 * s + 4], pb[8 * s + 5]); w1.w = pk2(pb[8 * s + 6], pb[8 * s + 7]);
                pf[s] = __builtin_bit_cast(bf16x8, w0); pf[2 + s] = __builtin_bit_cast(bf16x8, w1); }
            f32x16 o[2]; o[0] = z16; o[1] = z16;
#pragma unroll
            for (int dh = 0; dh < 2; ++dh)
#pragma unroll
                for (int s = 0; s < 4; ++s) {
                    if (s < 2 || qh) { const s16x4 lo = vtr(trb + sl + VT_ + dh * 4096 + s * 1024), hh = vtr(trb + sl + VT_ + dh * 4096 + s * 1024 + 512);
                        o[dh] = MFMA32(((bf16x8){lo[0], lo[1], lo[2], lo[3], hh[0], hh[1], hh[2], hh[3]}), pf[s], o[dh]); }
                    const bf16x8 rf = *(const LAS bf16x8*)((lds_cptr)lds + RS_ + rb + (2 * s + hi) * 1024 + (32 * dh + r32) * 16);
                    o[dh] = MFMA32(rf, qr[s], o[dh]); }
            const size_t mrow = rowbase + (size_t)i * 64 + 32 * qh + r32;
            float ss = 0.f;
#pragma unroll
            for (int dh = 0; dh < 2; ++dh)
#pragma unroll
                for (int r = 0; r < 16; ++r) ss += o[dh][r] * o[dh][r];
            ss = sum_x32(ss);
            const float rn = 1.0f / sqrtf(ss * (1.f / 64.f) + EPS);
#pragma unroll
            for (int dh = 0; dh < 2; ++dh)
#pragma unroll
                for (int g = 0; g < 4; ++g) { const int d = 32 * dh + 8 * g + 4 * hi; const u32x2 tg = *(const LAS u32x2*)((lds_cptr)lds + sl + TG_ + (32 * qh + r32) * 128 + d * 2);
                    u32x2 w; w.x = pk2(siluf_(bflo(tg.x)) * o[dh][4 * g] * rn, siluf_(bfhi(tg.x)) * o[dh][4 * g + 1] * rn); w.y = pk2(siluf_(bflo(tg.y)) * o[dh][4 * g + 2] * rn, siluf_(bfhi(tg.y)) * o[dh][4 * g + 3] * rn);
                    *(u32x2*)(Y + mrow * D + 768 + 64 * h + d) = w; }
        } else if (wid >= 4) {
#pragma unroll
            for (int s = 0; s < 4; ++s) {
                const s16x4 vl = vtr(trb + sl + VT_ + dvh * 4096 + s * 1024), vh = vtr(trb + sl + VT_ + dvh * 4096 + s * 1024 + 512);
                const s16x4 kl = vtr(trb + sl + KT_ + dkh * 4096 + s * 1024), kh = vtr(trb + sl + KT_ + dkh * 4096 + s * 1024 + 512);
                Rq = MFMA32(((bf16x8){vl[0], vl[1], vl[2], vl[3], vh[0], vh[1], vh[2], vh[3]}), ((bf16x8){kl[0], kl[1], kl[2], kl[3], kh[0], kh[1], kh[2], kh[3]}), Rq); }
            Rq = Rq * g64;
            LAS bf16_t* rs = (LAS bf16_t*)(lds + RS_ + (RSB - rb));
            const int dk = 32 * dkh + r32;
#pragma unroll
            for (int r = 0; r < 16; ++r) { const int dv = 32 * dvh + (r & 3) + 8 * (r >> 2) + 4 * hi; rs[(dk >> 3) * 512 + dv * 8 + (dk & 7)] = (bf16_t)(pk2(Rq[r], 0.f) & 0xffffu); }
        }
    }
    asm volatile("s_waitcnt lgkmcnt(0)\n\ts_barrier" ::: "memory");
#undef RS_DMA
}

__device__ __forceinline__ float em1(float x) {
    if (x > -0.25f) { float p = 1.f / 720.f; p = p * x + 1.f / 120.f; p = p * x + 1.f / 24.f; p = p * x + 1.f / 6.f; p = p * x + 0.5f; p = p * x + 1.f; return p * x; }
    return expm1f(x);
}
template <int DD> __device__ __forceinline__ float dpp_shr(float v) { return __int_as_float(__builtin_amdgcn_update_dpp(__float_as_int(v), __float_as_int(v), 0x110 + DD, 0xF, 0xF, false)); }
template <int DD> __device__ __forceinline__ f32x4 shup4(f32x4 v) { f32x4 r; r[0] = dpp_shr<DD>(v[0]); r[1] = dpp_shr<DD>(v[1]); r[2] = dpp_shr<DD>(v[2]); r[3] = dpp_shr<DD>(v[3]); return r; }
__device__ __forceinline__ float bc15f(float v) { return __int_as_float(__builtin_amdgcn_ds_swizzle(__float_as_int(v), (0x0F << 5) | 0x10)); }
__device__ __forceinline__ f32x4 bc15(f32x4 v) { f32x4 r; r[0] = bc15f(v[0]); r[1] = bc15f(v[1]); r[2] = bc15f(v[2]); r[3] = bc15f(v[3]); return r; }
template <int PASS>
__device__ __forceinline__ void rglru_item(int wi, const bf16_t* PROJ, const bf16_t* GWl, const float* SP8l, const float* cw, const float* cb, const float* ba, const float* bx, float* AGGA, float* AGGB, bf16_t* Y, int lane_in) {
    int lane = lane_in; asm volatile("" : "+v"(lane));
    const int fr = lane & 15, fq = lane >> 4;
    const int h = wi % 6, chunk = (wi / 6) & 63, b = wi / 384;
    const long m0 = (long)b * T + chunk * 64;
    const int chb = 64 * h + 4 * fq;
    bf16x8 wf[2][4][2];
#pragma unroll
    for (int g = 0; g < 2; ++g)
#pragma unroll
        for (int nbo = 0; nbo < 4; ++nbo)
#pragma unroll
            for (int ks = 0; ks < 2; ++ks) { const bf16_t* p = GWl + (((size_t)g * 6 + h) * 64 + 16 * nbo + fr) * 64 + 32 * ks + 4 * fq; const u32x2 lo = *(const u32x2*)p, hi2 = *(const u32x2*)(p + 16);
                wf[g][nbo][ks] = __builtin_bit_cast(bf16x8, (u32x4){lo.x, lo.y, hi2.x, hi2.y}); }
    f32x4 bav[4], bxv[4], spv[4], hc[4], At[4];
#pragma unroll
    for (int nb = 0; nb < 4; ++nb) { bav[nb] = *(const f32x4*)(ba + chb + 16 * nb); bxv[nb] = *(const f32x4*)(bx + chb + 16 * nb); spv[nb] = *(const f32x4*)(SP8l + chb + 16 * nb);
        hc[nb] = (f32x4){0.f, 0.f, 0.f, 0.f}; At[nb] = (f32x4){1.f, 1.f, 1.f, 1.f}; }
#define KS_STEP(DD, A_, B_) do { const f32x4 As = shup4<DD>(A_), Bs = shup4<DD>(B_); if (fr >= DD) { B_ = A_ * Bs + B_; A_ = A_ * As; } } while (0)
    if constexpr (PASS == 2) {
        f32x4 FA[4], FB[4];
#pragma unroll
        for (int nb = 0; nb < 4; ++nb) { FA[nb] = (f32x4){1.f, 1.f, 1.f, 1.f}; FB[nb] = (f32x4){0.f, 0.f, 0.f, 0.f}; }
#pragma unroll
        for (int k = 0; k < 4; ++k) { const int ci = 4 * fr + k;
            if (ci < chunk) {
#pragma unroll
                for (int nb = 0; nb < 4; ++nb) { const size_t o = ((size_t)(b * 64 + ci)) * RW + chb + 16 * nb; const f32x4 a = *(const f32x4*)(AGGA + o), bb = *(const f32x4*)(AGGB + o);
                    FB[nb] = a * FB[nb] + bb; FA[nb] = a * FA[nb]; } } }
#pragma unroll
        for (int nb = 0; nb < 4; ++nb) { KS_STEP(1, FA[nb], FB[nb]); KS_STEP(2, FA[nb], FB[nb]); KS_STEP(4, FA[nb], FB[nb]); KS_STEP(8, FA[nb], FB[nb]); }
#pragma unroll
        for (int nb = 0; nb < 4; ++nb) hc[nb] = bc15(FB[nb]);
    }
#pragma unroll 1
    for (int mb = 0; mb < 4; ++mb) {
        const int tl = 16 * mb + fr;
        f32x4 xc[4];
#pragma unroll
        for (int nb = 0; nb < 4; ++nb) { f32x4 acc = *(const f32x4*)(cb + chb + 16 * nb);
#pragma unroll
            for (int j = 0; j < 4; ++j) { const int tj = tl - 3 + j;
                if (chunk > 0 || tj >= 0) { const u32x2 w = *(const u32x2*)(PROJ + (size_t)(m0 + tj) * NINP + C_RX + chb + 16 * nb); const f32x4 cwv = *(const f32x4*)(cw + j * RW + chb + 16 * nb);
                    acc += cwv * (f32x4){bflo(w.x), bfhi(w.x), bflo(w.y), bfhi(w.y)}; } }
            xc[nb] = acc; }
        bf16x8 bfr[2];
#pragma unroll
        for (int ks = 0; ks < 2; ++ks) { u32x4 w; w.x = pk2(xc[2 * ks][0], xc[2 * ks][1]); w.y = pk2(xc[2 * ks][2], xc[2 * ks][3]); w.z = pk2(xc[2 * ks + 1][0], xc[2 * ks + 1][1]); w.w = pk2(xc[2 * ks + 1][2], xc[2 * ks + 1][3]);
            bfr[ks] = __builtin_bit_cast(bf16x8, w); }
#pragma unroll
        for (int nb = 0; nb < 4; ++nb) {
            f32x4 ra = bav[nb], ia = bxv[nb];
#pragma unroll
            for (int ks = 0; ks < 2; ++ks) { ra = MFMA16(wf[0][nb][ks], bfr[ks], ra); ia = MFMA16(wf[1][nb][ks], bfr[ks], ia); }
            f32x4 A, B;
#pragma unroll
            for (int r = 0; r < 4; ++r) { const float rg = sigmoidf_(ra[r]), ig = sigmoidf_(ia[r]); const float la = spv[nb][r] * rg;
                A[r] = 1.0f + em1(la); B[r] = sqrtf(-em1(2.0f * la)) * ig * xc[nb][r]; }
            KS_STEP(1, A, B); KS_STEP(2, A, B); KS_STEP(4, A, B); KS_STEP(8, A, B);
            const f32x4 hv = B + A * hc[nb];
            hc[nb] = bc15(hv);
            if constexpr (PASS == 1) { At[nb] = At[nb] * bc15(A); }
            else { const size_t mr = (size_t)(m0 + tl); const u32x2 gw = *(const u32x2*)(PROJ + mr * NINP + C_RG + chb + 16 * nb);
                u32x2 w; w.x = pk2(gelu_tanh(bflo(gw.x)) * hv[0], gelu_tanh(bfhi(gw.x)) * hv[1]); w.y = pk2(gelu_tanh(bflo(gw.y)) * hv[2], gelu_tanh(bfhi(gw.y)) * hv[3]);
                *(u32x2*)(Y + mr * D + chb + 16 * nb) = w; }
        }
    }
    if constexpr (PASS == 1) {
        if (fr == 15) {
#pragma unroll
            for (int nb = 0; nb < 4; ++nb) { const size_t o = ((size_t)(b * 64 + chunk)) * RW + chb + 16 * nb; *(f32x4*)(AGGA + o) = At[nb]; *(f32x4*)(AGGB + o) = hc[nb]; } }
    }
}
#undef KS_STEP
#undef MFMA32
#undef MFMA16
}

constexpr int NWAVES = 8;
struct Args { const float* in[27]; const int* pos; float* out; unsigned char* ws; float lam_init[4]; int ph_lo, ph_hi, li, pad; };
constexpr int PH_L0 = 3, NPH = 8, PH_FINAL = PH_L0 + NL * NPH, PH_END = PH_FINAL + 1;

struct Frame { LAS unsigned char* lds; int wave, vcu, G, gw, NGW; };

template <class Map>
__device__ __forceinline__ void transpose_item(const float* W, int K, int Nsrc, bf16_t* WT, int NT, LAS float* scr, int item, int lane, Map src, bool tiled = false) {
    const int nblk = NT / 32, kb = item / nblk, nb = item % nblk, k0 = 64 * kb, n0 = 32 * nb;
    const int sc = src(n0 + (lane & 31));
    float wv_[32];
#pragma unroll
    for (int i = 0; i < 32; ++i) { const int kk = 2 * i + (lane >> 5); wv_[i] = sc >= 0 ? __builtin_nontemporal_load(W + (size_t)(k0 + kk) * Nsrc + sc) : 0.f; }
#pragma unroll
    for (int i = 0; i < 32; ++i) { const int kk = 2 * i + (lane >> 5); scr[kk * 33 + (lane & 31)] = wv_[i]; }
    LDS_WAIT(); asm volatile("" ::: "memory");
    const int c = lane & 7;
#pragma unroll
    for (int j = 0; j < 4; ++j) { const int n = (lane >> 3) + 8 * j; const LAS float* s = scr + (8 * c) * 33 + n;
        u32x4 o; o.x = pk2(s[0 * 33], s[1 * 33]); o.y = pk2(s[2 * 33], s[3 * 33]); o.z = pk2(s[4 * 33], s[5 * 33]); o.w = pk2(s[6 * 33], s[7 * 33]);
        const size_t off = tiled ? (((size_t)((n0 + n) >> 8) * (K / 64) + kb) * 256 + ((n0 + n) & 255)) * 64 + 8 * c : (size_t)(n0 + n) * K + k0 + 8 * c;
        *(GAS u32x4*)(WT + off) = o; }
    LDS_WAIT(); asm volatile("" ::: "memory");
}
struct MapId { __device__ __forceinline__ int operator()(int n) const { return n; } };
struct MapFfnIn { __device__ __forceinline__ int operator()(int n) const { const int pn = n >> 8, bj = (n >> 7) & 1, cc = n & 127; return bj * F + pn * 128 + cc; } };
__device__ __forceinline__ int ret_dim(int pos) { const int w = pos >> 5, rem = pos & 31, fq = rem >> 3, n = (rem >> 2) & 1, j = rem & 3; return 32 * n + 16 * w + 4 * fq + j; }
struct MapMixIn { __device__ __forceinline__ int operator()(int p) const {
    if (p < C_DK) return 768 + p;
    if (p < C_TQ) return 1152 + (p - C_DK);
    if (p < C_TK) { const int q = p - C_TQ; return 1920 + (q & ~63) + ret_dim(q & 63); }
    if (p < C_DV) { const int q = p - C_TK; return 2176 + (q & ~63) + ret_dim(q & 63); }
    if (p < C_TV) return 1536 + (p - C_DV);
    if (p < C_TG) return 2432 + (p - C_TV);
    if (p < C_RX) return 2688 + (p - C_TG);
    if (p < C_RG) return p - C_RX;
    if (p < NIN) return 384 + (p - C_RG);
    return -1; } };

constexpr int I_FI = (D / 64) * (2 * F / 32), I_FO = (F / 64) * (D / 32), I_MI = (D / 64) * (NINP / 32), I_MO = (D / 64) * (D / 32), CONV_ITEMS_L = 2 * I_FI + 2 * I_FO + I_MI + I_MO;
constexpr int CONV_WG_ITEMS = (CONV_ITEMS_L + NWAVES - 1) / NWAVES;
struct ConvSrc { const float *f1i, *f1o, *f2i, *f2o, *mi, *mo; };
__device__ __forceinline__ void conv_item(const ConvSrc cs, unsigned char* ws, int l, int r, LAS float* scr, int lane) {
    unsigned char* wl = ws + WS_W + (size_t)l * W_L;
    if (r < I_FI) { transpose_item(cs.f1i + (size_t)l * D * 2 * F, D, 2 * F, (bf16_t*)(wl + W_1IN), 2 * F, scr, r, lane, MapFfnIn()); return; } r -= I_FI;
    if (r < I_FI) { transpose_item(cs.f2i + (size_t)l * D * 2 * F, D, 2 * F, (bf16_t*)(wl + W_2IN), 2 * F, scr, r, lane, MapFfnIn()); return; } r -= I_FI;
    if (r < I_FO) { transpose_item(cs.f1o + (size_t)l * F * D, F, D, (bf16_t*)(wl + W_1OUT), D, scr, r, lane, MapId(), true); return; } r -= I_FO;
    if (r < I_FO) { transpose_item(cs.f2o + (size_t)l * F * D, F, D, (bf16_t*)(wl + W_2OUT), D, scr, r, lane, MapId(), true); return; } r -= I_FO;
    if (r < I_MI) { transpose_item(cs.mi + (size_t)l * D * NIN, D, NIN, (bf16_t*)(wl + W_IN), NINP, scr, r, lane, MapMixIn()); return; } r -= I_MI;
    transpose_item(cs.mo + (size_t)l * D * D, D, D, (bf16_t*)(wl + W_OUT), D, scr, r, lane, MapId());
}
__device__ __forceinline__ void bias_layer(unsigned char* ws, int l, int gw, int ngw, int lane) {
    const float* MOD = (const float*)(ws + WS_MOD); float* BIAS = (float*)(ws + WS_BIAS);
    for (int g = 0; g < 3; ++g) {
        const int lg = l * 3 + g; const int Nw = (g == 1) ? NINP : 2 * F;
        const bf16_t* Wt = (const bf16_t*)(ws + WS_W + (size_t)l * W_L + (g == 0 ? W_1IN : g == 1 ? W_IN : W_2IN));
        f32x4 Sv[4][4];
#pragma unroll
        for (int b = 0; b < 4; ++b)
#pragma unroll
            for (int q = 0; q < 4; ++q) Sv[b][q] = *(const f32x4*)(MOD + ((size_t)l * NB + b) * NMD + (3 * g) * D + 16 * lane + 4 * q);
        for (int n = gw; n < Nw; n += ngw) {
            const u32x4 w0 = *(const u32x4*)(Wt + (size_t)n * D + 16 * lane), w1 = *(const u32x4*)(Wt + (size_t)n * D + 16 * lane + 8);
            const f32x4 wv[4] = {{bflo(w0.x), bfhi(w0.x), bflo(w0.y), bfhi(w0.y)}, {bflo(w0.z), bfhi(w0.z), bflo(w0.w), bfhi(w0.w)}, {bflo(w1.x), bfhi(w1.x), bflo(w1.y), bfhi(w1.y)}, {bflo(w1.z), bfhi(w1.z), bflo(w1.w), bfhi(w1.w)}};
            float acc4[4];
#pragma unroll
            for (int b = 0; b < 4; ++b) { f32x4 a = Sv[b][0] * wv[0] + Sv[b][1] * wv[1] + Sv[b][2] * wv[2] + Sv[b][3] * wv[3]; acc4[b] = wave_sum((a[0] + a[1]) + (a[2] + a[3])); }
            if (lane < 4) BIAS[((size_t)lg * NB + lane) * (2 * F) + n] = lane == 0 ? acc4[0] : lane == 1 ? acc4[1] : lane == 2 ? acc4[2] : acc4[3];
        }
    }
}

__global__ void __launch_bounds__(NWAVES * 64, 2) mega(Args args) {
    Frame FR;
    FR.lds = (LAS unsigned char*)lds_raw;
    volatile LAS unsigned* MISC = (volatile LAS unsigned*)(FR.lds + MISC_OFF);
    FR.wave = __builtin_amdgcn_readfirstlane((int)threadIdx.x >> 6);
    FR.G = gridDim.x; { const int bx = blockIdx.x; FR.vcu = (FR.G % 8 == 0) ? (bx % 8) * (FR.G / 8) + bx / 8 : bx; }
    FR.gw = FR.vcu * NWAVES + FR.wave; FR.NGW = FR.G * NWAVES;
    unsigned char* ws = args.ws;
    gu32* ctl = (gu32*)(ws + WS_CTL);
    for (int u = (int)threadIdx.x; u < (LDS_BYTES - LDSCTL_OFF) / 4; u += NWAVES * 64) ((LAS unsigned*)(FR.lds + LDSCTL_OFF))[u] = 0u;
    __syncthreads();
    const int lo = args.ph_lo, hi = args.ph_hi;
    if (MK_ONE_LAUNCH || hi - lo > 1) (void)xcd_barrier_post((unsigned*)(ctl + CW_BAR) + args.li * XCD_BAR_WORDS, MISC + 8);
#define bar (XcdBarrier{(unsigned*)((gu32*)(args.ws + WS_CTL) + CW_BAR) + args.li * XCD_BAR_WORDS, xb_xcc_id(), (volatile LAS unsigned*)((LAS unsigned char*)lds_raw + MISC_OFF) + 8})
#if MK_ONE_LAUNCH
#define IN(k) true
#if PROBE_BAR2
#define SEAM(k) do { xcd_barrier(bar); xcd_barrier(bar); } while (0)
#else
#define SEAM(k) xcd_barrier(bar)
#endif
#else
#define IN(k) (lo <= (k) && (k) < hi)
#define SEAM(k) do { if (IN(k) && IN((k) + 1)) xcd_barrier(bar); } while (0)
#endif
    float* X = (float*)(ws + WS_X); bf16_t* H = (bf16_t*)(ws + WS_H); bf16_t* Y = (bf16_t*)(ws + WS_Y); bf16_t* ACT = (bf16_t*)(ws + WS_ACT); bf16_t* PROJ = (bf16_t*)(ws + WS_PROJ);
    float* MODP = (float*)(ws + WS_MODP); float* MOD = (float*)(ws + WS_MOD); float* TABD = (float*)(ws + WS_TABD); float* TABR = (float*)(ws + WS_TABR);

    float* ANORM = (float*)(ws + WS_ANORM); float* BIAS = (float*)(ws + WS_BIAS); float* SSQ = (float*)(ws + WS_SSQ); bf16_t* XS = H;
    for (int repp = 0; repp < PROBE_REPP; ++repp) {
    if (IN(0)) {
        for (int i = FR.gw * 64 + lane_id(); i < M * 36; i += FR.NGW * 64) {
            const int m = i / 36, f = i % 36; const float p = (float)args.pos[m];
            if (f < 4) { const float inv = powf(500000.0f, -0.25f * (float)f); float s, c; sincosf(p * (f == 0 ? 1.0f : inv), &s, &c); TABD[m * 8 + f] = c; TABD[m * 8 + 4 + f] = s; }
            else { const int g = f - 4; const float inv = powf(10000.0f, -(float)g * (2.0f / 64.0f)); float s, c; sincosf(p * inv, &s, &c); TABR[m * 64 + g] = c; TABR[m * 64 + 32 + g] = s; }
        }
        LAS float* sc = (LAS float*)(FR.lds + RING_OFF);
        for (int i = (int)threadIdx.x; i < NB * D; i += NWAVES * 64) sc[i] = siluf_(args.in[1][i]);
        __syncthreads();
        for (int it = FR.gw; it < NL * NKC * (NMD / 256); it += FR.NGW) {
            const int nb = it % (NMD / 256), kc = (it / (NMD / 256)) % NKC, l = it / ((NMD / 256) * NKC);
            const float* W = args.in[6] + ((size_t)l * D + kc * KC) * NMD + nb * 256 + lane_id() * 4;
            f32x4 a0 = {0, 0, 0, 0}, a1 = a0, a2 = a0, a3 = a0;
#pragma unroll 8
            for (int k = 0; k < KC; ++k) { const f32x4 w = __builtin_nontemporal_load((const GAS f32x4*)(W + (size_t)k * NMD)); const int kk = kc * KC + k;
                a0 += w * sc[kk]; a1 += w * sc[D + kk]; a2 += w * sc[2 * D + kk]; a3 += w * sc[3 * D + kk]; }
            float* P = MODP + ((size_t)(kc * NL + l) * NB) * NMD + nb * 256 + lane_id() * 4;
            *(f32x4*)(P) = a0; *(f32x4*)(P + NMD) = a1; *(f32x4*)(P + 2 * NMD) = a2; *(f32x4*)(P + 3 * NMD) = a3;
        }
        __syncthreads();
        { LAS float* scr = (LAS float*)(FR.lds + RING_OFF + FR.wave * 16384);
          for (int it = FR.gw; it < CONV_ITEMS_L; it += FR.NGW) conv_item(ConvSrc{args.in[8], args.in[9], args.in[10], args.in[11], args.in[12], args.in[13]}, ws, 0, it, scr, lane_id()); }
        __syncthreads();
    }
    SEAM(0);
    if (IN(1)) {
        for (int i = FR.gw * 64 + lane_id(); i < NL * NB * NMD; i += FR.NGW * 64) {
            const int l = i / (NB * NMD), b = (i / NMD) % NB, n = i % NMD; float s = args.in[7][l * NMD + n];
            for (int kc = 0; kc < NKC; ++kc) s += MODP[(size_t)kc * NL * NB * NMD + i];
            MOD[i] = s;
            const int part = n / D, k = n % D;
            if (part % 3 == 1) { const int j = part / 3; ANORM[(((size_t)l * 3 + j) * NB + b) * D + k] = args.in[3 + j][l * D + k] * (1.0f + s); } }
        { bf16_t* GW = (bf16_t*)(ws + WS_GW); float* SP8 = (float*)(ws + WS_SP8); float* LAMS = (float*)(ws + WS_LAMS);
          for (int i = FR.gw * 64 + lane_id(); i < NL * 2 * 6 * 64 * 64; i += FR.NGW * 64) { const int in_ = i & 63, out = (i >> 6) & 63, h = (i >> 12) % 6, g = ((i >> 12) / 6) & 1, l = (i >> 12) / 12;
              const float v = args.in[g ? 18 : 16][(((size_t)l * 6 + h) * 64 + in_) * 64 + out]; GW[i] = (bf16_t)(pk2(v, 0.f) & 0xffffu); }
          for (int i = FR.gw * 64 + lane_id(); i < NL * RW; i += FR.NGW * 64) SP8[i] = -8.0f * log1pf(expf(-args.in[20][i]));
          if (FR.gw < NL) { const int l = FR.gw; float s1 = 0.f, s2 = 0.f; if (lane_id() < 32) { s1 = args.in[21][l * 32 + lane_id()] * args.in[22][l * 32 + lane_id()]; s2 = args.in[23][l * 32 + lane_id()] * args.in[24][l * 32 + lane_id()]; }
              s1 = wave_sum(s1); s2 = wave_sum(s2); if (lane_id() == 0) LAMS[l] = expf(s1) - expf(s2) + args.lam_init[l]; } }
    }
    SEAM(1);
    if (IN(2)) {
        { const int b = FR.gw >> 9; const float* ap = ANORM + (size_t)b * D; f32x4 Av[4];
#pragma unroll
          for (int jj = 0; jj < 4; ++jj) Av[jj] = *(const f32x4*)(ap + 4 * lane_id() + 256 * jj);
          for (int rr = 0; rr < 8; ++rr) { const int m = FR.gw * 8 + rr; const GAS f32x4* xr = (const GAS f32x4*)(args.in[0] + (size_t)m * D) + lane_id(); f32x4 v[4]; float s2 = 0.f;
#pragma unroll
              for (int jj = 0; jj < 4; ++jj) { v[jj] = __builtin_nontemporal_load(xr + 64 * jj); s2 += (v[jj].x * v[jj].x + v[jj].y * v[jj].y) + (v[jj].z * v[jj].z + v[jj].w * v[jj].w); }
              s2 = wave_sum(s2);
              if (lane_id() < 16) SSQ[(size_t)m * 16 + lane_id()] = lane_id() == 0 ? s2 : 0.f;
              GAS u32x2* o8 = (GAS u32x2*)(XS + (size_t)m * D) + lane_id();
#pragma unroll
              for (int jj = 0; jj < 4; ++jj) { const f32x4 h = v[jj] * Av[jj]; u32x2 w; w.x = pk2(h.x, h.y); w.y = pk2(h.z, h.w); o8[64 * jj] = w;
                  u32x2 xw; xw.x = pkh2(v[jj].x, v[jj].y); xw.y = pkh2(v[jj].z, v[jj].w); ((GAS u32x2*)((bf16_t*)(ws + WS_X) + (size_t)m * D) + lane_id())[64 * jj] = xw; } } }
        bias_layer(ws, 0, FR.gw, FR.NGW, lane_id());
        __syncthreads();
    }
    SEAM(2);

    }
    LAS float* rstd_lds = (LAS float*)(FR.lds + LDS_RSTD_OFF);
    for (int l = 0; l < NL; ++l) {
        const int pb = PH_L0 + l * NPH;
        unsigned char* wl = ws + WS_W + (size_t)l * W_L;
        const float* modl = MOD + (size_t)l * NB * NMD;
#define RSTD_TABLE(Ncols, slot) do { int tl_ = (int)threadIdx.x; asm volatile("" : "+v"(tl_)); pg8::StaticOrder S_; S_.init(M, (Ncols), FR.G, (int)blockIdx.x); const float* sq_ = SSQ + (size_t)(slot) * M * 16; \
            for (int i_ = 0; i_ < 6; ++i_) { pg8::Unit u_; if (!S_.next(i_, u_)) break; if (tl_ < 256) { const f32x4* q_ = (const f32x4*)(sq_ + ((size_t)u_.pm * 256 + tl_) * 16); \
                const f32x4 a_ = (q_[0] + q_[1]) + (q_[2] + q_[3]); rstd_lds[i_ * 256 + tl_] = 1.0f / sqrtf(((a_[0] + a_[1]) + (a_[2] + a_[3])) * (1.f / D) + EPS); } } \
            __syncthreads(); } while (0)
#define FFN_IN_PHASE(k, c, WOFF, g) do { if (IN(pb + (k))) { RSTD_TABLE(2 * F, (c) & 1); \
            pg8::Gemm g_{XS, (const bf16_t*)(wl + (WOFF)), M, 2 * F, D, 0}; pg8::StaticOrder S; S.init(M, 2 * F, FR.G, (int)blockIdx.x); pg8::EpiSwiglu E{ws, l * 3 + (g)}; \
            pg8::gemm_phase<pg8::EpiSwiglu, pg8::StaticOrder, true, MK_SP2>(FR.lds + RING_OFF, g_, S, E); } } while (0)
#define OUT_PHASE(k, c, Aop, WOFF, Kdim, gidx, coef_, jn) do { if (IN(pb + (k))) { \
            const bool last_ = (l == NL - 1) && ((jn) == 3); \
            pg8::Gemm g_{Aop, (const bf16_t*)(wl + (WOFF)), M, D, (Kdim), (Kdim) == F ? 1 : 0}; pg8::StaticOrder S; S.init(M, D, FR.G, (int)blockIdx.x); \
            pg8::EpiResid E{ws, l, (gidx), last_ ? -1 : ((jn) == 3 ? (l + 1) * 3 : l * 3 + (jn)), ((c) + 1) & 1, (coef_)}; \
            pg8::gemm_phase<pg8::EpiResid, pg8::StaticOrder, true, MK_SP2>(FR.lds + RING_OFF, g_, S, E); } } while (0)
        const int c0 = 3 * l;
        FFN_IN_PHASE(0, c0, W_1IN, 0);
#if PROBE_REPG > 1
        if (IN(pb + 0)) xcd_barrier(bar);
        FFN_IN_PHASE(0, c0, W_1IN, 0);
#endif
        SEAM(pb + 0);
        OUT_PHASE(1, c0, ACT, W_1OUT, F, 2, 0.5f, 1);
#if PROBE_REPO > 1
        xcd_barrier(bar); OUT_PHASE(1, (c0) + 2, ACT, W_1OUT, F, 2, 0.0f, 1);
#endif
        SEAM(pb + 1);
        if (IN(pb + 2)) { RSTD_TABLE(NINP, (c0 + 1) & 1);
            pg8::Gemm g{XS, (const bf16_t*)(wl + W_IN), M, NINP, D, 0}; pg8::StaticOrder S; S.init(M, NINP, FR.G, (int)blockIdx.x); pg8::EpiMixIn E{ws, l};
            pg8::gemm_phase<pg8::EpiMixIn, pg8::StaticOrder, true, MK_SP2>(FR.lds + RING_OFF, g, S, E); }
        SEAM(pb + 2);
#if !MK_NAIVE_MIX
        for (int rep5 = 0; rep5 < PROBE_REP5; ++rep5) { if (rep5) xcd_barrier(bar);
        if (IN(pb + 3)) {
            const bf16_t* GWl = (const bf16_t*)(ws + WS_GW) + (size_t)l * 2 * 6 * 64 * 64;
            const float lam = ((const float*)(ws + WS_LAMS))[l], lam_init = args.lam_init[l];
            LAS unsigned* qw = (LAS unsigned*)(FR.lds + LDSCTL_OFF + 256);
            for (;;) {
                if ((int)threadIdx.x == 0) *qw = __hip_atomic_fetch_add((unsigned*)(ctl + CW_Q + 64 * (l + NL * rep5)), 1u, RLX_AGENT);
                __syncthreads();
                const unsigned it = __builtin_amdgcn_readfirstlane(*qw);
                constexpr unsigned N_R1 = NB * 64 * 6 / NWAVES;
                if (it >= (unsigned)mix::N_ITEMS && it < (unsigned)mix::N_ITEMS + N_R1) { const int wi = (int)(it - (unsigned)mix::N_ITEMS) * NWAVES + FR.wave;
                mix::rglru_item<1>(wi, PROJ, GWl, (const float*)(ws + WS_SP8) + l * RW, args.in[14] + l * 4 * RW, args.in[15] + l * RW, args.in[17] + l * RW, args.in[19] + l * RW, (float*)(ws + WS_AGGA), (float*)(ws + WS_AGGB), Y, lane_id());
                    continue; }
                if (it >= (unsigned)mix::N_ITEMS + N_R1) {
                    const int cw = (int)(it - (unsigned)mix::N_ITEMS - N_R1);
                    if (l + 1 >= NL || cw >= CONV_WG_ITEMS) break;
                    const int r = cw * NWAVES + FR.wave;
                    if (r < CONV_ITEMS_L) conv_item(ConvSrc{args.in[8], args.in[9], args.in[10], args.in[11], args.in[12], args.in[13]}, ws, l + 1, r, (LAS float*)(FR.lds + RING_OFF + FR.wave * 16384), lane_id());
                    continue; }
                const unsigned code = mix::g_items.v[it]; const int qb = (code >> 8) & 15, bh = code & 31;
                if (code & 0x8000u) mix::ret_seq(bh >> 2, bh & 3, PROJ, Y, FR.lds + RING_OFF);
                else mix::attn_unit<0>(bh / 6, bh % 6, qb, PROJ, Y, FR.lds + RING_OFF, lam, lam_init, args.in[25] + l * 64);
            }
        } }
#endif
        SEAM(pb + 3);
#if !MK_NAIVE_MIX
        if (IN(pb + 4)) {
            const bf16_t* GWl = (const bf16_t*)(ws + WS_GW) + (size_t)l * 2 * 6 * 64 * 64;
            for (int wi = FR.gw; wi < NB * 64 * 6; wi += FR.NGW)
                mix::rglru_item<2>(wi, PROJ, GWl, (const float*)(ws + WS_SP8) + l * RW, args.in[14] + l * 4 * RW, args.in[15] + l * RW, args.in[17] + l * RW, args.in[19] + l * RW, (float*)(ws + WS_AGGA), (float*)(ws + WS_AGGB), Y, lane_id());
            if (l + 1 < NL) bias_layer(ws, l + 1, FR.gw, FR.NGW, lane_id());
        }
#endif
#if PROBE_REPR > 1
        xcd_barrier(bar);
#if !MK_NAIVE_MIX
        if (IN(pb + 4)) {
            const bf16_t* GWl = (const bf16_t*)(ws + WS_GW) + (size_t)l * 2 * 6 * 64 * 64;
            for (int wi = FR.gw; wi < NB * 64 * 6; wi += FR.NGW)
                mix::rglru_item<2>(wi, PROJ, GWl, (const float*)(ws + WS_SP8) + l * RW, args.in[14] + l * 4 * RW, args.in[15] + l * RW, args.in[17] + l * RW, args.in[19] + l * RW, (float*)(ws + WS_AGGA), (float*)(ws + WS_AGGB), Y, lane_id());
        }
#endif
#endif
        SEAM(pb + 4);
        OUT_PHASE(5, c0 + 1, Y, W_OUT, D, 5, 1.0f, 2);
#if PROBE_REPO > 1
        xcd_barrier(bar); OUT_PHASE(5, (c0 + 1) + 2, Y, W_OUT, D, 5, 0.0f, 2);
#endif
        SEAM(pb + 5);
        FFN_IN_PHASE(6, c0 + 2, W_2IN, 2);
        SEAM(pb + 6);
        OUT_PHASE(7, c0 + 2, ACT, W_2OUT, F, 8, 0.5f, 3);
#if PROBE_REPO > 1
        xcd_barrier(bar); OUT_PHASE(7, (c0 + 2) + 2, ACT, W_2OUT, F, 8, 0.0f, 3);
#endif
        SEAM(pb + 7);
    }
    if (IN(PH_FINAL)) {
        int lnf = lane_id(); asm volatile("" : "+v"(lnf));
        const float* gp = args.in[26]; f32x4 Gv[4];
#pragma unroll
        for (int jj = 0; jj < 4; ++jj) Gv[jj] = *(const f32x4*)(gp + 4 * lnf + 256 * jj);
        for (int rr = 0; rr < 8; ++rr) { const int m = FR.gw * 8 + rr; const GAS u32x2* xr = (const GAS u32x2*)((const bf16_t*)(ws + WS_X) + (size_t)m * D) + lnf; f32x4 v[4]; float s2 = 0.f;
#pragma unroll
            for (int jj = 0; jj < 4; ++jj) { const u32x2 xw = xr[64 * jj]; v[jj] = (f32x4){hlo(xw.x), hhi(xw.x), hlo(xw.y), hhi(xw.y)}; s2 += (v[jj].x * v[jj].x + v[jj].y * v[jj].y) + (v[jj].z * v[jj].z + v[jj].w * v[jj].w); }
            const float rstd = 1.0f / sqrtf(wave_sum(s2) * (1.f / D) + EPS);
            GAS f32x4* o = (GAS f32x4*)(args.out + (size_t)m * D) + lnf;
#pragma unroll
            for (int jj = 0; jj < 4; ++jj) o[64 * jj] = v[jj] * rstd * Gv[jj]; }
    }
#undef IN
#undef SEAM
#undef bar
}

__global__ void nv_conv(const bf16_t* PROJ, const float* cw, const float* cb, float* xc) {
    const int idx = blockIdx.x * 256 + threadIdx.x; if (idx >= M * RW) return;
    const int m = idx / RW, c = idx % RW, t = m & (T - 1); float s = cb[c];
    for (int j = 0; j < 4; ++j) { const int tt = t - 3 + j; if (tt >= 0) s += cw[j * RW + c] * bf2f(PROJ[(size_t)(m - 3 + j) * NINP + C_RX + c]); }
    xc[idx] = s;
}
__global__ void nv_gates(const float* xc, const float* wa, const float* ba, const float* wx, const float* bx, const float* lam, float* av, float* bv) {
    const int idx = blockIdx.x * 256 + threadIdx.x; if (idx >= M * RW) return;
    const int m = idx / RW, c = idx % RW, h = c >> 6, cc = c & 63; float sr = ba[c], si = bx[c];
    for (int i = 0; i < 64; ++i) { const float xv = xc[(size_t)m * RW + 64 * h + i]; sr += xv * wa[(h * 64 + i) * 64 + cc]; si += xv * wx[(h * 64 + i) * 64 + cc]; }
    const float r = 1.f / (1.f + expf(-sr)), ig = 1.f / (1.f + expf(-si)); const float sp = log1pf(expf(-lam[c])); const float la = -8.0f * r * sp;
    av[idx] = expf(la); bv[idx] = sqrtf(-expm1f(2.f * la)) * ig * xc[idx];
}
__global__ void nv_scan(const float* av, const float* bv, const bf16_t* PROJ, bf16_t* Y) {
    const int idx = blockIdx.x * 64 + threadIdx.x; if (idx >= NB * RW) return;
    const int b = idx / RW, c = idx % RW; float h = 0.f;
    for (int t = 0; t < T; ++t) { const size_t m = (size_t)b * T + t; h = av[m * RW + c] * h + bv[m * RW + c];
        const float g = bf2f(PROJ[m * NINP + C_RG + c]); const float u = 0.7978845608028654f * (g + 0.044715f * g * g * g); const float y = 0.5f * g * (1.f + tanhf(u)) * h;
        Y[m * D + c] = (bf16_t)(pk2(y, 0.f) & 0xffffu); }
}
__global__ void __launch_bounds__(64) nv_diff(const bf16_t* PROJ, float* OT) {
    const int t = blockIdx.x * 64 + threadIdx.x, hc = blockIdx.y, h = hc >> 1, comp = hc & 1, b = blockIdx.z;
    const size_t m = (size_t)b * T + t;
    float q[32], o[64];
#pragma unroll
    for (int i = 0; i < 32; ++i) q[i] = bf2f(PROJ[m * NINP + C_DQ + 64 * h + 32 * comp + i]);
#pragma unroll
    for (int i = 0; i < 64; ++i) o[i] = 0.f;
    float mx = -INFINITY, lsum = 0.f; const int tmax = blockIdx.x * 64 + 63;
    for (int j = 0; j <= tmax; ++j) {
        const bf16_t* kr = PROJ + ((size_t)b * T + j) * NINP + C_DK + 64 * h + 32 * comp; const bf16_t* vr = PROJ + ((size_t)b * T + j) * NINP + C_DV + 64 * h;
        float s = 0.f;
#pragma unroll
        for (int i = 0; i < 32; ++i) s += q[i] * bf2f(kr[i]);
        if (j <= t) { const float mn = fmaxf(mx, s); const float al = exp2f(mx - mn), p = exp2f(s - mn); lsum = lsum * al + p; mx = mn;
#pragma unroll
            for (int i = 0; i < 64; ++i) o[i] = o[i] * al + p * bf2f(vr[i]); }
    }
    const float il = 1.f / lsum; float* op = OT + ((m * 6 + h) * 2 + comp) * 64;
#pragma unroll
    for (int i = 0; i < 64; ++i) op[i] = o[i] * il;
}
__global__ void nv_diff_fin(const float* OT, const float* lq1, const float* lk1, const float* lq2, const float* lk2, const float* subg, float lambda_init, bf16_t* Y) {
    const int idx = blockIdx.x * 256 + threadIdx.x; if (idx >= M * 6) return;
    float s1 = 0.f, s2 = 0.f; for (int i = 0; i < 32; ++i) { s1 += lq1[i] * lk1[i]; s2 += lq2[i] * lk2[i]; }
    const float lam = expf(s1) - expf(s2) + lambda_init;
    const int m = idx / 6, h = idx % 6; const float* o1 = OT + ((size_t)idx * 2) * 64; const float* o2 = o1 + 64; float ss = 0.f;
    for (int i = 0; i < 64; ++i) { const float v = o1[i] - lam * o2[i]; ss += v * v; }
    const float r = 1.0f / sqrtf(ss * (1.f / 64.f) + EPS) * (1.f - lambda_init);
    for (int i = 0; i < 64; ++i) { const float v = (o1[i] - lam * o2[i]) * r * subg[i]; Y[(size_t)m * D + RW + 64 * h + i] = (bf16_t)(pk2(v, 0.f) & 0xffffu); }
}
__global__ void __launch_bounds__(64) nv_ret(const bf16_t* PROJ, bf16_t* Y) {
    const int t = blockIdx.x * 64 + threadIdx.x, h = blockIdx.y, b = blockIdx.z; const size_t m = (size_t)b * T + t;
    float q[64], o[64];
#pragma unroll
    for (int i = 0; i < 64; ++i) { q[i] = bf2f(PROJ[m * NINP + C_TQ + 64 * h + i]); o[i] = 0.f; }
    const float lg2 = log2f(1.0f - exp2f(-5.0f - (float)h)); const int tmax = blockIdx.x * 64 + 63;
    for (int j = 0; j <= tmax; ++j) {
        const bf16_t* kr = PROJ + ((size_t)b * T + j) * NINP + C_TK + 64 * h; const bf16_t* vr = PROJ + ((size_t)b * T + j) * NINP + C_TV + 64 * h;
        float s = 0.f;
#pragma unroll
        for (int i = 0; i < 64; ++i) s += q[i] * bf2f(kr[i]);
        if (j <= t) { const float p = s * exp2f(64.0f * (float)((t >> 6) - (j >> 6)) * lg2);
#pragma unroll
            for (int i = 0; i < 64; ++i) o[i] += p * bf2f(vr[i]); }
    }
    float ss = 0.f;
#pragma unroll
    for (int i = 0; i < 64; ++i) ss += o[i] * o[i];
    const float r = 1.0f / sqrtf(ss * (1.f / 64.f) + EPS);
#pragma unroll
    for (int i = 0; i < 64; ++i) { const float g = bf2f(PROJ[m * NINP + C_TG + 64 * h + i]); const float v = g / (1.f + expf(-g)) * o[i] * r; Y[m * D + 768 + 64 * h + i] = (bf16_t)(pk2(v, 0.f) & 0xffffu); }
}

extern "C" void kernel_launch(void* const* d_in, const int* in_sizes, int n_in, void* d_out, int out_size, void* d_ws, size_t ws_size, hipStream_t stream) {
    static int grid = 0;
    if (grid == 0) {
        if (n_in != 27 || in_sizes[0] != M * D || out_size != M * D || ws_size < WS_END) { fprintf(stderr, "kernel_launch: unexpected shapes (n_in %d, ws %zu < %zu)\n", n_in, ws_size, (size_t)WS_END); grid = -1; return; }
        int dev = 0, cus = 0;
        if (hipGetDevice(&dev) != hipSuccess || hipDeviceGetAttribute(&cus, hipDeviceAttributeMultiprocessorCount, dev) != hipSuccess) { grid = -1; return; }
        if (hipFuncSetAttribute((const void*)mega, hipFuncAttributeMaxDynamicSharedMemorySize, LDS_BYTES) != hipSuccess) { fprintf(stderr, "kernel_launch: hipFuncSetAttribute failed\n"); grid = -1; return; }
        int per_cu = 0;
        if (hipOccupancyMaxActiveBlocksPerMultiprocessor(&per_cu, (const void*)mega, NWAVES * 64, LDS_BYTES) != hipSuccess || per_cu < 1) fprintf(stderr, "kernel_launch: occupancy query says %d\n", per_cu);
        (void)hipGetLastError();
        grid = cus;
        if (grid != 256) { fprintf(stderr, "kernel_launch: built for 256 CUs, got %d\n", grid); }
    }
    if (grid < 0) return;
    (void)hipMemsetAsync((char*)d_ws + WS_CTL, 0, CTL_ZERO_BYTES, stream);
    Args a{};
    for (int i = 0; i < 27; ++i) a.in[i] = (const float*)d_in[i];
    a.pos = (const int*)d_in[2]; a.out = (float*)d_out; a.ws = (unsigned char*)d_ws;
    for (int l = 0; l < NL; ++l) a.lam_init[l] = (float)(0.8 - 0.6 * exp(-0.3 * (double)l));
    unsigned char* ws = (unsigned char*)d_ws;
#if MK_ONE_LAUNCH
    a.ph_lo = 0; a.ph_hi = PH_END;
    hipLaunchKernelGGL(mega, dim3(grid), dim3(NWAVES * 64), LDS_BYTES, stream, a);
#else
    int nrun = 0; auto run = [&](int lo, int hi) { a.ph_lo = lo; a.ph_hi = hi; a.li = nrun++; hipLaunchKernelGGL(mega, dim3(grid), dim3(NWAVES * 64), LDS_BYTES, stream, a); };
    int seg_lo = 0;
    for (int l = 0; l < NL; ++l) {
        const int pb = PH_L0 + l * NPH;
        run(seg_lo, pb + 3); seg_lo = pb + 5;
#if !MK_NAIVE_MIX
        run(pb + 3, pb + 4); run(pb + 4, pb + 5);
#endif
        if (MK_NAIVE_MASK) {
            const bf16_t* PROJ = (const bf16_t*)(ws + WS_PROJ); bf16_t* Y = (bf16_t*)(ws + WS_Y);
            float* xc = (float*)(ws + WS_TMP); float* av = xc + (size_t)M * RW; float* bv = av + (size_t)M * RW; float* OT = (float*)(ws + WS_TMP);
            if (MK_NAIVE_MASK & 1) {
                hipLaunchKernelGGL(nv_conv, dim3(M * RW / 256), dim3(256), 0, stream, PROJ, a.in[14] + l * 4 * RW, a.in[15] + l * RW, xc);
                hipLaunchKernelGGL(nv_gates, dim3(M * RW / 256), dim3(256), 0, stream, xc, a.in[16] + l * 6 * 64 * 64, a.in[17] + l * RW, a.in[18] + l * 6 * 64 * 64, a.in[19] + l * RW, a.in[20] + l * RW, av, bv);
                hipLaunchKernelGGL(nv_scan, dim3(NB * RW / 64), dim3(64), 0, stream, av, bv, PROJ, Y); }
            if (MK_NAIVE_MASK & 2) {
                hipLaunchKernelGGL(nv_diff, dim3(T / 64, 12, NB), dim3(64), 0, stream, PROJ, OT);
                hipLaunchKernelGGL(nv_diff_fin, dim3(M * 6 / 256), dim3(256), 0, stream, OT, a.in[21] + l * 32, a.in[22] + l * 32, a.in[23] + l * 32, a.in[24] + l * 32, a.in[25] + l * 64, a.lam_init[l], Y); }
            if (MK_NAIVE_MASK & 4) hipLaunchKernelGGL(nv_ret, dim3(T / 64, 4, NB), dim3(64), 0, stream, PROJ, Y);
        }
    }
    run(seg_lo, PH_END);
#endif
}
```

```cpp
#include <hip/hip_runtime.h>
#include <cstdio>
#include <cstdint>
#include <cmath>

#ifndef MK_ONE_LAUNCH
#define MK_ONE_LAUNCH 1
#endif
#ifndef PROBE_REP5
#define PROBE_REP5 1
#endif
#ifndef PROBE_EPIR2
#define PROBE_EPIR2 0
#endif
#ifndef PROBE_EPI2
#define PROBE_EPI2 0
#endif
#ifndef PROBE_XEXP
#define PROBE_XEXP 0
#endif
#if PROBE_XEXP
#define PROBE_EXTRA_EXP(pa, pb) do { _Pragma("unroll") for (int r = 0; r < 16; ++r) { float d0_, d1_; asm volatile("v_exp_f32 %0, %2\n\tv_exp_f32 %1, %3" : "=v"(d0_), "=v"(d1_) : "v"(pa[r]), "v"(pb[r])); } } while (0)
#else
#define PROBE_EXTRA_EXP(pa, pb) do { } while (0)
#endif
#ifndef MK_SP2
#define MK_SP2 true
#endif
#ifndef PROBE_REPO
#define PROBE_REPO 1
#endif
#ifndef PROBE_REPP
#define PROBE_REPP 1
#endif
#ifndef PROBE_REPR
#define PROBE_REPR 1
#endif
#ifndef PROBE_BAR2
#define PROBE_BAR2 0
#endif
#ifndef PROBE_REPG
#define PROBE_REPG 1
#endif
#ifndef PROBE_CLK
#define PROBE_CLK 0
#endif
#ifndef PROBE_EPT
#define PROBE_EPT 0
#endif
#ifndef PROBE_BARW
#define PROBE_BARW 0
#endif
#ifndef PROBE_BARW_WG
#define PROBE_BARW_WG 0
#endif
#ifndef PROBE_PRO
#define PROBE_PRO 0
#endif
#ifndef PROBE_PHT
#define PROBE_PHT 0
#endif
#if PROBE_BARW
#define SEAM_P(k) do { unsigned long long b0_ = 0; const bool me_ = (PROBE_BARW - 1 == (k) - pb) && l == 1 && blockIdx.x == PROBE_BARW_WG && (int)threadIdx.x == 0; if (me_) b0_ = __builtin_amdgcn_s_memrealtime(); SEAM(k); \
        if (me_) { const unsigned long long r0_ = __builtin_amdgcn_s_memrealtime(), d_ = (r0_ - b0_) * 20ull; while (__builtin_amdgcn_s_memrealtime() - r0_ < d_ && __builtin_amdgcn_s_memrealtime() - r0_ < 2000000ull) __builtin_amdgcn_s_sleep(16); } } while (0)
#elif PROBE_PHT
#define SEAM_P(k) do { if (blockIdx.x == 0 && (int)threadIdx.x == 0 && l == 1 && (k) - pb == PROBE_PHT - 1) { volatile LAS unsigned long long* lt_ = (volatile LAS unsigned long long*)((LAS unsigned char*)lds_raw + MISC_OFF + 192); \
        asm volatile("s_waitcnt vmcnt(0)" ::: "memory"); const unsigned long long r0_ = __builtin_amdgcn_s_memrealtime(), d_ = (r0_ - lt_[0]) * 5ull; while (__builtin_amdgcn_s_memrealtime() - r0_ < d_ && __builtin_amdgcn_s_memrealtime() - r0_ < 2000000ull) __builtin_amdgcn_s_sleep(16); } \
        SEAM(k); if (blockIdx.x == 0 && (int)threadIdx.x == 0) { volatile LAS unsigned long long* lt_ = (volatile LAS unsigned long long*)((LAS unsigned char*)lds_raw + MISC_OFF + 192); lt_[0] = __builtin_amdgcn_s_memrealtime(); } } while (0)
#else
#define SEAM_P(k) SEAM(k)
#endif
#if PROBE_EPT
#define EPT_END(sel) do { if ((PROBE_EPT % 10) == (sel) && (int)threadIdx.x == 0 && l == 1 && blockIdx.x == 0) { volatile LAS unsigned long long* ep_ = (volatile LAS unsigned long long*)((LAS unsigned char*)lds_raw + MISC_OFF + 160); \
        const unsigned long long d_ = (PROBE_EPT >= 10) ? (ep_[0] - ep_[2]) * 5ull : (ep_[1] - ep_[0]) * 100ull; const unsigned long long r0_ = __builtin_amdgcn_s_memrealtime(); \
        while (__builtin_amdgcn_s_memrealtime() - r0_ < d_ && __builtin_amdgcn_s_memrealtime() - r0_ < 2000000ull) __builtin_amdgcn_s_sleep(16); } } while (0)
#else
#define EPT_END(sel) do { } while (0)
#endif
#if PROBE_CLK
#define CLK_BEGIN(sel) do { if (PROBE_CLK == (sel) && (int)threadIdx.x == 0 && l == 1) { volatile LAS unsigned long long* ck_ = (volatile LAS unsigned long long*)((LAS unsigned char*)lds_raw + MISC_OFF + 128); ck_[0] = __builtin_amdgcn_s_memtime(); ck_[1] = __builtin_amdgcn_s_memrealtime(); } } while (0)
#define CLK_END(sel) do { if (PROBE_CLK == (sel) && (int)threadIdx.x == 0 && l == 1) { volatile LAS unsigned long long* ck_ = (volatile LAS unsigned long long*)((LAS unsigned char*)lds_raw + MISC_OFF + 128); \
        const unsigned long long t1_ = __builtin_amdgcn_s_memtime(), r1_ = __builtin_amdgcn_s_memrealtime(); const float dt_ = (float)(t1_ - ck_[0]), dr_ = (float)(r1_ - ck_[1]); \
        float mhz_ = dr_ > 0.f ? dt_ * 100.f / dr_ : 1000.f; mhz_ = mhz_ < 1000.f ? 1000.f : (mhz_ > 3000.f ? 3000.f : mhz_); \
        if (blockIdx.x == 0) { const unsigned long long tgt_ = (unsigned long long)((mhz_ - 1000.f) * 100.f); while (__builtin_amdgcn_s_memrealtime() - r1_ < tgt_) __builtin_amdgcn_s_sleep(16); } } } while (0)
#else
#define CLK_BEGIN(sel) do { } while (0)
#define CLK_END(sel) do { } while (0)
#endif
#ifndef MK_NAIVE_MIX
#define MK_NAIVE_MIX 0
#endif
#ifndef MK_NAIVE_MASK
#define MK_NAIVE_MASK 0
#endif

constexpr int D = 1024, NB = 4, T = 4096, M = NB * T, NL = 4, F = 2816, NMOD = 9, NMD = NMOD * D;
constexpr int NIN = 2944, NINP = 3072;
constexpr int C_DQ = 0, C_DK = 384, C_TQ = 768, C_TK = 1024, C_DV = 1280, C_TV = 1664, C_TG = 1920, C_RX = 2176, C_RG = 2560;
constexpr int RW = 384;
constexpr float EPS = 1e-6f;
constexpr float QSCALE = 0.17677669529663687f * 1.4426950408889634f;
constexpr int KC = 32, NKC = D / KC;

constexpr size_t MiB = 1u << 20;
constexpr size_t WS_CTL = 0, CTL_ZERO_BYTES = 1 * MiB;
constexpr size_t WS_MODP = 1 * MiB;
constexpr size_t WS_MOD = 20 * MiB;
constexpr size_t WS_GW = 20 * MiB + 640 * 1024;
constexpr size_t WS_TABD = 21 * MiB;
constexpr size_t WS_TABR = 22 * MiB;
constexpr size_t WS_W = 26 * MiB;
constexpr size_t W_L = 41 * MiB, W_1IN = 0, W_1OUT = 11 * MiB, W_2IN = 16 * MiB + MiB / 2, W_2OUT = 27 * MiB + MiB / 2, W_IN = 33 * MiB, W_OUT = 39 * MiB;
constexpr size_t WS_X = WS_W + NL * W_L;
constexpr size_t WS_H = WS_X + 64 * MiB;
constexpr size_t WS_Y = WS_H + 32 * MiB;
constexpr size_t WS_ACT = WS_Y + 32 * MiB;
constexpr size_t WS_PROJ = WS_ACT;
constexpr size_t WS_TMP = WS_ACT + 96 * MiB;
constexpr size_t WS_SP8 = 21 * MiB + 512 * 1024;
constexpr size_t WS_LAMS = 21 * MiB + 520 * 1024;
constexpr size_t WS_ANORM = 21 * MiB + 528 * 1024;
constexpr size_t WS_BIAS = WS_TMP + 100 * MiB;
constexpr size_t WS_SSQ = WS_TMP + 104 * MiB;
constexpr size_t WS_AGGA = WS_TMP + 110 * MiB, WS_AGGB = WS_TMP + 111 * MiB;
constexpr size_t WS_END = WS_TMP + 112 * MiB;
constexpr int CW_TMO = 0, CW_CODE = 1, CW_Q = 2048  , CW_BAR = 4096;

#define GAS __attribute__((address_space(1)))
#define LAS __attribute__((address_space(3)))
typedef unsigned short bf16_t;
typedef short bf16x8 __attribute__((ext_vector_type(8)));
typedef float f32x4 __attribute__((ext_vector_type(4)));
typedef float f32x2 __attribute__((ext_vector_type(2)));
typedef unsigned u32x4 __attribute__((ext_vector_type(4)));
typedef unsigned u32x2 __attribute__((ext_vector_type(2)));
typedef __bf16 bf16x2_t __attribute__((ext_vector_type(2)));
typedef GAS unsigned gu32;
#define RLX_AGENT __ATOMIC_RELAXED, __HIP_MEMORY_SCOPE_AGENT
#define LDS_WAIT() asm volatile("s_waitcnt lgkmcnt(0)" ::: "memory")
#define VM_WAIT() asm volatile("s_waitcnt vmcnt(0)" ::: "memory")
__device__ __forceinline__ unsigned pk2(float lo, float hi) { f32x2 v = {lo, hi}; bf16x2_t b = __builtin_convertvector(v, bf16x2_t); return __builtin_bit_cast(unsigned, b); }
typedef _Float16 h16x2_t __attribute__((ext_vector_type(2)));
__device__ __forceinline__ unsigned pkh2(float lo, float hi) { f32x2 v = {lo, hi}; h16x2_t h = __builtin_convertvector(v, h16x2_t); return __builtin_bit_cast(unsigned, h); }
__device__ __forceinline__ float hlo(unsigned w) { const h16x2_t h = __builtin_bit_cast(h16x2_t, w); return (float)h[0]; }
__device__ __forceinline__ float hhi(unsigned w) { const h16x2_t h = __builtin_bit_cast(h16x2_t, w); return (float)h[1]; }
__device__ __forceinline__ float bf2f(bf16_t v) { return __uint_as_float((unsigned)v << 16); }
__device__ __forceinline__ float bflo(unsigned w) { return __uint_as_float(w << 16); }
__device__ __forceinline__ float bfhi(unsigned w) { return __uint_as_float(w & 0xffff0000u); }
__device__ __forceinline__ float fast_rcp(float x) { return __builtin_amdgcn_rcpf(x); }
__device__ __forceinline__ float sigmoidf_(float x) { return fast_rcp(1.f + __builtin_amdgcn_exp2f(-1.4426950408889634f * x)); }
__device__ __forceinline__ float siluf_(float x) { return x * sigmoidf_(x); }
__device__ __forceinline__ float gelu_tanh(float x) { const float u = 0.7978845608028654f * (x + 0.044715f * x * x * x); return x * sigmoidf_(2.f * u); }
__device__ __forceinline__ int lane_id() { int l; asm volatile("v_mbcnt_lo_u32_b32 %0, -1, 0\n\tv_mbcnt_hi_u32_b32 %0, -1, %0" : "=v"(l)); return l; }
template <int XM> __device__ __forceinline__ float swz_xor(float v) { return __int_as_float(__builtin_amdgcn_ds_swizzle(__float_as_int(v), (XM << 10) | 0x1F)); }
__device__ __forceinline__ float sum_x32(float v) { const auto r = __builtin_amdgcn_permlane32_swap(__float_as_uint(v), __float_as_uint(v), false, false); return __uint_as_float(r[0]) + __uint_as_float(r[1]); }
__device__ __forceinline__ int imax_x32(int v) { const auto r = __builtin_amdgcn_permlane32_swap((unsigned)v, (unsigned)v, false, false); const int a = (int)r[0], b = (int)r[1]; return a > b ? a : b; }
__device__ __forceinline__ float wave_sum(float v) {
    v += swz_xor<1>(v); v += swz_xor<2>(v); v += swz_xor<4>(v); v += swz_xor<8>(v); v += swz_xor<16>(v);
    return sum_x32(v);
}

__device__ __forceinline__ float lg2gamma(int hh) { return hh == 0 ? -0.04580368961312479f : hh == 1 ? -0.02272007650008353f : hh == 2 ? -0.011315313227834146f : -0.005646563141142063f; }

constexpr int RING_OFF = 0, RING_BYTES = 131072, LDSCTL_OFF = RING_BYTES, MISC_OFF = LDSCTL_OFF + 320, LDS_RSTD_OFF = RING_BYTES + 1024  , LDS_BIAS_OFF = LDS_RSTD_OFF + 6144  , LDS_BYTES = 163840;
extern __shared__ __attribute__((aligned(16))) unsigned char lds_raw[];

namespace pg8 {
#define PG8_LAS __attribute__((address_space(3)))
constexpr int BM = 256, BK = 64, HALF = 128, HTB = HALF * BK * 2, STAGE_BYTES = 8 * HTB, NXCD = 8, WGM = 8;
__host__ __device__ __forceinline__ int lds_byte(int r, int c) { const int st = (r >> 4) * 2 + (c >> 5), rr = r & 15, cc = c & 31, ob = rr * 64 + cc * 2; return st * 1024 + (ob ^ (((ob >> 9) & 1) << 5)); }
__host__ __device__ __forceinline__ void stage_rc(int b, int& R, int& C) { const int st = b / 1024, sb = b % 1024, swz = sb ^ (((sb >> 9) & 1) << 5); R = (st >> 1) * 16 + swz / 64; C = (st & 1) * 32 + (swz % 64) / 2; }
__host__ __device__ __forceinline__ int perm32(int rho) { const int n = rho >> 4, i = rho & 15; return 8 * (i >> 2) + 4 * n + (i & 3); }
struct Unit { int pm, pn, idx; };
struct Gemm { const bf16_t* A; const bf16_t* Bt; int M, N, K, tiled; };
struct StaticOrder {
    int nM, nN, nwg, G, c;
    __host__ __device__ void init(int M_, int N_, int G_, int c_) { nM = M_ / BM; nN = N_ / BM; nwg = nM * nN; G = G_; c = c_;
#if defined(__HIP_DEVICE_COMPILE__)
        asm volatile("" : "+s"(c));
#endif
    }
    __host__ __device__ __forceinline__ bool next(int i, Unit& u) const {
        const long L = (long)i * G + c; if (L >= nwg) return false;
        int wgid = (int)L; { const int q = nwg / NXCD, r = nwg % NXCD, xcd = wgid % NXCD, off = wgid / NXCD; wgid = (xcd < r ? xcd * (q + 1) : r * (q + 1) + (xcd - r) * q) + off; }
        const int nig = WGM * nN, gid = wgid / nig, fm = gid * WGM, gsz = (nM - fm) < WGM ? (nM - fm) : WGM;
        u.pm = fm + ((wgid % nig) % gsz); u.pn = (wgid % nig) / gsz; u.idx = i; return true;
    }
    __device__ __forceinline__ void a_ready(const Unit&) const {}
    __device__ __forceinline__ void done(const Unit&) const {}
};

struct EpiSwiglu {
    static constexpr bool PERM = true, AFTER_DRAIN = false;
    unsigned char* ws; int lg;
    __device__ __forceinline__ void operator()(const f32x4 (&acc)[2][2][4][2], const Unit& u, int wr, int wc, int fr, int fq) const {
        bf16_t* O = (bf16_t*)(ws + WS_ACT); const float* bias = (const float*)(ws + WS_BIAS) + (size_t)lg * NB * (2 * F); const LAS float* rstd = (const LAS float*)((LAS unsigned char*)lds_raw + LDS_RSTD_OFF);
        const int row0 = u.pm * BM + wr * 64 + fr, col0 = u.pn * HALF + wc * 32 + 8 * fq;
        const LAS float* bp = (const LAS float*)((LAS unsigned char*)lds_raw + LDS_BIAS_OFF) + u.idx * BM + wc * 32 + 8 * fq;
        const f32x4 bg0 = *(const LAS f32x4*)bp, bg1 = *(const LAS f32x4*)(bp + 4), bu0 = *(const LAS f32x4*)(bp + HALF), bu1 = *(const LAS f32x4*)(bp + HALF + 4);
#pragma unroll
        for (int ai = 0; ai < 2; ++ai)
#pragma unroll
            for (int m = 0; m < 4; ++m) {
                const float rs = rstd[u.idx * BM + ai * HALF + m * 16 + wr * 64 + fr];
                const int row_ = row0 + ai * HALF + m * 16;
                bf16_t* rowp = O + ((((size_t)(row_ >> 8) * (F / 64) + (col0 >> 6)) * BM + (row_ & 255)) << 6) + (col0 & 63);
                const f32x4 g0 = acc[ai][0][m][0] * rs + bg0, g1 = acc[ai][0][m][1] * rs + bg1, u0 = acc[ai][1][m][0] * rs + bu0, u1 = acc[ai][1][m][1] * rs + bu1;
                u32x4 w;
                w.x = pk2(siluf_(g0[0]) * u0[0], siluf_(g0[1]) * u0[1]); w.y = pk2(siluf_(g0[2]) * u0[2], siluf_(g0[3]) * u0[3]);
                w.z = pk2(siluf_(g1[0]) * u1[0], siluf_(g1[1]) * u1[1]); w.w = pk2(siluf_(g1[2]) * u1[2], siluf_(g1[3]) * u1[3]);
                *(u32x4*)rowp = w;
            }
    }
};
struct EpiResid {
    static constexpr bool PERM = true, AFTER_DRAIN = false;
    unsigned char* ws; int l, gidx, an_idx, slot; float coef;
    __device__ __forceinline__ void operator()(const f32x4 (&acc)[2][2][4][2], const Unit& u, int wr, int wc, int fr, int fq) const {
        bf16_t* X = (bf16_t*)(ws + WS_X); bf16_t* XS = (bf16_t*)(ws + WS_H); float* SSQ = (float*)(ws + WS_SSQ) + (size_t)slot * M * 16;
        const float* gate = (const float*)(ws + WS_MOD) + (size_t)l * NB * NMD + gidx * D; const float* An = (const float*)(ws + WS_ANORM) + (size_t)(an_idx < 0 ? 0 : an_idx) * NB * D; const bool has_an = an_idx >= 0;
        const int row0 = u.pm * BM + wr * 64 + fr, col0 = u.pn * BM + wc * 32 + 8 * fq, b = u.pm >> 4;
        f32x4 gv[2][2], av[2][2];
#pragma unroll
        for (int bj = 0; bj < 2; ++bj)
#pragma unroll
            for (int n = 0; n < 2; ++n) { gv[bj][n] = *(const f32x4*)(gate + (size_t)b * NMD + col0 + bj * HALF + n * 4) * coef;
                av[bj][n] = *(const f32x4*)(An + (size_t)b * D + col0 + bj * HALF + n * 4); }
        u32x4 xin[2][2];
#define RES_LOAD(g_, buf) do { const size_t ro_ = (size_t)(row0 + ((g_) >> 2) * HALF + ((g_) & 3) * 16) * D + col0; \
            _Pragma("unroll") for (int bj = 0; bj < 2; ++bj) xin[buf][bj] = *(const u32x4*)(X + ro_ + bj * HALF); } while (0)
        RES_LOAD(0, 0);
#pragma unroll
        for (int g = 0; g < 8; ++g) { const int ai = g >> 2, m = g & 3, row = row0 + ai * HALF + m * 16; const size_t ro = (size_t)row * D + col0; float ss = 0.f;
            if (g + 1 < 8) RES_LOAD(g + 1, (g + 1) & 1);
#pragma unroll
            for (int bj = 0; bj < 2; ++bj) { const size_t o = ro + bj * HALF; const u32x4 xi = xin[g & 1][bj];
                const f32x4 x0 = (f32x4){hlo(xi.x), hhi(xi.x), hlo(xi.y), hhi(xi.y)} + gv[bj][0] * acc[ai][bj][m][0], x1 = (f32x4){hlo(xi.z), hhi(xi.z), hlo(xi.w), hhi(xi.w)} + gv[bj][1] * acc[ai][bj][m][1];
                { u32x4 w; w.x = pkh2(x0[0], x0[1]); w.y = pkh2(x0[2], x0[3]); w.z = pkh2(x1[0], x1[1]); w.w = pkh2(x1[2], x1[3]); *(u32x4*)(X + o) = w; }
                ss += ((x0[0] * x0[0] + x0[1] * x0[1]) + (x0[2] * x0[2] + x0[3] * x0[3])) + ((x1[0] * x1[0] + x1[1] * x1[1]) + (x1[2] * x1[2] + x1[3] * x1[3]));
                if (has_an) { const f32x4 s0 = x0 * av[bj][0], s1 = x1 * av[bj][1]; u32x4 w; w.x = pk2(s0[0], s0[1]); w.y = pk2(s0[2], s0[3]); w.z = pk2(s1[0], s1[1]); w.w = pk2(s1[2], s1[3]); *(u32x4*)(XS + o) = w; } }
            ss += swz_xor<16>(ss); ss = sum_x32(ss);
            if (fq == 0) SSQ[(size_t)row * 16 + u.pn * 4 + wc] = ss; }
#undef RES_LOAD
    }
};
struct EpiMixIn {
    static constexpr bool PERM = true, AFTER_DRAIN = false;
    unsigned char* ws; int l;
    __device__ __forceinline__ void operator()(const f32x4 (&acc)[2][2][4][2], const Unit& u, int wr, int wc, int fr, int fq) const {
        bf16_t* O = (bf16_t*)(ws + WS_PROJ); const float* tabD = (const float*)(ws + WS_TABD); const float* tabR = (const float*)(ws + WS_TABR);
        const float* bias = (const float*)(ws + WS_BIAS) + (size_t)(3 * l + 1) * NB * (2 * F); const LAS float* rstd = (const LAS float*)((LAS unsigned char*)lds_raw + LDS_RSTD_OFF);
        const int row0 = u.pm * BM + wr * 64 + fr;
#pragma unroll
        for (int bj = 0; bj < 2; ++bj) {
            const int kb = 2 * u.pn + bj, col0 = kb * HALF + wc * 32 + 8 * fq;
            const LAS float* bp = (const LAS float*)((LAS unsigned char*)lds_raw + LDS_BIAS_OFF) + u.idx * BM + bj * HALF + wc * 32 + 8 * fq;
            const f32x4 b0 = *(const LAS f32x4*)bp, b1 = *(const LAS f32x4*)(bp + 4);
            if (kb < 6) {
                const float qs = (kb < 3) ? QSCALE : 1.f;
#pragma unroll
                for (int ai = 0; ai < 2; ++ai)
#pragma unroll
                    for (int m = 0; m < 4; ++m) { const int row = row0 + ai * HALF + m * 16; const float rs = rstd[u.idx * BM + ai * HALF + m * 16 + wr * 64 + fr];
                        f32x4 v0 = acc[ai][bj][m][0] * rs + b0, v1 = acc[ai][bj][m][1] * rs + b1;
                        if (fq == 0) { const f32x4 c = *(const f32x4*)(tabD + (size_t)row * 8), s = *(const f32x4*)(tabD + (size_t)row * 8 + 4); const f32x4 r0 = v0 * c - v1 * s, r1 = v1 * c + v0 * s; v0 = r0; v1 = r1; }
                        v0 = v0 * qs; v1 = v1 * qs;
                        u32x4 w; w.x = pk2(v0[0], v0[1]); w.y = pk2(v0[2], v0[3]); w.z = pk2(v1[0], v1[1]); w.w = pk2(v1[2], v1[3]);
                        *(u32x4*)(O + (size_t)row * NINP + col0) = w; }
            } else if (kb < 10) {
                const bool isk = (kb >= 8); const int i0 = 16 * (wc & 1) + 4 * fq; const float lg = lg2gamma(2 * (kb & 1) + (wc >> 1)) * (isk ? -1.f : 1.f);
#pragma unroll
                for (int ai = 0; ai < 2; ++ai)
#pragma unroll
                    for (int m = 0; m < 4; ++m) { const int row = row0 + ai * HALF + m * 16; const float rs = rstd[u.idx * BM + ai * HALF + m * 16 + wr * 64 + fr];
                        const f32x4 v0 = acc[ai][bj][m][0] * rs + b0, v1 = acc[ai][bj][m][1] * rs + b1;
                        const f32x4 c = *(const f32x4*)(tabR + (size_t)row * 64 + i0), s = *(const f32x4*)(tabR + (size_t)row * 64 + 32 + i0);
                        const float ks = __builtin_amdgcn_exp2f((float)(row & 63) * lg) * (isk ? 0.125f : 1.f);
                        const f32x4 r0 = (v0 * c - v1 * s) * ks, r1 = (v1 * c + v0 * s) * ks;
                        u32x4 w; w.x = pk2(r0[0], r0[1]); w.y = pk2(r0[2], r0[3]); w.z = pk2(r1[0], r1[1]); w.w = pk2(r1[2], r1[3]);
                        *(u32x4*)(O + (size_t)row * NINP + col0) = w; }
            } else {
#pragma unroll
                for (int ai = 0; ai < 2; ++ai)
#pragma unroll
                    for (int m = 0; m < 4; ++m) { const int row = row0 + ai * HALF + m * 16; const float rs = rstd[u.idx * BM + ai * HALF + m * 16 + wr * 64 + fr];
                        const f32x4 v0 = acc[ai][bj][m][0] * rs + b0, v1 = acc[ai][bj][m][1] * rs + b1;
                        u32x4 w; w.x = pk2(v0[0], v0[1]); w.y = pk2(v0[2], v0[3]); w.z = pk2(v1[0], v1[1]); w.w = pk2(v1[2], v1[3]);
                        *(u32x4*)(O + (size_t)row * NINP + col0) = w; }
            }
        }
    }
};

template <class Epi, class Sched, bool ALIGN_EPI = false, bool SP2 = false>
__device__ __forceinline__ void gemm_phase(PG8_LAS unsigned char* lds, const Gemm g, const Sched& S, const Epi& E) {
    int tid_ = threadIdx.x; asm volatile("" : "+v"(tid_));
    const int tid = tid_, wid = __builtin_amdgcn_readfirstlane(tid >> 6), lane = tid & 63, wr = wid >> 2, wc = wid & 3, fr = lane & 15, fq = lane >> 4;
    const int K = g.K, nt = K / BK, ld = g.tiled ? BK : K;
    unsigned voffA[2], voffB[2];
#pragma unroll
    for (int i = 0; i < 2; ++i) { int R, C; stage_rc(tid * 16 + i * 8192, R, C); const int Rb = Epi::PERM ? ((R & ~31) + perm32(R & 31)) : R;
        voffA[i] = (unsigned)(R * ld + C) * 2u; voffB[i] = (unsigned)(Rb * ld + C) * 2u; }
    const size_t kstep = g.tiled ? (size_t)(BM * BK * 2) : (size_t)(BK * 2);
    const size_t hstep = (size_t)HALF * ld * 2;
    const size_t tstep = g.tiled ? (size_t)nt * (BM * BK * 2) : 2 * hstep;
    const unsigned ldsw = (unsigned)wid * 1024u;
    const int aoff = lds_byte(wr * 64 + fr, fq * 8), boff = lds_byte(wc * 32 + fr, fq * 8);
#define PG8_SA(b, h) (((b) * 2 + (h)) * HTB)
#define PG8_SB(b, h) ((4 + (b) * 2 + (h)) * HTB)
#define PG8_STAGE(bufoff, gbase, voff) do { _Pragma("unroll") for (int _i = 0; _i < 2; ++_i) \
        __builtin_amdgcn_global_load_lds((const unsigned*)((const char*)(gbase) + (voff)[_i]), (PG8_LAS unsigned*)(lds + (bufoff) + ldsw + _i * 8192), 16, 0, 0); } while (0)
#define PG8_LDA(dst, b, h) do { _Pragma("unroll") for (int m = 0; m < 4; ++m) _Pragma("unroll") for (int k = 0; k < 2; ++k) dst[m][k] = *(const PG8_LAS bf16x8*)(lds + PG8_SA(b, h) + aoff + m * 2048 + k * 1024); } while (0)
#define PG8_LDB(dst, b, h) do { _Pragma("unroll") for (int n = 0; n < 2; ++n) _Pragma("unroll") for (int k = 0; k < 2; ++k) dst[n][k] = *(const PG8_LAS bf16x8*)(lds + PG8_SB(b, h) + boff + n * 2048 + k * 1024); } while (0)
#define PG8_MMA(ai, bj, At, Bt) do { __builtin_amdgcn_s_setprio(1); _Pragma("unroll") for (int m = 0; m < 4; ++m) _Pragma("unroll") for (int n = 0; n < 2; ++n) _Pragma("unroll") for (int k = 0; k < 2; ++k) \
        acc[ai][bj][m][n] = __builtin_amdgcn_mfma_f32_16x16x32_bf16(Bt[n][k], At[m][k], acc[ai][bj][m][n], 0, 0, 0); __builtin_amdgcn_s_setprio(0); } while (0)
#define PG8_WAIT_V(n) asm volatile("s_waitcnt vmcnt(" #n ")" ::: "memory")
#define PG8_WAIT_L(n) asm volatile("s_waitcnt lgkmcnt(" #n ")" ::: "memory")
#define PG8_BAR __builtin_amdgcn_s_barrier()
#define PG8_SCHED __builtin_amdgcn_sched_barrier(0)
    Unit cur, nxt; int ui = 0;
#if PROBE_EPT
    if (tid == 0) ((volatile PG8_LAS unsigned long long*)((PG8_LAS unsigned char*)lds_raw + MISC_OFF + 160))[2] = __builtin_amdgcn_s_memrealtime();
#endif
    if (!S.next(0, cur)) return;
    f32x4 acc[2][2][4][2];
#pragma unroll
    for (int a = 0; a < 2; ++a)
#pragma unroll
        for (int b = 0; b < 2; ++b)
#pragma unroll
            for (int m = 0; m < 4; ++m)
#pragma unroll
                for (int n = 0; n < 2; ++n) acc[a][b][m][n] = (f32x4){0.f, 0.f, 0.f, 0.f};
    bf16x8 At[4][2], B0[2][2], B1[2][2];
    const char* cA = (const char*)g.A + (size_t)cur.pm * tstep; const char* cB = (const char*)g.Bt + (size_t)cur.pn * tstep;
    S.a_ready(cur);
    if constexpr (SP2) {
        PG8_STAGE(PG8_SB(0, 0), cB, voffB); PG8_STAGE(PG8_SB(0, 1), cB + hstep, voffB); PG8_STAGE(PG8_SA(0, 0), cA, voffA); PG8_STAGE(PG8_SA(0, 1), cA + hstep, voffA);
        if (wr == 1) PG8_BAR;
        PG8_WAIT_V(2); PG8_BAR;
        PG8_STAGE(PG8_SB(1, 0), cB + kstep, voffB); PG8_STAGE(PG8_SA(1, 0), cA + kstep, voffA); PG8_STAGE(PG8_SB(1, 1), cB + hstep + kstep, voffB);
        PG8_WAIT_V(6); PG8_BAR;
    } else {
        PG8_STAGE(PG8_SB(0, 0), cB, voffB); PG8_STAGE(PG8_SA(0, 0), cA, voffA); PG8_STAGE(PG8_SB(0, 1), cB + hstep, voffB); PG8_STAGE(PG8_SA(0, 1), cA + hstep, voffA);
        if (wr == 1) PG8_BAR;
        PG8_WAIT_V(4); PG8_BAR;
        PG8_STAGE(PG8_SB(1, 0), cB + kstep, voffB); PG8_STAGE(PG8_SA(1, 0), cA + kstep, voffA); PG8_STAGE(PG8_SB(1, 1), cB + hstep + kstep, voffB);
        PG8_WAIT_V(6); PG8_BAR;
    }
    for (;;) {
        const bool has_next = S.next(ui + 1, nxt);
        const char* nA = has_next ? (const char*)g.A + (size_t)nxt.pm * tstep : cA; const char* nB = has_next ? (const char*)g.Bt + (size_t)nxt.pn * tstep : cB;
        for (int t = 0; t < nt; t += 2) {
            const bool last = (t == nt - 2);
            const char* a1 = cA + (size_t)(t + 1) * kstep;
            const char* a2 = last ? nA : cA + (size_t)(t + 2) * kstep; const char* b2 = last ? nB : cB + (size_t)(t + 2) * kstep;
            const char* a3 = a2 + kstep; const char* b3 = b2 + kstep;
            if (last && has_next) S.a_ready(nxt);
            if constexpr (SP2) {
            PG8_LDB(B0, 0, 0); PG8_LDB(B1, 0, 1); PG8_SCHED; PG8_LDA(At, 0, 0); PG8_STAGE(PG8_SA(1, 1), a1 + hstep, voffA);
            PG8_WAIT_V(8); PG8_WAIT_L(0); PG8_BAR; PG8_MMA(0, 0, At, B0); PG8_MMA(0, 1, At, B1); PG8_BAR; PG8_SCHED;
            PG8_LDA(At, 0, 1); PG8_STAGE(PG8_SB(0, 0), b2, voffB); PG8_STAGE(PG8_SB(0, 1), b2 + hstep, voffB); PG8_STAGE(PG8_SA(0, 0), a2, voffA);
            PG8_WAIT_V(8); PG8_WAIT_L(0); PG8_BAR; PG8_MMA(1, 0, At, B0); PG8_MMA(1, 1, At, B1); PG8_BAR; PG8_SCHED;
            PG8_LDB(B0, 1, 0); PG8_LDB(B1, 1, 1); PG8_SCHED; PG8_LDA(At, 1, 0); PG8_STAGE(PG8_SA(0, 1), a2 + hstep, voffA);
            PG8_WAIT_V(8); PG8_WAIT_L(0); PG8_BAR; PG8_MMA(0, 0, At, B0); PG8_MMA(0, 1, At, B1); PG8_BAR; PG8_SCHED;
            PG8_LDA(At, 1, 1); PG8_STAGE(PG8_SB(1, 0), b3, voffB); PG8_STAGE(PG8_SB(1, 1), b3 + hstep, voffB); PG8_STAGE(PG8_SA(1, 0), a3, voffA);
            PG8_WAIT_V(8); PG8_WAIT_L(0); PG8_BAR; PG8_MMA(1, 0, At, B0); PG8_MMA(1, 1, At, B1); PG8_BAR; PG8_SCHED;
            } else {
            PG8_LDB(B0, 0, 0); PG8_SCHED; PG8_LDA(At, 0, 0); PG8_STAGE(PG8_SA(1, 1), a1 + hstep, voffA);
            PG8_WAIT_L(8); PG8_BAR; PG8_WAIT_L(0); PG8_MMA(0, 0, At, B0); PG8_BAR; PG8_SCHED;
            PG8_LDB(B1, 0, 1); PG8_STAGE(PG8_SB(0, 0), b2, voffB);
            PG8_BAR; PG8_WAIT_L(0); PG8_MMA(0, 1, At, B1); PG8_BAR;
            PG8_LDA(At, 0, 1); PG8_STAGE(PG8_SA(0, 0), a2, voffA);
            PG8_BAR; PG8_WAIT_L(0); PG8_MMA(1, 0, At, B0); PG8_BAR; PG8_SCHED;
            PG8_STAGE(PG8_SB(0, 1), b2 + hstep, voffB);
            PG8_WAIT_V(6); PG8_BAR; PG8_MMA(1, 1, At, B1); PG8_BAR;
            PG8_LDB(B0, 1, 0); PG8_SCHED; PG8_LDA(At, 1, 0); PG8_STAGE(PG8_SA(0, 1), a2 + hstep, voffA);
            PG8_WAIT_L(8); PG8_BAR; PG8_WAIT_L(0); PG8_MMA(0, 0, At, B0); PG8_BAR; PG8_SCHED;
            PG8_LDB(B1, 1, 1); PG8_STAGE(PG8_SB(1, 0), b3, voffB);
            PG8_BAR; PG8_WAIT_L(0); PG8_MMA(0, 1, At, B1); PG8_BAR;
            PG8_LDA(At, 1, 1); PG8_STAGE(PG8_SA(1, 0), a3, voffA);
            PG8_BAR; PG8_WAIT_L(0); PG8_MMA(1, 0, At, B0); PG8_BAR; PG8_SCHED;
            PG8_STAGE(PG8_SB(1, 1), b3 + hstep, voffB);
            PG8_WAIT_V(6); PG8_BAR; PG8_MMA(1, 1, At, B1); PG8_BAR;
            }
        }
        if constexpr (ALIGN_EPI) { if (wr == 0) PG8_BAR; }
#if PROBE_EPT
        if (tid == 0) ((volatile PG8_LAS unsigned long long*)((PG8_LAS unsigned char*)lds_raw + MISC_OFF + 160))[0] = __builtin_amdgcn_s_memrealtime();
#endif
        if constexpr (!Epi::AFTER_DRAIN) { E(acc, cur, wr, wc, fr, fq);
#if PROBE_EPT
            asm volatile("s_waitcnt vmcnt(0)" ::: "memory");
            if (tid == 0) ((volatile PG8_LAS unsigned long long*)((PG8_LAS unsigned char*)lds_raw + MISC_OFF + 160))[1] = __builtin_amdgcn_s_memrealtime();
#endif
#if PROBE_EPI2
            if constexpr (Epi::PERM) { asm volatile("" ::: "memory"); E(acc, cur, wr, wc, fr, fq); }
#elif PROBE_EPIR2
            if constexpr (!Epi::PERM) { asm volatile("s_waitcnt vmcnt(0)" ::: "memory"); Epi E2 = E; E2.coef = 0.f; E2(acc, cur, wr, wc, fr, fq); }
#endif
            S.done(cur); }
        if (!has_next) break;
#pragma unroll
        for (int a = 0; a < 2; ++a)
#pragma unroll
            for (int b = 0; b < 2; ++b)
#pragma unroll
                for (int m = 0; m < 4; ++m)
#pragma unroll
                    for (int n = 0; n < 2; ++n) acc[a][b][m][n] = (f32x4){0.f, 0.f, 0.f, 0.f};
        cur = nxt; cA = nA; cB = nB; ++ui;
        if constexpr (ALIGN_EPI) { if (wr == 1) PG8_BAR; }
    }
    PG8_WAIT_V(0);
    if constexpr (!ALIGN_EPI) { if (wr == 0) PG8_BAR; }
    PG8_BAR;
#undef PG8_SA
#undef PG8_SB
#undef PG8_STAGE
#undef PG8_LDA
#undef PG8_LDB
#undef PG8_MMA
#undef PG8_WAIT_V
#undef PG8_WAIT_L
#undef PG8_BAR
#undef PG8_SCHED
}
}

#define XB_TMO      128
#define XB_XCNT(j)  (256  + 64 * (j))
#define XB_XSUB(j)  (1280 + 64 * (j))
#define XB_XGEN(j)  (2304 + 64 * (j))
#define XB_TOP      3328
#define XB_TOPGEN   3392
#define XCD_BAR_WORDS 3456
#define XB_SPIN_CAP (1u << 18)
__device__ __forceinline__ unsigned xb_ld(unsigned* p)              { return __hip_atomic_load(p, __ATOMIC_RELAXED, __HIP_MEMORY_SCOPE_AGENT); }
__device__ __forceinline__ unsigned xb_add(unsigned* p, unsigned v) { return __hip_atomic_fetch_add(p, v, __ATOMIC_RELAXED, __HIP_MEMORY_SCOPE_AGENT); }
__device__ __forceinline__ unsigned xb_xcc_id() { return (unsigned)__builtin_amdgcn_s_getreg((3 << 11) | 20) & 0xFu; }
#define XB_SPIN(cond, bar) do { unsigned _sp = 0; while (cond) { __builtin_amdgcn_s_sleep(1); \
    if ((++_sp & 255u) == 0u) { if (xb_ld(&(bar)[XB_TMO])) break; if (_sp > XB_SPIN_CAP) { atomicAdd(&(bar)[XB_TMO], 1u); break; } } } } while (0)
struct XcdBarrier { unsigned* bar; unsigned x; volatile LAS unsigned* st; };
__device__ __forceinline__ XcdBarrier xcd_barrier_post(unsigned* bar, volatile LAS unsigned* st) {
    XcdBarrier b; b.bar = bar; b.x = xb_xcc_id(); b.st = st;
    if (threadIdx.x == 0) (void)xb_add(&bar[XB_XCNT(b.x)], 1u);
    return b;
}
__device__ __forceinline__ void xcd_barrier_complete(unsigned* bar, unsigned x, unsigned& nloc, unsigned& nx) {
    const unsigned G = gridDim.x * gridDim.y * gridDim.z;
    unsigned sum, cnt, mine, sp = 0u;
    for (;;) {
        sum = 0u; cnt = 0u; mine = 0u;
#pragma unroll
        for (unsigned j = 0; j < 16; ++j) { const unsigned c = xb_ld(&bar[XB_XCNT(j)]); sum += c; cnt += (c > 0u) ? 1u : 0u; mine = (j == x) ? c : mine; }
        if (sum == G) break;
        __builtin_amdgcn_s_sleep(1);
        if ((++sp & 255u) == 0u) { if (xb_ld(&bar[XB_TMO])) break; if (sp > XB_SPIN_CAP) { atomicAdd(&bar[XB_TMO], 1u); break; } }
    }
    nloc = mine > 0u ? mine : 1u; nx = cnt > 0u ? cnt : 1u;
}
__device__ __forceinline__ void xcd_barrier(const XcdBarrier& b) {
    asm volatile("s_waitcnt vmcnt(0)" ::: "memory");
    __syncthreads();
    if (threadIdx.x == 0) {
        unsigned* bar = b.bar; asm volatile("" : "+s"(bar));
        __builtin_amdgcn_s_waitcnt(0);
        unsigned nloc = b.st[0], nx = b.st[1];
        if (nloc == 0u) { xcd_barrier_complete(bar, b.x, nloc, nx); b.st[0] = nloc; b.st[1] = nx; }
        const unsigned old = xb_add(&bar[XB_XSUB(b.x)], 1u);
        const unsigned gen = old / nloc;
        if (old + 1u == (gen + 1u) * nloc) {
            __builtin_amdgcn_fence(__ATOMIC_RELEASE, "agent");
            asm volatile("s_waitcnt vmcnt(0)" ::: "memory");
            const unsigned og = xb_add(&bar[XB_TOP], 1u);
            const unsigned tg = og / nx;
            if (og + 1u == (tg + 1u) * nx) xb_add(&bar[XB_TOPGEN], 1u);
            else XB_SPIN(xb_ld(&bar[XB_TOPGEN]) == tg, bar);
            __builtin_amdgcn_fence(__ATOMIC_ACQUIRE, "agent");
            xb_add(&bar[XB_XGEN(b.x)], 1u);
            asm volatile("s_waitcnt vmcnt(0)" ::: "memory");
        } else {
            XB_SPIN(xb_ld(&bar[XB_XGEN(b.x)]) == gen, bar);
            __builtin_amdgcn_fence(__ATOMIC_ACQUIRE, "agent");
            asm volatile("s_waitcnt vmcnt(0)" ::: "memory");
        }
    }
    __syncthreads();
}

namespace mix {
typedef float f32x16 __attribute__((ext_vector_type(16)));
typedef short s16x4 __attribute__((ext_vector_type(4)));
typedef short v4i16_t __attribute__((ext_vector_type(4)));
typedef LAS const char* lds_cptr;
constexpr int SLOTB = 8192, LDS_K = 0, LDS_V = 2 * SLOTB, LDS_QW = 4 * SLOTB, LDS_QF = 4 * SLOTB + 1024;
constexpr int N_DIFF = 24 * 16, N_RET = 16, N_ITEMS = N_DIFF + N_RET;
__device__ __forceinline__ int crow(int r, int hi) { return (r & 3) + 8 * (r >> 2) + 4 * hi; }
__device__ __forceinline__ int imax(int a, int b) { return a > b ? a : b; }
__device__ __forceinline__ void glds16(const void* g, unsigned lds_base) { unsigned sv; asm volatile("s_mov_b32 %0, m0\n\ts_mov_b32 m0, %2\n\ts_nop 0\n\tglobal_load_lds_dwordx4 %1, off\n\ts_mov_b32 m0, %0" : "=&s"(sv) : "v"(g), "s"(lds_base) : "memory"); }
__device__ __forceinline__ s16x4 vtr(lds_cptr p) { return __builtin_bit_cast(s16x4, __builtin_amdgcn_ds_read_tr16_b64_v4i16((LAS v4i16_t*)p)); }
#define MFMA32(a, b, c) __builtin_amdgcn_mfma_f32_32x32x16_bf16(a, b, c, 0, 0, 0)
#define MFMA16(a, b, c) __builtin_amdgcn_mfma_f32_16x16x32_bf16(a, b, c, 0, 0, 0)

struct ItemTab { unsigned short v[N_ITEMS]; };
constexpr ItemTab make_items() {
    ItemTab t{}; int n = 0;
    for (int bh = 0; bh < 16; ++bh) t.v[n++] = (unsigned short)(0x8000 | bh);
    for (int qb = 15; qb >= 0; --qb) for (int bh = 0; bh < 24; ++bh) t.v[n++] = (unsigned short)((qb << 8) | bh);
    return t;
}
__device__ const ItemTab g_items = make_items();

template <int MODE>
__device__ __forceinline__ void attn_unit(int b, int h, int qb, const bf16_t* PROJ, bf16_t* Y, LAS unsigned char* lds, float lam, float lam_init, const float* subg) {
    int tid_ = threadIdx.x; asm volatile("" : "+v"(tid_));
    const int tid = tid_, lane = tid & 63, r32 = lane & 31, hi = lane >> 5; const int wid = __builtin_amdgcn_readfirstlane(tid >> 6);
    constexpr int CQ = MODE == 0 ? C_DQ : C_TQ, CK = MODE == 0 ? C_DK : C_TK, CV = MODE == 0 ? C_DV : C_TV;
    const size_t rowbase = (size_t)b * T; const int q0 = qb * 256, NT = 4 * (qb + 1), my_last = 4 * qb + (wid >> 1);
    const bf16_t* Qw = PROJ + (rowbase + q0 + wid * 32) * NINP + CQ + 64 * h;
    const bf16_t* ksrc = PROJ + (rowbase + lane) * NINP + CK + 64 * h + wid * 8;
    const bf16_t* vsrc = PROJ + (rowbase + 16 * (wid & 3) + (lane >> 2)) * NINP + CV + 64 * h + (wid >> 2) * 32 + (lane & 3) * 8;
    const unsigned lds0 = (unsigned)(uintptr_t)lds;
    const unsigned kdst = lds0 + LDS_K + wid * 1024, vdst = lds0 + LDS_V + wid * 1024;
    const lds_cptr kp0 = (lds_cptr)lds + LDS_K + hi * 1024 + r32 * 16;
    const lds_cptr vp0 = (lds_cptr)lds + LDS_V + ((lane >> 4) & 1) * 32 + (lane & 3) * 8 + (4 * hi + ((lane & 15) >> 2)) * 64;
#define DMA_K(t, slot) glds16(ksrc + (size_t)(t) * 64 * NINP, (unsigned)__builtin_amdgcn_readfirstlane(kdst + (slot)))
#define DMA_V(t, slot) glds16(vsrc + (size_t)(t) * 64 * NINP, (unsigned)__builtin_amdgcn_readfirstlane(vdst + (slot)))
    DMA_K(0, 0); DMA_V(0, 0);
#pragma unroll
    for (int p = 0; p < 4; ++p) glds16(Qw + (size_t)(lane & 31) * NINP + (2 * p + (lane >> 5)) * 8, (unsigned)__builtin_amdgcn_readfirstlane(lds0 + LDS_QF + wid * 4096 + p * 1024));
    const lds_cptr qp0 = (lds_cptr)lds + LDS_QF + wid * 4096 + hi * 512 + r32 * 16;
    f32x16 oA[2], oB[2];
    oA[0] = f32x16{}; oA[1] = f32x16{}; oB[0] = f32x16{}; oB[1] = f32x16{};
    float mref = 0.f, lA = 0.f, lB = 0.f; f32x16 nm = f32x16{};
    const int qabs = q0 + wid * 32 + r32;
    const float lg2 = lg2gamma(h);
    for (int t = 0; t < NT; ++t) {
        asm volatile("s_waitcnt vmcnt(0) lgkmcnt(0)\n\ts_barrier" ::: "memory");
        const int sl = (t & 1) * SLOTB;
        if (t + 1 < NT) { DMA_K(t + 1, SLOTB - sl); DMA_V(t + 1, SLOTB - sl); }
        if (t <= my_last) {
            bf16x8 kf[8], vf[8], qr[4];
#pragma unroll
            for (int d0 = 0; d0 < 4; ++d0) { qr[d0] = *(const LAS bf16x8*)(qp0 + d0 * 1024); kf[2 * d0] = *(const LAS bf16x8*)(kp0 + sl + d0 * 2048); kf[2 * d0 + 1] = *(const LAS bf16x8*)(kp0 + sl + d0 * 2048 + 512); }
#define LOAD_VF() do { _Pragma("unroll") for (int i = 0; i < 8; ++i) { const s16x4 lo = vtr(vp0 + sl + (i >> 2) * 4096 + (i & 3) * 1024), hh = vtr(vp0 + sl + (i >> 2) * 4096 + (i & 3) * 1024 + 512); \
                vf[i] = (bf16x8){lo[0], lo[1], lo[2], lo[3], hh[0], hh[1], hh[2], hh[3]}; } } while (0)
            const bool diag = (t == my_last);
            const int kv0 = 64 * t + 4 * hi;
            const f32x16 z16 = f32x16{};
            if constexpr (MODE == 0) {
                f32x16 paA = MFMA32(kf[0], qr[0], nm); paA = MFMA32(kf[2], qr[1], paA);
                f32x16 pbA = MFMA32(kf[1], qr[0], nm); pbA = MFMA32(kf[3], qr[1], pbA);
                f32x16 paB = MFMA32(kf[4], qr[2], nm); paB = MFMA32(kf[6], qr[3], paB);
                f32x16 pbB = MFMA32(kf[5], qr[2], nm); pbB = MFMA32(kf[7], qr[3], pbB);
                if ((t & 7) == 0) {
                int ti = imax(imax(__float_as_int(paA[0]), __float_as_int(pbA[0])), imax(__float_as_int(paB[0]), __float_as_int(pbB[0])));
#pragma unroll
                for (int r = 1; r < 16; ++r) ti = imax(imax(ti, imax(__float_as_int(paA[r]), __float_as_int(pbA[r]))), imax(__float_as_int(paB[r]), __float_as_int(pbB[r])));
                ti = imax_x32(ti);
                if (t == 0 || __any(ti > 0x41000000)) {
                    const float tmf = __int_as_float(ti); const float dl = (t == 0) ? tmf : fmaxf(tmf, 0.f); mref += dl;
#pragma unroll
                    for (int r = 0; r < 16; ++r) { paA[r] -= dl; pbA[r] -= dl; paB[r] -= dl; pbB[r] -= dl; nm[r] = -mref; }
                    if (t > 0) { const float f = __builtin_amdgcn_exp2f(-dl); lA *= f; lB *= f; oA[0] = oA[0] * f; oA[1] = oA[1] * f; oB[0] = oB[0] * f; oB[1] = oB[1] * f; } }
                }
                if (diag) {
#pragma unroll
                    for (int r = 0; r < 16; ++r) { const int kv = kv0 + (r & 3) + 8 * (r >> 2); if (kv > qabs) { paA[r] = -1e30f; paB[r] = -1e30f; } if (kv + 32 > qabs) { pbA[r] = -1e30f; pbB[r] = -1e30f; } } }
#define EXP_PACK(pa, pb, L_, pf) do { \
                float rs0 = 0.f, rs1 = 0.f; \
                  \
                _Pragma("unroll") for (int r = 0; r < 16; ++r) { pa[r] = __builtin_amdgcn_exp2f(pa[r]); pb[r] = __builtin_amdgcn_exp2f(pb[r]); rs0 += pa[r]; asm("" : "+v"(rs0)); rs1 += pb[r]; asm("" : "+v"(rs1)); } \
                L_ += rs0 + rs1; \
                PROBE_EXTRA_EXP(pa, pb); \
                _Pragma("unroll") for (int s = 0; s < 2; ++s) { \
                    u32x4 w0, w1; \
                    w0.x = pk2(pa[8 * s + 0], pa[8 * s + 1]); w0.y = pk2(pa[8 * s + 2], pa[8 * s + 3]); w0.z = pk2(pa[8 * s + 4], pa[8 * s + 5]); w0.w = pk2(pa[8 * s + 6], pa[8 * s + 7]); \
                    w1.x = pk2(pb[8 * s + 0], pb[8 * s + 1]); w1.y = pk2(pb[8 * s + 2], pb[8 * s + 3]); w1.z = pk2(pb[8 * s + 4], pb[8 * s + 5]); w1.w = pk2(pb[8 * s + 6], pb[8 * s + 7]); \
                    pf[s] = __builtin_bit_cast(bf16x8, w0); pf[2 + s] = __builtin_bit_cast(bf16x8, w1); } } while (0)
#define PV_ACC(O, pf) do { _Pragma("unroll") for (int dh = 0; dh < 2; ++dh) _Pragma("unroll") for (int s = 0; s < 4; ++s) O[dh] = MFMA32(vf[4 * dh + s], pf[s], O[dh]); } while (0)
                __builtin_amdgcn_sched_barrier(0);
                LOAD_VF();
                bf16x8 pfA[4], pfB[4];
                EXP_PACK(paA, pbA, lA, pfA);
                __builtin_amdgcn_sched_barrier(0);
                PV_ACC(oA, pfA);
                EXP_PACK(paB, pbB, lB, pfB);
#pragma unroll
                for (int i = 0; i < 8; ++i) { __builtin_amdgcn_sched_group_barrier(0x008, 1, 0); __builtin_amdgcn_sched_group_barrier(0x402, 10, 0); }
                __builtin_amdgcn_sched_barrier(0);
                PV_ACC(oB, pfB);
#undef EXP_PACK
#undef PV_ACC
            } else {
                f32x16 pa = MFMA32(kf[0], qr[0], z16), pb = MFMA32(kf[1], qr[0], z16);
#pragma unroll
                for (int d0 = 1; d0 < 4; ++d0) { pa = MFMA32(kf[2 * d0], qr[d0], pa); pb = MFMA32(kf[2 * d0 + 1], qr[d0], pb); }
                const int qt = (q0 + wid * 32) >> 6;
                const float tf = __builtin_amdgcn_exp2f(64.0f * (float)(qt - t) * lg2);
#pragma unroll
                for (int r = 0; r < 16; ++r) { pa[r] *= tf; pb[r] *= tf; }
                if (diag) {
#pragma unroll
                    for (int r = 0; r < 16; ++r) { const int kv = kv0 + (r & 3) + 8 * (r >> 2); if (kv > qabs) pa[r] = 0.f; if (kv + 32 > qabs) pb[r] = 0.f; } }
                LOAD_VF();
                bf16x8 pf[4];
#pragma unroll
                for (int s = 0; s < 2; ++s) {
                    u32x4 w0, w1;
                    w0.x = pk2(pa[8 * s + 0], pa[8 * s + 1]); w0.y = pk2(pa[8 * s + 2], pa[8 * s + 3]); w0.z = pk2(pa[8 * s + 4], pa[8 * s + 5]); w0.w = pk2(pa[8 * s + 6], pa[8 * s + 7]);
                    w1.x = pk2(pb[8 * s + 0], pb[8 * s + 1]); w1.y = pk2(pb[8 * s + 2], pb[8 * s + 3]); w1.z = pk2(pb[8 * s + 4], pb[8 * s + 5]); w1.w = pk2(pb[8 * s + 6], pb[8 * s + 7]);
                    pf[s] = __builtin_bit_cast(bf16x8, w0); pf[2 + s] = __builtin_bit_cast(bf16x8, w1); }
#pragma unroll
                for (int dh = 0; dh < 2; ++dh)
#pragma unroll
                    for (int s = 0; s < 4; ++s) oA[dh] = MFMA32(vf[4 * dh + s], pf[s], oA[dh]);
            }
        }
    }
#undef DMA_K
#undef DMA_V
#undef LOAD_VF
    const size_t mrow = rowbase + qabs;
    if constexpr (MODE == 0) {
        lA = sum_x32(lA); lB = sum_x32(lB);
        const float rA = 1.0f / lA, rB = lam / lB;
        float ss = 0.f;
#pragma unroll
        for (int dh = 0; dh < 2; ++dh)
#pragma unroll
            for (int r = 0; r < 16; ++r) { const float v = oA[dh][r] * rA - oB[dh][r] * rB; oA[dh][r] = v; ss += v * v; }
        ss = sum_x32(ss);
        float li_ = lam_init; asm volatile("" : "+v"(li_));
        const float rn = (1.0f / sqrtf(ss * (1.f / 64.f) + EPS)) * (1.0f - li_);
#pragma unroll
        for (int dh = 0; dh < 2; ++dh)
#pragma unroll
            for (int g = 0; g < 4; ++g) { const int d = 32 * dh + 8 * g + 4 * hi; const f32x4 sg = *(const f32x4*)(subg + d);
                u32x2 w; w.x = pk2(oA[dh][4 * g] * rn * sg[0], oA[dh][4 * g + 1] * rn * sg[1]); w.y = pk2(oA[dh][4 * g + 2] * rn * sg[2], oA[dh][4 * g + 3] * rn * sg[3]);
                *(u32x2*)(Y + mrow * D + RW + 64 * h + d) = w; }
    } else {
        float ss = 0.f;
#pragma unroll
        for (int dh = 0; dh < 2; ++dh)
#pragma unroll
            for (int r = 0; r < 16; ++r) ss += oA[dh][r] * oA[dh][r];
        ss = sum_x32(ss);
        const float rn = 1.0f / sqrtf(ss * (1.f / 64.f) + EPS);
#pragma unroll
        for (int dh = 0; dh < 2; ++dh)
#pragma unroll
            for (int g = 0; g < 4; ++g) { const int d = 32 * dh + 8 * g + 4 * hi; const u32x2 tg = *(const u32x2*)(PROJ + mrow * NINP + C_TG + 64 * h + d);
                u32x2 w; w.x = pk2(siluf_(bflo(tg.x)) * oA[dh][4 * g] * rn, siluf_(bfhi(tg.x)) * oA[dh][4 * g + 1] * rn); w.y = pk2(siluf_(bflo(tg.y)) * oA[dh][4 * g + 2] * rn, siluf_(bfhi(tg.y)) * oA[dh][4 * g + 3] * rn);
                *(u32x2*)(Y + mrow * D + 768 + 64 * h + d) = w; }
    }
}

namespace rseq { constexpr int SLOT = 40960, KB_ = 0, KT_ = 8192, VT_ = 16384, QB_ = 24576, TG_ = 32768, RS_ = 139264, RSB = 8192; }
__device__ __forceinline__ void ret_seq(int b, int h, const bf16_t* PROJ, bf16_t* Y, LAS unsigned char* lds) {
    using namespace rseq;
    int tid_ = threadIdx.x; asm volatile("" : "+v"(tid_));
    const int tid = tid_, lane = tid & 63, r32 = lane & 31, hi = lane >> 5; const int wid = __builtin_amdgcn_readfirstlane(tid >> 6);
    const size_t rowbase = (size_t)b * T;
    const unsigned lds0 = (unsigned)(uintptr_t)lds;
    const bf16_t* kb_src = PROJ + (rowbase + lane) * NINP + C_TK + 64 * h + wid * 8;
    const bf16_t* qb_src = PROJ + (rowbase + lane) * NINP + C_TQ + 64 * h + wid * 8;
    const size_t tr_off = (size_t)(16 * (wid & 3) + (lane >> 2)) * NINP + (wid >> 2) * 32 + (lane & 3) * 8;
    const bf16_t* kt_src = PROJ + rowbase * NINP + C_TK + 64 * h + tr_off;
    const bf16_t* vt_src = PROJ + rowbase * NINP + C_TV + 64 * h + tr_off;
    const bf16_t* tg_src = PROJ + (rowbase + 8 * wid + (lane >> 3)) * NINP + C_TG + 64 * h + (lane & 7) * 8;
#define RS_DMA(blk, slot_) do { const size_t go_ = (size_t)(blk) * 64 * NINP; const unsigned d_ = lds0 + (slot_) * SLOT + wid * 1024; \
        glds16(kb_src + go_, (unsigned)__builtin_amdgcn_readfirstlane(d_ + KB_)); glds16(kt_src + go_, (unsigned)__builtin_amdgcn_readfirstlane(d_ + KT_)); \
        glds16(vt_src + go_, (unsigned)__builtin_amdgcn_readfirstlane(d_ + VT_)); glds16(qb_src + go_, (unsigned)__builtin_amdgcn_readfirstlane(d_ + QB_)); \
        glds16(tg_src + go_, (unsigned)__builtin_amdgcn_readfirstlane(d_ + TG_)); } while (0)
    RS_DMA(0, 0); RS_DMA(1, 1);
    { unsigned z = 0u; asm volatile("" : "+v"(z)); for (int i = tid; i < RSB / 16; i += 512) ((LAS u32x4*)(lds + RS_))[i] = (u32x4){z, z, z, z}; }
    const int qh = wid & 1;
    const int dvh = (wid >> 1) & 1, dkh = wid & 1;
    f32x16 Rq = f32x16{};
    const float g64 = __builtin_amdgcn_exp2f(64.0f * lg2gamma(h));
    const lds_cptr trb = (lds_cptr)lds + ((lane >> 4) & 1) * 32 + (lane & 3) * 8 + (4 * hi + ((lane & 15) >> 2)) * 64;
    for (int i = 0; i < T / 64; ++i) {
        if (i + 1 < T / 64) { if (wid < 2 && i > 0) asm volatile("s_waitcnt vmcnt(13) lgkmcnt(0)\n\ts_barrier" ::: "memory"); else asm volatile("s_waitcnt vmcnt(5) lgkmcnt(0)\n\ts_barrier" ::: "memory"); }
        else asm volatile("s_waitcnt vmcnt(0) lgkmcnt(0)\n\ts_barrier" ::: "memory");
        const int sl = (i % 3) * SLOT, rb = (i & 1) * RSB;
        if (i + 2 < T / 64) RS_DMA(i + 2, (i + 2) % 3);
        if (wid < 2) {
            bf16x8 kf[8], qr[4];
#pragma unroll
            for (int d0 = 0; d0 < 4; ++d0) { qr[d0] = *(const LAS bf16x8*)((lds_cptr)lds + sl + QB_ + (2 * d0 + hi) * 1024 + (32 * qh + r32) * 16);
                kf[2 * d0] = *(const LAS bf16x8*)((lds_cptr)lds + sl + KB_ + (2 * d0 + hi) * 1024 + r32 * 16); kf[2 * d0 + 1] = *(const LAS bf16x8*)((lds_cptr)lds + sl + KB_ + (2 * d0 + hi) * 1024 + 512 + r32 * 16); }
            const f32x16 z16 = f32x16{};
            f32x16 pa = MFMA32(kf[0], qr[0], z16), pb = z16;
#pragma unroll
            for (int d0 = 1; d0 < 4; ++d0) pa = MFMA32(kf[2 * d0], qr[d0], pa);
            if (qh) {
#pragma unroll
                for (int d0 = 0; d0 < 4; ++d0) pb = MFMA32(kf[2 * d0 + 1], qr[d0], pb); }
#pragma unroll
            for (int r = 0; r < 16; ++r) { const int kv = (r & 3) + 8 * (r >> 2) + 4 * hi;
                if (qh == 0) { if (kv > r32) pa[r] = 0.f; }
                else { if (kv > r32) pb[r] = 0.f; } }
            bf16x8 pf[4];
#pragma unroll
            for (int s = 0; s < 2; ++s) { u32x4 w0, w1;
                w0.x = pk2(pa[8 * s + 0], pa[8 * s + 1]); w0.y = pk2(pa[8 * s + 2], pa[8 * s + 3]); w0.z = pk2(pa[8 * s + 4], pa[8 * s + 5]); w0.w = pk2(pa[8 * s + 6], pa[8 * s + 7]);
                w1.x = pk2(pb[8 * s + 0], pb[8 * s + 1]); w1.y = pk2(pb[8 * s + 2], pb[8 * s + 3]); w1.z = pk2(pb[8 * s + 4], pb[8 * s + 5]); w1.w = pk2(pb[8 * s + 6], pb[8 * s + 7]);
                pf[s] = __builtin_bit_cast(bf16x8, w0); pf[2 + s] = __builtin_bit_cast(bf16x8, w1); }
            f32x16 o[2]; o[0] = z16; o[1] = z16;
#pragma unroll
            for (int dh = 0; dh < 2; ++dh)
#pragma unroll
                for (int s = 0; s < 4; ++s) {
                    if (s < 2 || qh) { const s16x4 lo = vtr(trb + sl + VT_ + dh * 4096 + s * 1024), hh = vtr(trb + sl + VT_ + dh * 4096 + s * 1024 + 512);
                        o[dh] = MFMA32(((bf16x8){lo[0], lo[1], lo[2], lo[3], hh[0], hh[1], hh[2], hh[3]}), pf[s], o[dh]); }
                    const bf16x8 rf = *(const LAS bf16x8*)((lds_cptr)lds + RS_ + rb + (2 * s + hi) * 1024 + (32 * dh + r32) * 16);
                    o[dh] = MFMA32(rf, qr[s], o[dh]); }
            const size_t mrow = rowbase + (size_t)i * 64 + 32 * qh + r32;
            float ss = 0.f;
#pragma unroll
            for (int dh = 0; dh < 2; ++dh)
#pragma unroll
                for (int r = 0; r < 16; ++r) ss += o[dh][r] * o[dh][r];
            ss = sum_x32(ss);
            const float rn = 1.0f / sqrtf(ss * (1.f / 64.f) + EPS);
#pragma unroll
            for (int dh = 0; dh < 2; ++dh)
#pragma unroll
                for (int g = 0; g < 4; ++g) { const int d = 32 * dh + 8 * g + 4 * hi; const u32x2 tg = *(const LAS u32x2*)((lds_cptr)lds + sl + TG_ + (32 * qh + r32) * 128 + d * 2);
                    u32x2 w; w.x = pk2(siluf_(bflo(tg.x)) * o[dh][4 * g] * rn, siluf_(bfhi(tg.x)) * o[dh][4 * g + 1] * rn); w.y = pk2(siluf_(bflo(tg.y)) * o[dh][4 * g + 2] * rn, siluf_(bfhi(tg.y)) * o[dh][4 * g + 3] * rn);
                    *(u32x2*)(Y + mrow * D + 768 + 64 * h + d) = w; }
        } else if (wid >= 4) {
#pragma unroll
            for (int s = 0; s < 4; ++s) {
                const s16x4 vl = vtr(trb + sl + VT_ + dvh * 4096 + s * 1024), vh = vtr(trb + sl + VT_ + dvh * 4096 + s * 1024 + 512);
                const s16x4 kl = vtr(trb + sl + KT_ + dkh * 4096 + s * 1024), kh = vtr(trb + sl + KT_ + dkh * 4096 + s * 1024 + 512);
                Rq = MFMA32(((bf16x8){vl[0], vl[1], vl[2], vl[3], vh[0], vh[1], vh[2], vh[3]}), ((bf16x8){kl[0], kl[1], kl[2], kl[3], kh[0], kh[1], kh[2], kh[3]}), Rq); }
            Rq = Rq * g64;
            LAS bf16_t* rs = (LAS bf16_t*)(lds + RS_ + (RSB - rb));
            const int dk = 32 * dkh + r32;
#pragma unroll
            for (int r = 0; r < 16; ++r) { const int dv = 32 * dvh + (r & 3) + 8 * (r >> 2) + 4 * hi; rs[(dk >> 3) * 512 + dv * 8 + (dk & 7)] = (bf16_t)(pk2(Rq[r], 0.f) & 0xffffu); }
        }
    }
    asm volatile("s_waitcnt lgkmcnt(0)\n\ts_barrier" ::: "memory");
#undef RS_DMA
}

__device__ __forceinline__ float em1(float x) {
    if (x > -0.25f) { float p = 1.f / 720.f; p = p * x + 1.f / 120.f; p = p * x + 1.f / 24.f; p = p * x + 1.f / 6.f; p = p * x + 0.5f; p = p * x + 1.f; return p * x; }
    return expm1f(x);
}
template <int DD> __device__ __forceinline__ float dpp_shr(float v) { return __int_as_float(__builtin_amdgcn_update_dpp(__float_as_int(v), __float_as_int(v), 0x110 + DD, 0xF, 0xF, false)); }
template <int DD> __device__ __forceinline__ f32x4 shup4(f32x4 v) { f32x4 r; r[0] = dpp_shr<DD>(v[0]); r[1] = dpp_shr<DD>(v[1]); r[2] = dpp_shr<DD>(v[2]); r[3] = dpp_shr<DD>(v[3]); return r; }
__device__ __forceinline__ float bc15f(float v) { return __int_as_float(__builtin_amdgcn_ds_swizzle(__float_as_int(v), (0x0F << 5) | 0x10)); }
__device__ __forceinline__ f32x4 bc15(f32x4 v) { f32x4 r; r[0] = bc15f(v[0]); r[1] = bc15f(v[1]); r[2] = bc15f(v[2]); r[3] = bc15f(v[3]); return r; }
template <int PASS>
__device__ __forceinline__ void rglru_item(int wi, const bf16_t* PROJ, const bf16_t* GWl, const float* SP8l, const float* cw, const float* cb, const float* ba, const float* bx, float* AGGA, float* AGGB, bf16_t* Y, int lane_in) {
    int lane = lane_in; asm volatile("" : "+v"(lane));
    const int fr = lane & 15, fq = lane >> 4;
    const int h = wi % 6, chunk = (wi / 6) & 63, b = wi / 384;
    const long m0 = (long)b * T + chunk * 64;
    const int chb = 64 * h + 4 * fq;
    bf16x8 wf[2][4][2];
#pragma unroll
    for (int g = 0; g < 2; ++g)
#pragma unroll
        for (int nbo = 0; nbo < 4; ++nbo)
#pragma unroll
            for (int ks = 0; ks < 2; ++ks) { const bf16_t* p = GWl + (((size_t)g * 6 + h) * 64 + 16 * nbo + fr) * 64 + 32 * ks + 4 * fq; const u32x2 lo = *(const u32x2*)p, hi2 = *(const u32x2*)(p + 16);
                wf[g][nbo][ks] = __builtin_bit_cast(bf16x8, (u32x4){lo.x, lo.y, hi2.x, hi2.y}); }
    f32x4 bav[4], bxv[4], spv[4], hc[4], At[4];
#pragma unroll
    for (int nb = 0; nb < 4; ++nb) { bav[nb] = *(const f32x4*)(ba + chb + 16 * nb); bxv[nb] = *(const f32x4*)(bx + chb + 16 * nb); spv[nb] = *(const f32x4*)(SP8l + chb + 16 * nb);
        hc[nb] = (f32x4){0.f, 0.f, 0.f, 0.f}; At[nb] = (f32x4){1.f, 1.f, 1.f, 1.f}; }
#define KS_STEP(DD, A_, B_) do { const f32x4 As = shup4<DD>(A_), Bs = shup4<DD>(B_); if (fr >= DD) { B_ = A_ * Bs + B_; A_ = A_ * As; } } while (0)
    if constexpr (PASS == 2) {
        f32x4 FA[4], FB[4];
#pragma unroll
        for (int nb = 0; nb < 4; ++nb) { FA[nb] = (f32x4){1.f, 1.f, 1.f, 1.f}; FB[nb] = (f32x4){0.f, 0.f, 0.f, 0.f}; }
#pragma unroll
        for (int k = 0; k < 4; ++k) { const int ci = 4 * fr + k;
            if (ci < chunk) {
#pragma unroll
                for (int nb = 0; nb < 4; ++nb) { const size_t o = ((size_t)(b * 64 + ci)) * RW + chb + 16 * nb; const f32x4 a = *(const f32x4*)(AGGA + o), bb = *(const f32x4*)(AGGB + o);
                    FB[nb] = a * FB[nb] + bb; FA[nb] = a * FA[nb]; } } }
#pragma unroll
        for (int nb = 0; nb < 4; ++nb) { KS_STEP(1, FA[nb], FB[nb]); KS_STEP(2, FA[nb], FB[nb]); KS_STEP(4, FA[nb], FB[nb]); KS_STEP(8, FA[nb], FB[nb]); }
#pragma unroll
        for (int nb = 0; nb < 4; ++nb) hc[nb] = bc15(FB[nb]);
    }
#pragma unroll 1
    for (int mb = 0; mb < 4; ++mb) {
        const int tl = 16 * mb + fr;
        f32x4 xc[4];
#pragma unroll
        for (int nb = 0; nb < 4; ++nb) { f32x4 acc = *(const f32x4*)(cb + chb + 16 * nb);
#pragma unroll
            for (int j = 0; j < 4; ++j) { const int tj = tl - 3 + j;
                if (chunk > 0 || tj >= 0) { const u32x2 w = *(const u32x2*)(PROJ + (size_t)(m0 + tj) * NINP + C_RX + chb + 16 * nb); const f32x4 cwv = *(const f32x4*)(cw + j * RW + chb + 16 * nb);
                    acc += cwv * (f32x4){bflo(w.x), bfhi(w.x), bflo(w.y), bfhi(w.y)}; } }
            xc[nb] = acc; }
        bf16x8 bfr[2];
#pragma unroll
        for (int ks = 0; ks < 2; ++ks) { u32x4 w; w.x = pk2(xc[2 * ks][0], xc[2 * ks][1]); w.y = pk2(xc[2 * ks][2], xc[2 * ks][3]); w.z = pk2(xc[2 * ks + 1][0], xc[2 * ks + 1][1]); w.w = pk2(xc[2 * ks + 1][2], xc[2 * ks + 1][3]);
            bfr[ks] = __builtin_bit_cast(bf16x8, w); }
#pragma unroll
        for (int nb = 0; nb < 4; ++nb) {
            f32x4 ra = bav[nb], ia = bxv[nb];
#pragma unroll
            for (int ks = 0; ks < 2; ++ks) { ra = MFMA16(wf[0][nb][ks], bfr[ks], ra); ia = MFMA16(wf[1][nb][ks], bfr[ks], ia); }
            f32x4 A, B;
#pragma unroll
            for (int r = 0; r < 4; ++r) { const float rg = sigmoidf_(ra[r]), ig = sigmoidf_(ia[r]); const float la = spv[nb][r] * rg;
                A[r] = 1.0f + em1(la); B[r] = sqrtf(-em1(2.0f * la)) * ig * xc[nb][r]; }
            KS_STEP(1, A, B); KS_STEP(2, A, B); KS_STEP(4, A, B); KS_STEP(8, A, B);
            const f32x4 hv = B + A * hc[nb];
            hc[nb] = bc15(hv);
            if constexpr (PASS == 1) { At[nb] = At[nb] * bc15(A); }
            else { const size_t mr = (size_t)(m0 + tl); const u32x2 gw = *(const u32x2*)(PROJ + mr * NINP + C_RG + chb + 16 * nb);
                u32x2 w; w.x = pk2(gelu_tanh(bflo(gw.x)) * hv[0], gelu_tanh(bfhi(gw.x)) * hv[1]); w.y = pk2(gelu_tanh(bflo(gw.y)) * hv[2], gelu_tanh(bfhi(gw.y)) * hv[3]);
                *(u32x2*)(Y + mr * D + chb + 16 * nb) = w; }
        }
    }
    if constexpr (PASS == 1) {
        if (fr == 15) {
#pragma unroll
            for (int nb = 0; nb < 4; ++nb) { const size_t o = ((size_t)(b * 64 + chunk)) * RW + chb + 16 * nb; *(f32x4*)(AGGA + o) = At[nb]; *(f32x4*)(AGGB + o) = hc[nb]; } }
    }
}
#undef KS_STEP
#undef MFMA32
#undef MFMA16
}

constexpr int NWAVES = 8;
struct Args { const float* in[27]; const int* pos; float* out; unsigned char* ws; float lam_init[4]; int ph_lo, ph_hi, li, pad; };
constexpr int PH_L0 = 3, NPH = 8, PH_FINAL = PH_L0 + NL * NPH, PH_END = PH_FINAL + 1;

struct Frame { LAS unsigned char* lds; int wave, vcu, G, gw, NGW; };

template <class Map>
__device__ __forceinline__ void transpose_item(const float* W, int K, int Nsrc, bf16_t* WT, int NT, LAS float* scr, int item, int lane, Map src, bool tiled = false) {
    const int nblk = NT / 32, kb = item / nblk, nb = item % nblk, k0 = 64 * kb, n0 = 32 * nb;
    const int sc = src(n0 + (lane & 31));
    float wv_[32];
#pragma unroll
    for (int i = 0; i < 32; ++i) { const int kk = 2 * i + (lane >> 5); wv_[i] = sc >= 0 ? __builtin_nontemporal_load(W + (size_t)(k0 + kk) * Nsrc + sc) : 0.f; }
#pragma unroll
    for (int i = 0; i < 32; ++i) { const int kk = 2 * i + (lane >> 5); scr[kk * 33 + (lane & 31)] = wv_[i]; }
    LDS_WAIT(); asm volatile("" ::: "memory");
    const int c = lane & 7;
#pragma unroll
    for (int j = 0; j < 4; ++j) { const int n = (lane >> 3) + 8 * j; const LAS float* s = scr + (8 * c) * 33 + n;
        u32x4 o; o.x = pk2(s[0 * 33], s[1 * 33]); o.y = pk2(s[2 * 33], s[3 * 33]); o.z = pk2(s[4 * 33], s[5 * 33]); o.w = pk2(s[6 * 33], s[7 * 33]);
        const size_t off = tiled ? (((size_t)((n0 + n) >> 8) * (K / 64) + kb) * 256 + ((n0 + n) & 255)) * 64 + 8 * c : (size_t)(n0 + n) * K + k0 + 8 * c;
        __builtin_nontemporal_store(o, (GAS u32x4*)(WT + off)); }
    LDS_WAIT(); asm volatile("" ::: "memory");
}
struct MapId { __device__ __forceinline__ int operator()(int n) const { return n; } };
struct MapFfnIn { __device__ __forceinline__ int operator()(int n) const { const int pn = n >> 8, bj = (n >> 7) & 1, cc = n & 127; return bj * F + pn * 128 + cc; } };
__device__ __forceinline__ int ret_dim(int pos) { const int w = pos >> 5, rem = pos & 31, fq = rem >> 3, n = (rem >> 2) & 1, j = rem & 3; return 32 * n + 16 * w + 4 * fq + j; }
struct MapMixIn { __device__ __forceinline__ int operator()(int p) const {
    if (p < C_DK) return 768 + p;
    if (p < C_TQ) return 1152 + (p - C_DK);
    if (p < C_TK) { const int q = p - C_TQ; return 1920 + (q & ~63) + ret_dim(q & 63); }
    if (p < C_DV) { const int q = p - C_TK; return 2176 + (q & ~63) + ret_dim(q & 63); }
    if (p < C_TV) return 1536 + (p - C_DV);
    if (p < C_TG) return 2432 + (p - C_TV);
    if (p < C_RX) return 2688 + (p - C_TG);
    if (p < C_RG) return p - C_RX;
    if (p < NIN) return 384 + (p - C_RG);
    return -1; } };

constexpr int I_FI = (D / 64) * (2 * F / 32), I_FO = (F / 64) * (D / 32), I_MI = (D / 64) * (NINP / 32), I_MO = (D / 64) * (D / 32), CONV_ITEMS_L = 2 * I_FI + 2 * I_FO + I_MI + I_MO;
constexpr int CONV_WG_ITEMS = (CONV_ITEMS_L + NWAVES - 1) / NWAVES;
struct ConvSrc { const float *f1i, *f1o, *f2i, *f2o, *mi, *mo; };
__device__ __forceinline__ void conv_item(const ConvSrc cs, unsigned char* ws, int l, int r, LAS float* scr, int lane) {
    unsigned char* wl = ws + WS_W + (size_t)l * W_L;
    if (r < I_FI) { transpose_item(cs.f1i + (size_t)l * D * 2 * F, D, 2 * F, (bf16_t*)(wl + W_1IN), 2 * F, scr, r, lane, MapFfnIn()); return; } r -= I_FI;
    if (r < I_FI) { transpose_item(cs.f2i + (size_t)l * D * 2 * F, D, 2 * F, (bf16_t*)(wl + W_2IN), 2 * F, scr, r, lane, MapFfnIn()); return; } r -= I_FI;
    if (r < I_FO) { transpose_item(cs.f1o + (size_t)l * F * D, F, D, (bf16_t*)(wl + W_1OUT), D, scr, r, lane, MapId(), true); return; } r -= I_FO;
    if (r < I_FO) { transpose_item(cs.f2o + (size_t)l * F * D, F, D, (bf16_t*)(wl + W_2OUT), D, scr, r, lane, MapId(), true); return; } r -= I_FO;
    if (r < I_MI) { transpose_item(cs.mi + (size_t)l * D * NIN, D, NIN, (bf16_t*)(wl + W_IN), NINP, scr, r, lane, MapMixIn()); return; } r -= I_MI;
    transpose_item(cs.mo + (size_t)l * D * D, D, D, (bf16_t*)(wl + W_OUT), D, scr, r, lane, MapId());
}
__device__ __forceinline__ void bias_layer(unsigned char* ws, int l, int gw, int ngw, int lane) {
    const float* MOD = (const float*)(ws + WS_MOD); float* BIAS = (float*)(ws + WS_BIAS);
    for (int g = 0; g < 3; ++g) {
        const int lg = l * 3 + g; const int Nw = (g == 1) ? NINP : 2 * F;
        const bf16_t* Wt = (const bf16_t*)(ws + WS_W + (size_t)l * W_L + (g == 0 ? W_1IN : g == 1 ? W_IN : W_2IN));
        f32x4 Sv[4][4];
#pragma unroll
        for (int b = 0; b < 4; ++b)
#pragma unroll
            for (int q = 0; q < 4; ++q) Sv[b][q] = *(const f32x4*)(MOD + ((size_t)l * NB + b) * NMD + (3 * g) * D + 16 * lane + 4 * q);
        for (int n = gw; n < Nw; n += ngw) {
            const u32x4 w0 = *(const u32x4*)(Wt + (size_t)n * D + 16 * lane), w1 = *(const u32x4*)(Wt + (size_t)n * D + 16 * lane + 8);
            const f32x4 wv[4] = {{bflo(w0.x), bfhi(w0.x), bflo(w0.y), bfhi(w0.y)}, {bflo(w0.z), bfhi(w0.z), bflo(w0.w), bfhi(w0.w)}, {bflo(w1.x), bfhi(w1.x), bflo(w1.y), bfhi(w1.y)}, {bflo(w1.z), bfhi(w1.z), bflo(w1.w), bfhi(w1.w)}};
            float acc4[4];
#pragma unroll
            for (int b = 0; b < 4; ++b) { f32x4 a = Sv[b][0] * wv[0] + Sv[b][1] * wv[1] + Sv[b][2] * wv[2] + Sv[b][3] * wv[3]; acc4[b] = wave_sum((a[0] + a[1]) + (a[2] + a[3])); }
            if (lane < 4) BIAS[((size_t)lg * NB + lane) * (2 * F) + n] = lane == 0 ? acc4[0] : lane == 1 ? acc4[1] : lane == 2 ? acc4[2] : acc4[3];
        }
    }
}

__device__ __forceinline__ void bias_layer_mma(unsigned char* ws, int l, LAS unsigned char* lds, int j, int stride, int lane) {
    const float* MOD = (const float*)(ws + WS_MOD); float* BIAS = (float*)(ws + WS_BIAS);
    int tid_ = threadIdx.x; asm volatile("" : "+v"(tid_));
    for (int c = tid_; c < 3 * 4 * 128; c += NWAVES * 64) {
        const int g = c >> 9, b = (c >> 7) & 3, kc = c & 127;
        const float* sp = MOD + ((size_t)l * NB + b) * NMD + (3 * g) * D + 8 * kc;
        const f32x4 s0 = *(const f32x4*)sp, s1 = *(const f32x4*)(sp + 4);
        u32x4 hi, lo;
        hi.x = pk2(s0[0], s0[1]); hi.y = pk2(s0[2], s0[3]); hi.z = pk2(s1[0], s1[1]); hi.w = pk2(s1[2], s1[3]);
        lo.x = pk2(s0[0] - bflo(hi.x), s0[1] - bfhi(hi.x)); lo.y = pk2(s0[2] - bflo(hi.y), s0[3] - bfhi(hi.y)); lo.z = pk2(s1[0] - bflo(hi.z), s1[1] - bfhi(hi.z)); lo.w = pk2(s1[2] - bflo(hi.w), s1[3] - bfhi(hi.w));
        const int off = ((g * 2) * 32 + (kc >> 2)) * 256 + (kc & 3) * 64 + b * 16;
        *(LAS u32x4*)(lds + off) = hi; *(LAS u32x4*)(lds + off + 8192) = lo; }
    if (tid_ == 0) { unsigned z_ = 0u; asm volatile("" : "+v"(z_)); *(LAS u32x4*)(lds + 49152) = (u32x4){z_, z_, z_, z_}; }
    __syncthreads();
    int ln = lane; asm volatile("" : "+v"(ln));
    const int fr = ln & 15, fq = ln >> 4;
    for (int grp = j; grp < 896; grp += stride) {
        const int g = grp < 352 ? 0 : grp < 544 ? 1 : 2; const int n0 = 16 * (grp - (g == 0 ? 0 : g == 1 ? 352 : 544));
        const bf16_t* Wt = (const bf16_t*)(ws + WS_W + (size_t)l * W_L + (g == 0 ? W_1IN : g == 1 ? W_IN : W_2IN)) + (size_t)(n0 + fr) * D + 8 * fq;
        bf16x8 wf[32];
#pragma unroll
        for (int ks = 0; ks < 32; ++ks) wf[ks] = *(const bf16x8*)(Wt + 32 * ks);
        const bool act = fr < 4; const int sb = act ? g * 16384 + fq * 64 + fr * 16 : 49152, st = act ? 256 : 0, lo_ = act ? 8192 : 0;
        f32x4 acc = {0.f, 0.f, 0.f, 0.f};
#pragma unroll
        for (int ks = 0; ks < 32; ++ks) { const bf16x8 sh = *(const LAS bf16x8*)(lds + sb + ks * st), sl = *(const LAS bf16x8*)(lds + sb + lo_ + ks * st);
            acc = __builtin_amdgcn_mfma_f32_16x16x32_bf16(wf[ks], sh, acc, 0, 0, 0); acc = __builtin_amdgcn_mfma_f32_16x16x32_bf16(wf[ks], sl, acc, 0, 0, 0); }
        if (act) *(f32x4*)(BIAS + ((size_t)(l * 3 + g) * NB + fr) * (2 * F) + n0 + 4 * fq) = acc;
    }
    __syncthreads();
}

__global__ void __launch_bounds__(NWAVES * 64, 2) mega(Args args) {
    Frame FR;
    FR.lds = (LAS unsigned char*)lds_raw;
    volatile LAS unsigned* MISC = (volatile LAS unsigned*)(FR.lds + MISC_OFF);
    FR.wave = __builtin_amdgcn_readfirstlane((int)threadIdx.x >> 6);
    FR.G = gridDim.x; { const int bx = blockIdx.x; FR.vcu = (FR.G % 8 == 0) ? (bx % 8) * (FR.G / 8) + bx / 8 : bx; }
    FR.gw = FR.vcu * NWAVES + FR.wave; FR.NGW = FR.G * NWAVES;
    unsigned char* ws = args.ws;
    gu32* ctl = (gu32*)(ws + WS_CTL);
    for (int u = (int)threadIdx.x; u < (LDS_BYTES - LDSCTL_OFF) / 4; u += NWAVES * 64) ((LAS unsigned*)(FR.lds + LDSCTL_OFF))[u] = 0u;
    __syncthreads();
#if PROBE_PRO
    if (blockIdx.x == 0 && (int)threadIdx.x == 0) ((volatile LAS unsigned long long*)((LAS unsigned char*)lds_raw + MISC_OFF + 200))[0] = __builtin_amdgcn_s_memrealtime();
#endif
    const int lo = args.ph_lo, hi = args.ph_hi;
    if (MK_ONE_LAUNCH || hi - lo > 1) (void)xcd_barrier_post((unsigned*)(ctl + CW_BAR) + args.li * XCD_BAR_WORDS, MISC + 8);
#define bar (XcdBarrier{(unsigned*)((gu32*)(args.ws + WS_CTL) + CW_BAR) + args.li * XCD_BAR_WORDS, xb_xcc_id(), (volatile LAS unsigned*)((LAS unsigned char*)lds_raw + MISC_OFF) + 8})
#if MK_ONE_LAUNCH
#define IN(k) true
#if PROBE_BAR2
#define SEAM(k) do { xcd_barrier(bar); xcd_barrier(bar); } while (0)
#else
#define SEAM(k) xcd_barrier(bar)
#endif
#else
#define IN(k) (lo <= (k) && (k) < hi)
#define SEAM(k) do { if (IN(k) && IN((k) + 1)) xcd_barrier(bar); } while (0)
#endif
    float* X = (float*)(ws + WS_X); bf16_t* H = (bf16_t*)(ws + WS_H); bf16_t* Y = (bf16_t*)(ws + WS_Y); bf16_t* ACT = (bf16_t*)(ws + WS_ACT); bf16_t* PROJ = (bf16_t*)(ws + WS_PROJ);
    float* MODP = (float*)(ws + WS_MODP); float* MOD = (float*)(ws + WS_MOD); float* TABD = (float*)(ws + WS_TABD); float* TABR = (float*)(ws + WS_TABR);

    float* ANORM = (float*)(ws + WS_ANORM); float* BIAS = (float*)(ws + WS_BIAS); float* SSQ = (float*)(ws + WS_SSQ); bf16_t* XS = H;
    for (int repp = 0; repp < PROBE_REPP; ++repp) {
    if (IN(0)) {
        for (int i = FR.gw * 64 + lane_id(); i < M * 36; i += FR.NGW * 64) {
            const int m = i / 36, f = i % 36; const float p = (float)args.pos[m];
            if (f < 4) { const float inv = powf(500000.0f, -0.25f * (float)f); float s, c; sincosf(p * (f == 0 ? 1.0f : inv), &s, &c); TABD[m * 8 + f] = c; TABD[m * 8 + 4 + f] = s; }
            else { const int g = f - 4; const float inv = powf(10000.0f, -(float)g * (2.0f / 64.0f)); float s, c; sincosf(p * inv, &s, &c); TABR[m * 64 + g] = c; TABR[m * 64 + 32 + g] = s; }
        }
        LAS float* sc = (LAS float*)(FR.lds + RING_OFF);
        for (int i = (int)threadIdx.x; i < NB * D; i += NWAVES * 64) sc[i] = siluf_(args.in[1][i]);
        __syncthreads();
        for (int it = FR.gw; it < NL * NKC * (NMD / 256); it += FR.NGW) {
            const int nb = it % (NMD / 256), kc = (it / (NMD / 256)) % NKC, l = it / ((NMD / 256) * NKC);
            const float* W = args.in[6] + ((size_t)l * D + kc * KC) * NMD + nb * 256 + lane_id() * 4;
            f32x4 a0 = {0, 0, 0, 0}, a1 = a0, a2 = a0, a3 = a0;
#pragma unroll 8
            for (int k = 0; k < KC; ++k) { const f32x4 w = __builtin_nontemporal_load((const GAS f32x4*)(W + (size_t)k * NMD)); const int kk = kc * KC + k;
                a0 += w * sc[kk]; a1 += w * sc[D + kk]; a2 += w * sc[2 * D + kk]; a3 += w * sc[3 * D + kk]; }
            float* P = MODP + ((size_t)(kc * NL + l) * NB) * NMD + nb * 256 + lane_id() * 4;
            *(f32x4*)(P) = a0; *(f32x4*)(P + NMD) = a1; *(f32x4*)(P + 2 * NMD) = a2; *(f32x4*)(P + 3 * NMD) = a3;
        }
        __syncthreads();
        { LAS float* scr = (LAS float*)(FR.lds + RING_OFF + FR.wave * 16384);
          for (int it = FR.gw; it < CONV_ITEMS_L; it += FR.NGW) conv_item(ConvSrc{args.in[8], args.in[9], args.in[10], args.in[11], args.in[12], args.in[13]}, ws, 0, it, scr, lane_id()); }
        __syncthreads();
    }
    SEAM(0);
    if (IN(1)) {
        for (int i = FR.gw * 64 + lane_id(); i < NL * NB * NMD; i += FR.NGW * 64) {
            const int l = i / (NB * NMD), b = (i / NMD) % NB, n = i % NMD; float s = args.in[7][l * NMD + n];
            for (int kc = 0; kc < NKC; ++kc) s += MODP[(size_t)kc * NL * NB * NMD + i];
            MOD[i] = s;
            const int part = n / D, k = n % D;
            if (part % 3 == 1) { const int j = part / 3; ANORM[(((size_t)l * 3 + j) * NB + b) * D + k] = args.in[3 + j][l * D + k] * (1.0f + s); } }
        { bf16_t* GW = (bf16_t*)(ws + WS_GW); float* SP8 = (float*)(ws + WS_SP8); float* LAMS = (float*)(ws + WS_LAMS);
          for (int i = FR.gw * 64 + lane_id(); i < NL * 2 * 6 * 64 * 64; i += FR.NGW * 64) { const int in_ = i & 63, out = (i >> 6) & 63, h = (i >> 12) % 6, g = ((i >> 12) / 6) & 1, l = (i >> 12) / 12;
              const float v = args.in[g ? 18 : 16][(((size_t)l * 6 + h) * 64 + in_) * 64 + out]; GW[i] = (bf16_t)(pk2(v, 0.f) & 0xffffu); }
          for (int i = FR.gw * 64 + lane_id(); i < NL * RW; i += FR.NGW * 64) SP8[i] = -8.0f * log1pf(expf(-args.in[20][i]));
          if (FR.gw < NL) { const int l = FR.gw; float s1 = 0.f, s2 = 0.f; if (lane_id() < 32) { s1 = args.in[21][l * 32 + lane_id()] * args.in[22][l * 32 + lane_id()]; s2 = args.in[23][l * 32 + lane_id()] * args.in[24][l * 32 + lane_id()]; }
              s1 = wave_sum(s1); s2 = wave_sum(s2); if (lane_id() == 0) LAMS[l] = expf(s1) - expf(s2) + args.lam_init[l]; } }
    }
    SEAM(1);
    if (IN(2)) {
        { const int b = FR.gw >> 9; const float* ap = ANORM + (size_t)b * D; f32x4 Av[4];
#pragma unroll
          for (int jj = 0; jj < 4; ++jj) Av[jj] = *(const f32x4*)(ap + 4 * lane_id() + 256 * jj);
          for (int rr = 0; rr < 8; ++rr) { const int m = FR.gw * 8 + rr; const GAS f32x4* xr = (const GAS f32x4*)(args.in[0] + (size_t)m * D) + lane_id(); f32x4 v[4]; float s2 = 0.f;
#pragma unroll
              for (int jj = 0; jj < 4; ++jj) { v[jj] = __builtin_nontemporal_load(xr + 64 * jj); s2 += (v[jj].x * v[jj].x + v[jj].y * v[jj].y) + (v[jj].z * v[jj].z + v[jj].w * v[jj].w); }
              s2 = wave_sum(s2);
              if (lane_id() < 16) SSQ[(size_t)m * 16 + lane_id()] = lane_id() == 0 ? s2 : 0.f;
              GAS u32x2* o8 = (GAS u32x2*)(XS + (size_t)m * D) + lane_id();
#pragma unroll
              for (int jj = 0; jj < 4; ++jj) { const f32x4 h = v[jj] * Av[jj]; u32x2 w; w.x = pk2(h.x, h.y); w.y = pk2(h.z, h.w); o8[64 * jj] = w;
                  u32x2 xw; xw.x = pkh2(v[jj].x, v[jj].y); xw.y = pkh2(v[jj].z, v[jj].w); ((GAS u32x2*)((bf16_t*)(ws + WS_X) + (size_t)m * D) + lane_id())[64 * jj] = xw; } } }
        bias_layer_mma(ws, 0, FR.lds + RING_OFF, FR.gw, FR.NGW, lane_id());
        __syncthreads();
    }
#if PROBE_PRO == 1
    if (blockIdx.x == 0 && (int)threadIdx.x == 0) { asm volatile("s_waitcnt vmcnt(0)" ::: "memory"); const unsigned long long r0_ = __builtin_amdgcn_s_memrealtime(), d_ = (r0_ - ((volatile LAS unsigned long long*)((LAS unsigned char*)lds_raw + MISC_OFF + 200))[0]) * 3ull;
        while (__builtin_amdgcn_s_memrealtime() - r0_ < d_ && __builtin_amdgcn_s_memrealtime() - r0_ < 2000000ull) __builtin_amdgcn_s_sleep(16); }
#endif
    SEAM(2);

    }
    LAS float* rstd_lds = (LAS float*)(FR.lds + LDS_RSTD_OFF);
    for (int l = 0; l < NL; ++l) {
        const int pb = PH_L0 + l * NPH;
        unsigned char* wl = ws + WS_W + (size_t)l * W_L;
        const float* modl = MOD + (size_t)l * NB * NMD;
#define RSTD_TABLE(Ncols, slot, lg_) do { int tl_ = (int)threadIdx.x; asm volatile("" : "+v"(tl_)); pg8::StaticOrder S_; S_.init(M, (Ncols), FR.G, (int)blockIdx.x); const float* sq_ = SSQ + (size_t)(slot) * M * 16; \
            int pmv_[6], pnv_[6];     \
            _Pragma("unroll") for (int i_ = 0; i_ < 6; ++i_) { pg8::Unit u_{0, 0, 0}; const bool k_ = S_.next(i_, u_); pmv_[i_] = __builtin_amdgcn_readfirstlane(k_ ? u_.pm : -1); pnv_[i_] = __builtin_amdgcn_readfirstlane(k_ ? u_.pn : 0); } \
            if (tl_ < 256) { f32x4 a_[6];     \
                _Pragma("unroll") for (int i_ = 0; i_ < 6; ++i_) { const GAS f32x4* q_ = (const GAS f32x4*)(sq_ + ((size_t)(pmv_[i_] < 0 ? 0 : pmv_[i_]) * 256 + tl_) * 16); a_[i_] = (q_[0] + q_[1]) + (q_[2] + q_[3]); } \
                _Pragma("unroll") for (int i_ = 0; i_ < 6; ++i_) if (pmv_[i_] >= 0) rstd_lds[i_ * 256 + tl_] = 1.0f / sqrtf(((a_[i_][0] + a_[i_][1]) + (a_[i_][2] + a_[i_][3])) * (1.f / D) + EPS); } \
            else { float b_[6]; const GAS float* bs_ = (const GAS float*)(BIAS + (size_t)(lg_) * NB * (2 * F)) + (tl_ - 256);     \
                _Pragma("unroll") for (int i_ = 0; i_ < 6; ++i_) b_[i_] = bs_[(size_t)((pmv_[i_] < 0 ? 0 : pmv_[i_]) >> 4) * (2 * F) + pnv_[i_] * 256]; \
                _Pragma("unroll") for (int i_ = 0; i_ < 6; ++i_) if (pmv_[i_] >= 0) ((LAS float*)(FR.lds + LDS_BIAS_OFF))[i_ * 256 + tl_ - 256] = b_[i_]; } \
            __syncthreads(); } while (0)
#define FFN_IN_PHASE(k, c, WOFF, g) do { if (IN(pb + (k))) { RSTD_TABLE(2 * F, (c) & 1, l * 3 + (g)); \
            pg8::Gemm g_{XS, (const bf16_t*)(wl + (WOFF)), M, 2 * F, D, 0}; pg8::StaticOrder S; S.init(M, 2 * F, FR.G, (int)blockIdx.x); pg8::EpiSwiglu E{ws, l * 3 + (g)}; \
            if ((k) == 0) CLK_BEGIN(1); pg8::gemm_phase<pg8::EpiSwiglu, pg8::StaticOrder, true, MK_SP2>(FR.lds + RING_OFF, g_, S, E); if ((k) == 0) { CLK_END(1); EPT_END(1); } } } while (0)
#define OUT_PHASE(k, c, Aop, WOFF, Kdim, gidx, coef_, jn) do { if (IN(pb + (k))) { \
            const bool last_ = (l == NL - 1) && ((jn) == 3); \
            pg8::Gemm g_{Aop, (const bf16_t*)(wl + (WOFF)), M, D, (Kdim), (Kdim) == F ? 1 : 0}; pg8::StaticOrder S; S.init(M, D, FR.G, (int)blockIdx.x); \
            pg8::EpiResid E{ws, l, (gidx), last_ ? -1 : ((jn) == 3 ? (l + 1) * 3 : l * 3 + (jn)), ((c) + 1) & 1, (coef_)}; \
            if ((k) == 1) CLK_BEGIN(3); pg8::gemm_phase<pg8::EpiResid, pg8::StaticOrder, true, MK_SP2>(FR.lds + RING_OFF, g_, S, E); if ((k) == 1) { CLK_END(3); EPT_END(3); } } } while (0)
        const int c0 = 3 * l;
        FFN_IN_PHASE(0, c0, W_1IN, 0);
#if PROBE_REPG > 1
        if (IN(pb + 0)) xcd_barrier(bar);
        FFN_IN_PHASE(0, c0, W_1IN, 0);
#endif
        SEAM_P(pb + 0);
        OUT_PHASE(1, c0, ACT, W_1OUT, F, 2, 0.5f, 1);
#if PROBE_REPO > 1
        xcd_barrier(bar); OUT_PHASE(1, (c0) + 2, ACT, W_1OUT, F, 2, 0.0f, 1);
#endif
        SEAM_P(pb + 1);
        if (IN(pb + 2)) { RSTD_TABLE(NINP, (c0 + 1) & 1, l * 3 + 1);
            pg8::Gemm g{XS, (const bf16_t*)(wl + W_IN), M, NINP, D, 0}; pg8::StaticOrder S; S.init(M, NINP, FR.G, (int)blockIdx.x); pg8::EpiMixIn E{ws, l};
            pg8::gemm_phase<pg8::EpiMixIn, pg8::StaticOrder, true, MK_SP2>(FR.lds + RING_OFF, g, S, E); EPT_END(5); }
        SEAM_P(pb + 2);
#if !MK_NAIVE_MIX
        for (int rep5 = 0; rep5 < PROBE_REP5; ++rep5) { if (rep5) xcd_barrier(bar);
        if (IN(pb + 3)) {
            const bf16_t* GWl = (const bf16_t*)(ws + WS_GW) + (size_t)l * 2 * 6 * 64 * 64;
            const float lam = ((const float*)(ws + WS_LAMS))[l], lam_init = args.lam_init[l];
            LAS unsigned* qw = (LAS unsigned*)(FR.lds + LDSCTL_OFF + 256);
            CLK_BEGIN(2);
            constexpr unsigned N_RG = NB * 64 * 6 / NWAVES, Q_R1 = (unsigned)mix::N_RET, Q_DIFF = Q_R1 + N_RG, Q_R2 = Q_DIFF + (unsigned)mix::N_DIFF, Q_CONV = Q_R2 + N_RG;
            unsigned* r1done = (unsigned*)(ctl + CW_Q + 64 * (l + NL * rep5) + 32);
            bool pub = false;
            for (;;) {
                if ((int)threadIdx.x == 0) {
                    if (pub) { __builtin_amdgcn_fence(__ATOMIC_RELEASE, "agent"); (void)__hip_atomic_fetch_add(r1done, 1u, RLX_AGENT); }
                    *qw = __hip_atomic_fetch_add((unsigned*)(ctl + CW_Q + 64 * (l + NL * rep5)), 1u, RLX_AGENT); }
                __syncthreads();
                pub = false;
                const unsigned it = __builtin_amdgcn_readfirstlane(*qw);
                if (it >= Q_R1 && it < Q_DIFF) { const int wi = (int)(it - Q_R1) * NWAVES + FR.wave;
                    mix::rglru_item<1>(wi, PROJ, GWl, (const float*)(ws + WS_SP8) + l * RW, args.in[14] + l * 4 * RW, args.in[15] + l * RW, args.in[17] + l * RW, args.in[19] + l * RW, (float*)(ws + WS_AGGA), (float*)(ws + WS_AGGB), Y, lane_id());
                    asm volatile("s_waitcnt vmcnt(0)" ::: "memory"); __syncthreads();
                    pub = true;
                    continue; }
                if (it >= Q_R2 && it < Q_CONV) {
                    if ((int)threadIdx.x == 0) { unsigned sp_ = 0; while (__hip_atomic_load(r1done, RLX_AGENT) < N_RG) { __builtin_amdgcn_s_sleep(2); if (++sp_ > (1u << 17)) break; } __builtin_amdgcn_fence(__ATOMIC_ACQUIRE, "agent"); }
                    __syncthreads();
                    const int wi = (int)(it - Q_R2) * NWAVES + FR.wave;
                    mix::rglru_item<2>(wi, PROJ, GWl, (const float*)(ws + WS_SP8) + l * RW, args.in[14] + l * 4 * RW, args.in[15] + l * RW, args.in[17] + l * RW, args.in[19] + l * RW, (float*)(ws + WS_AGGA), (float*)(ws + WS_AGGB), Y, lane_id());
                    continue; }
                if (it >= Q_CONV) {
                    const int cw = (int)(it - Q_CONV);
                    if (l + 1 >= NL || cw >= CONV_WG_ITEMS) break;
                    const int r = cw * NWAVES + FR.wave;
                    if (r < CONV_ITEMS_L) conv_item(ConvSrc{args.in[8], args.in[9], args.in[10], args.in[11], args.in[12], args.in[13]}, ws, l + 1, r, (LAS float*)(FR.lds + RING_OFF + FR.wave * 16384), lane_id());
                    continue; }
                const unsigned code = mix::g_items.v[it < Q_R1 ? it : it - N_RG]; const int qb = (code >> 8) & 15, bh = code & 31;
                if (code & 0x8000u) mix::ret_seq(bh >> 2, bh & 3, PROJ, Y, FR.lds + RING_OFF);
                else mix::attn_unit<0>(bh / 6, bh % 6, qb, PROJ, Y, FR.lds + RING_OFF, lam, lam_init, args.in[25] + l * 64);
            }
            CLK_END(2);
        } }
#endif
        SEAM_P(pb + 3);
        OUT_PHASE(5, c0 + 1, Y, W_OUT, D, 5, 1.0f, 2);
#if PROBE_REPO > 1
        xcd_barrier(bar); OUT_PHASE(5, (c0 + 1) + 2, Y, W_OUT, D, 5, 0.0f, 2);
#endif
        SEAM_P(pb + 5);
        FFN_IN_PHASE(6, c0 + 2, W_2IN, 2);
        if (IN(pb + 6) && l + 1 < NL) {
            const int nfull = ((M / 256) * (2 * F / 256)) % FR.G;
            if (nfull > 0) { if ((int)blockIdx.x >= nfull) bias_layer_mma(ws, l + 1, FR.lds + RING_OFF, ((int)blockIdx.x - nfull) * NWAVES + FR.wave, (FR.G - nfull) * NWAVES, lane_id()); }
            else bias_layer_mma(ws, l + 1, FR.lds + RING_OFF, FR.gw, FR.NGW, lane_id());
        }
        SEAM_P(pb + 6);
        OUT_PHASE(7, c0 + 2, ACT, W_2OUT, F, 8, 0.5f, 3);
#if PROBE_REPO > 1
        xcd_barrier(bar); OUT_PHASE(7, (c0 + 2) + 2, ACT, W_2OUT, F, 8, 0.0f, 3);
#endif
        SEAM_P(pb + 7);
#if PROBE_PRO >= 10
        if (l == PROBE_PRO % 10 && blockIdx.x == 0 && (int)threadIdx.x == 0) { const unsigned long long r0_ = __builtin_amdgcn_s_memrealtime(), d_ = PROBE_PRO >= 20 ? 20000ull : (r0_ - ((volatile LAS unsigned long long*)((LAS unsigned char*)lds_raw + MISC_OFF + 200))[0]);
            while (__builtin_amdgcn_s_memrealtime() - r0_ < d_ && __builtin_amdgcn_s_memrealtime() - r0_ < 2000000ull) __builtin_amdgcn_s_sleep(16); }
#endif
    }
    if (IN(PH_FINAL)) {
        int lnf = lane_id(); asm volatile("" : "+v"(lnf));
        const float* gp = args.in[26]; f32x4 Gv[4];
#pragma unroll
        for (int jj = 0; jj < 4; ++jj) Gv[jj] = *(const f32x4*)(gp + 4 * lnf + 256 * jj);
        for (int rr = 0; rr < 8; ++rr) { const int m = FR.gw * 8 + rr; const GAS u32x2* xr = (const GAS u32x2*)((const bf16_t*)(ws + WS_X) + (size_t)m * D) + lnf; f32x4 v[4]; float s2 = 0.f;
#pragma unroll
            for (int jj = 0; jj < 4; ++jj) { const u32x2 xw = xr[64 * jj]; v[jj] = (f32x4){hlo(xw.x), hhi(xw.x), hlo(xw.y), hhi(xw.y)}; s2 += (v[jj].x * v[jj].x + v[jj].y * v[jj].y) + (v[jj].z * v[jj].z + v[jj].w * v[jj].w); }
            const float rstd = 1.0f / sqrtf(wave_sum(s2) * (1.f / D) + EPS);
            GAS f32x4* o = (GAS f32x4*)(args.out + (size_t)m * D) + lnf;
#pragma unroll
            for (int jj = 0; jj < 4; ++jj) o[64 * jj] = v[jj] * rstd * Gv[jj]; }
    }
#if PROBE_PRO == 2
    if (blockIdx.x == 0 && (int)threadIdx.x == 0) { asm volatile("s_waitcnt vmcnt(0)" ::: "memory"); const unsigned long long r0_ = __builtin_amdgcn_s_memrealtime(), d_ = (r0_ - ((volatile LAS unsigned long long*)((LAS unsigned char*)lds_raw + MISC_OFF + 200))[0]);
        while (__builtin_amdgcn_s_memrealtime() - r0_ < d_ && __builtin_amdgcn_s_memrealtime() - r0_ < 2000000ull) __builtin_amdgcn_s_sleep(16); }
#endif
#undef IN
#undef SEAM
#undef bar
}

__global__ void nv_conv(const bf16_t* PROJ, const float* cw, const float* cb, float* xc) {
    const int idx = blockIdx.x * 256 + threadIdx.x; if (idx >= M * RW) return;
    const int m = idx / RW, c = idx % RW, t = m & (T - 1); float s = cb[c];
    for (int j = 0; j < 4; ++j) { const int tt = t - 3 + j; if (tt >= 0) s += cw[j * RW + c] * bf2f(PROJ[(size_t)(m - 3 + j) * NINP + C_RX + c]); }
    xc[idx] = s;
}
__global__ void nv_gates(const float* xc, const float* wa, const float* ba, const float* wx, const float* bx, const float* lam, float* av, float* bv) {
    const int idx = blockIdx.x * 256 + threadIdx.x; if (idx >= M * RW) return;
    const int m = idx / RW, c = idx % RW, h = c >> 6, cc = c & 63; float sr = ba[c], si = bx[c];
    for (int i = 0; i < 64; ++i) { const float xv = xc[(size_t)m * RW + 64 * h + i]; sr += xv * wa[(h * 64 + i) * 64 + cc]; si += xv * wx[(h * 64 + i) * 64 + cc]; }
    const float r = 1.f / (1.f + expf(-sr)), ig = 1.f / (1.f + expf(-si)); const float sp = log1pf(expf(-lam[c])); const float la = -8.0f * r * sp;
    av[idx] = expf(la); bv[idx] = sqrtf(-expm1f(2.f * la)) * ig * xc[idx];
}
__global__ void nv_scan(const float* av, const float* bv, const bf16_t* PROJ, bf16_t* Y) {
    const int idx = blockIdx.x * 64 + threadIdx.x; if (idx >= NB * RW) return;
    const int b = idx / RW, c = idx % RW; float h = 0.f;
    for (int t = 0; t < T; ++t) { const size_t m = (size_t)b * T + t; h = av[m * RW + c] * h + bv[m * RW + c];
        const float g = bf2f(PROJ[m * NINP + C_RG + c]); const float u = 0.7978845608028654f * (g + 0.044715f * g * g * g); const float y = 0.5f * g * (1.f + tanhf(u)) * h;
        Y[m * D + c] = (bf16_t)(pk2(y, 0.f) & 0xffffu); }
}
__global__ void __launch_bounds__(64) nv_diff(const bf16_t* PROJ, float* OT) {
    const int t = blockIdx.x * 64 + threadIdx.x, hc = blockIdx.y, h = hc >> 1, comp = hc & 1, b = blockIdx.z;
    const size_t m = (size_t)b * T + t;
    float q[32], o[64];
#pragma unroll
    for (int i = 0; i < 32; ++i) q[i] = bf2f(PROJ[m * NINP + C_DQ + 64 * h + 32 * comp + i]);
#pragma unroll
    for (int i = 0; i < 64; ++i) o[i] = 0.f;
    float mx = -INFINITY, lsum = 0.f; const int tmax = blockIdx.x * 64 + 63;
    for (int j = 0; j <= tmax; ++j) {
        const bf16_t* kr = PROJ + ((size_t)b * T + j) * NINP + C_DK + 64 * h + 32 * comp; const bf16_t* vr = PROJ + ((size_t)b * T + j) * NINP + C_DV + 64 * h;
        float s = 0.f;
#pragma unroll
        for (int i = 0; i < 32; ++i) s += q[i] * bf2f(kr[i]);
        if (j <= t) { const float mn = fmaxf(mx, s); const float al = exp2f(mx - mn), p = exp2f(s - mn); lsum = lsum * al + p; mx = mn;
#pragma unroll
            for (int i = 0; i < 64; ++i) o[i] = o[i] * al + p * bf2f(vr[i]); }
    }
    const float il = 1.f / lsum; float* op = OT + ((m * 6 + h) * 2 + comp) * 64;
#pragma unroll
    for (int i = 0; i < 64; ++i) op[i] = o[i] * il;
}
__global__ void nv_diff_fin(const float* OT, const float* lq1, const float* lk1, const float* lq2, const float* lk2, const float* subg, float lambda_init, bf16_t* Y) {
    const int idx = blockIdx.x * 256 + threadIdx.x; if (idx >= M * 6) return;
    float s1 = 0.f, s2 = 0.f; for (int i = 0; i < 32; ++i) { s1 += lq1[i] * lk1[i]; s2 += lq2[i] * lk2[i]; }
    const float lam = expf(s1) - expf(s2) + lambda_init;
    const int m = idx / 6, h = idx % 6; const float* o1 = OT + ((size_t)idx * 2) * 64; const float* o2 = o1 + 64; float ss = 0.f;
    for (int i = 0; i < 64; ++i) { const float v = o1[i] - lam * o2[i]; ss += v * v; }
    const float r = 1.0f / sqrtf(ss * (1.f / 64.f) + EPS) * (1.f - lambda_init);
    for (int i = 0; i < 64; ++i) { const float v = (o1[i] - lam * o2[i]) * r * subg[i]; Y[(size_t)m * D + RW + 64 * h + i] = (bf16_t)(pk2(v, 0.f) & 0xffffu); }
}
__global__ void __launch_bounds__(64) nv_ret(const bf16_t* PROJ, bf16_t* Y) {
    const int t = blockIdx.x * 64 + threadIdx.x, h = blockIdx.y, b = blockIdx.z; const size_t m = (size_t)b * T + t;
    float q[64], o[64];
#pragma unroll
    for (int i = 0; i < 64; ++i) { q[i] = bf2f(PROJ[m * NINP + C_TQ + 64 * h + i]); o[i] = 0.f; }
    const float lg2 = log2f(1.0f - exp2f(-5.0f - (float)h)); const int tmax = blockIdx.x * 64 + 63;
    for (int j = 0; j <= tmax; ++j) {
        const bf16_t* kr = PROJ + ((size_t)b * T + j) * NINP + C_TK + 64 * h; const bf16_t* vr = PROJ + ((size_t)b * T + j) * NINP + C_TV + 64 * h;
        float s = 0.f;
#pragma unroll
        for (int i = 0; i < 64; ++i) s += q[i] * bf2f(kr[i]);
        if (j <= t) { const float p = s * exp2f(64.0f * (float)((t >> 6) - (j >> 6)) * lg2);
#pragma unroll
            for (int i = 0; i < 64; ++i) o[i] += p * bf2f(vr[i]); }
    }
    float ss = 0.f;
#pragma unroll
    for (int i = 0; i < 64; ++i) ss += o[i] * o[i];
    const float r = 1.0f / sqrtf(ss * (1.f / 64.f) + EPS);
#pragma unroll
    for (int i = 0; i < 64; ++i) { const float g = bf2f(PROJ[m * NINP + C_TG + 64 * h + i]); const float v = g / (1.f + expf(-g)) * o[i] * r; Y[m * D + 768 + 64 * h + i] = (bf16_t)(pk2(v, 0.f) & 0xffffu); }
}

extern "C" void kernel_launch(void* const* d_in, const int* in_sizes, int n_in, void* d_out, int out_size, void* d_ws, size_t ws_size, hipStream_t stream) {
    static int grid = 0;
    if (grid == 0) {
        if (n_in != 27 || in_sizes[0] != M * D || out_size != M * D || ws_size < WS_END) { fprintf(stderr, "kernel_launch: unexpected shapes (n_in %d, ws %zu < %zu)\n", n_in, ws_size, (size_t)WS_END); grid = -1; return; }
        int dev = 0, cus = 0;
        if (hipGetDevice(&dev) != hipSuccess || hipDeviceGetAttribute(&cus, hipDeviceAttributeMultiprocessorCount, dev) != hipSuccess) { grid = -1; return; }
        if (hipFuncSetAttribute((const void*)mega, hipFuncAttributeMaxDynamicSharedMemorySize, LDS_BYTES) != hipSuccess) { fprintf(stderr, "kernel_launch: hipFuncSetAttribute failed\n"); grid = -1; return; }
        int per_cu = 0;
        if (hipOccupancyMaxActiveBlocksPerMultiprocessor(&per_cu, (const void*)mega, NWAVES * 64, LDS_BYTES) != hipSuccess || per_cu < 1) fprintf(stderr, "kernel_launch: occupancy query says %d\n", per_cu);
        (void)hipGetLastError();
        grid = cus;
        if (grid != 256) { fprintf(stderr, "kernel_launch: built for 256 CUs, got %d\n", grid); }
    }
    if (grid < 0) return;
    (void)hipMemsetAsync((char*)d_ws + WS_CTL, 0, CTL_ZERO_BYTES, stream);
    Args a{};
    for (int i = 0; i < 27; ++i) a.in[i] = (const float*)d_in[i];
    a.pos = (const int*)d_in[2]; a.out = (float*)d_out; a.ws = (unsigned char*)d_ws;
    for (int l = 0; l < NL; ++l) a.lam_init[l] = (float)(0.8 - 0.6 * exp(-0.3 * (double)l));
    unsigned char* ws = (unsigned char*)d_ws;
#if MK_ONE_LAUNCH
    a.ph_lo = 0; a.ph_hi = PH_END;
    hipLaunchKernelGGL(mega, dim3(grid), dim3(NWAVES * 64), LDS_BYTES, stream, a);
#else
    int nrun = 0; auto run = [&](int lo, int hi) { a.ph_lo = lo; a.ph_hi = hi; a.li = nrun++; hipLaunchKernelGGL(mega, dim3(grid), dim3(NWAVES * 64), LDS_BYTES, stream, a); };
    int seg_lo = 0;
    for (int l = 0; l < NL; ++l) {
        const int pb = PH_L0 + l * NPH;
        run(seg_lo, pb + 3); seg_lo = pb + 5;
#if !MK_NAIVE_MIX
        run(pb + 3, pb + 4); run(pb + 4, pb + 5);
#endif
        if (MK_NAIVE_MASK) {
            const bf16_t* PROJ = (const bf16_t*)(ws + WS_PROJ); bf16_t* Y = (bf16_t*)(ws + WS_Y);
            float* xc = (float*)(ws + WS_TMP); float* av = xc + (size_t)M * RW; float* bv = av + (size_t)M * RW; float* OT = (float*)(ws + WS_TMP);
            if (MK_NAIVE_MASK & 1) {
                hipLaunchKernelGGL(nv_conv, dim3(M * RW / 256), dim3(256), 0, stream, PROJ, a.in[14] + l * 4 * RW, a.in[15] + l * RW, xc);
                hipLaunchKernelGGL(nv_gates, dim3(M * RW / 256), dim3(256), 0, stream, xc, a.in[16] + l * 6 * 64 * 64, a.in[17] + l * RW, a.in[18] + l * 6 * 64 * 64, a.in[19] + l * RW, a.in[20] + l * RW, av, bv);
                hipLaunchKernelGGL(nv_scan, dim3(NB * RW / 64), dim3(64), 0, stream, av, bv, PROJ, Y); }
            if (MK_NAIVE_MASK & 2) {
                hipLaunchKernelGGL(nv_diff, dim3(T / 64, 12, NB), dim3(64), 0, stream, PROJ, OT);
                hipLaunchKernelGGL(nv_diff_fin, dim3(M * 6 / 256), dim3(256), 0, stream, OT, a.in[21] + l * 32, a.in[22] + l * 32, a.in[23] + l * 32, a.in[24] + l * 32, a.in[25] + l * 64, a.lam_init[l], Y); }
            if (MK_NAIVE_MASK & 4) hipLaunchKernelGGL(nv_ret, dim3(T / 64, 4, NB), dim3(64), 0, stream, PROJ, Y);
        }
    }
    run(seg_lo, PH_END);
#endif
}
```

```cpp
#include <hip/hip_runtime.h>
#include <cstdio>
#include <cstdint>
#include <cmath>

#ifndef MK_ONE_LAUNCH
#define MK_ONE_LAUNCH 1
#endif
#ifndef PROBE_REP5
#define PROBE_REP5 1
#endif
#ifndef PROBE_EPIR2
#define PROBE_EPIR2 0
#endif
#ifndef PROBE_EPI2
#define PROBE_EPI2 0
#endif
#ifndef PROBE_XEXP
#define PROBE_XEXP 0
#endif
#if PROBE_XEXP
#define PROBE_EXTRA_EXP(pa, pb) do { _Pragma("unroll") for (int r = 0; r < 16; ++r) { float d0_, d1_; asm volatile("v_exp_f32 %0, %2\n\tv_exp_f32 %1, %3" : "=v"(d0_), "=v"(d1_) : "v"(pa[r]), "v"(pb[r])); } } while (0)
#else
#define PROBE_EXTRA_EXP(pa, pb) do { } while (0)
#endif
#ifndef MK_SP2
#define MK_SP2 true
#endif
#ifndef PROBE_REPO
#define PROBE_REPO 1
#endif
#ifndef PROBE_REPP
#define PROBE_REPP 1
#endif
#ifndef PROBE_REPR
#define PROBE_REPR 1
#endif
#ifndef PROBE_BAR2
#define PROBE_BAR2 0
#endif
#ifndef PROBE_REPG
#define PROBE_REPG 1
#endif
#ifndef PROBE_CLK
#define PROBE_CLK 0
#endif
#ifndef PROBE_EPT
#define PROBE_EPT 0
#endif
#ifndef PROBE_BARW
#define PROBE_BARW 0
#endif
#ifndef PROBE_BARW_WG
#define PROBE_BARW_WG 0
#endif
#ifndef PROBE_PRO
#define PROBE_PRO 0
#endif
#ifndef PROBE_MIXV
#define PROBE_MIXV 0
#endif
#ifndef PROBE_DV
#define PROBE_DV 0
#endif
#ifndef PROBE_TL
#define PROBE_TL 0
#endif
#ifndef PROBE_PHT
#define PROBE_PHT 0
#endif
#if PROBE_BARW
#define SEAM_P(k) do { unsigned long long b0_ = 0; const bool me_ = (PROBE_BARW - 1 == (k) - pb) && l == 1 && blockIdx.x == PROBE_BARW_WG && (int)threadIdx.x == 0; if (me_) b0_ = __builtin_amdgcn_s_memrealtime(); SEAM(k); \
        if (me_) { const unsigned long long r0_ = __builtin_amdgcn_s_memrealtime(), d_ = (r0_ - b0_) * 20ull; while (__builtin_amdgcn_s_memrealtime() - r0_ < d_ && __builtin_amdgcn_s_memrealtime() - r0_ < 2000000ull) __builtin_amdgcn_s_sleep(16); } } while (0)
#elif PROBE_PHT
#define SEAM_P(k) do { if (blockIdx.x == 0 && (int)threadIdx.x == 0 && l == 1 && (k) - pb == PROBE_PHT - 1) { volatile LAS unsigned long long* lt_ = (volatile LAS unsigned long long*)((LAS unsigned char*)lds_raw + MISC_OFF + 192); \
        asm volatile("s_waitcnt vmcnt(0)" ::: "memory"); const unsigned long long r0_ = __builtin_amdgcn_s_memrealtime(), d_ = (r0_ - lt_[0]) * 5ull; while (__builtin_amdgcn_s_memrealtime() - r0_ < d_ && __builtin_amdgcn_s_memrealtime() - r0_ < 2000000ull) __builtin_amdgcn_s_sleep(16); } \
        SEAM(k); if (blockIdx.x == 0 && (int)threadIdx.x == 0) { volatile LAS unsigned long long* lt_ = (volatile LAS unsigned long long*)((LAS unsigned char*)lds_raw + MISC_OFF + 192); lt_[0] = __builtin_amdgcn_s_memrealtime(); } } while (0)
#elif PROBE_TL
#define SEAM_P(k) do { SEAM(k); if (blockIdx.x == 0 && (int)threadIdx.x == 0 && (l == 1 || (l == 0 && (k) - pb == 7))) ((volatile LAS unsigned long long*)((LAS unsigned char*)lds_raw + MISC_OFF + 256))[l == 0 ? 0 : 1 + (k) - pb] = __builtin_amdgcn_s_memrealtime(); } while (0)
#else
#define SEAM_P(k) SEAM(k)
#endif
#if PROBE_EPT
#define EPT_END(sel) do { if ((PROBE_EPT % 10) == (sel) && (int)threadIdx.x == 0 && l == 1 && blockIdx.x == 0) { volatile LAS unsigned long long* ep_ = (volatile LAS unsigned long long*)((LAS unsigned char*)lds_raw + MISC_OFF + 160); \
        const unsigned long long d_ = (PROBE_EPT >= 10) ? (ep_[0] - ep_[2]) * 5ull : (ep_[1] - ep_[0]) * 100ull; const unsigned long long r0_ = __builtin_amdgcn_s_memrealtime(); \
        while (__builtin_amdgcn_s_memrealtime() - r0_ < d_ && __builtin_amdgcn_s_memrealtime() - r0_ < 2000000ull) __builtin_amdgcn_s_sleep(16); } } while (0)
#else
#define EPT_END(sel) do { } while (0)
#endif
#if PROBE_CLK
#define CLK_BEGIN(sel) do { if (PROBE_CLK == (sel) && (int)threadIdx.x == 0 && l == 1) { volatile LAS unsigned long long* ck_ = (volatile LAS unsigned long long*)((LAS unsigned char*)lds_raw + MISC_OFF + 128); ck_[0] = __builtin_amdgcn_s_memtime(); ck_[1] = __builtin_amdgcn_s_memrealtime(); } } while (0)
#define CLK_END(sel) do { if (PROBE_CLK == (sel) && (int)threadIdx.x == 0 && l == 1) { volatile LAS unsigned long long* ck_ = (volatile LAS unsigned long long*)((LAS unsigned char*)lds_raw + MISC_OFF + 128); \
        const unsigned long long t1_ = __builtin_amdgcn_s_memtime(), r1_ = __builtin_amdgcn_s_memrealtime(); const float dt_ = (float)(t1_ - ck_[0]), dr_ = (float)(r1_ - ck_[1]); \
        float mhz_ = dr_ > 0.f ? dt_ * 100.f / dr_ : 1000.f; mhz_ = mhz_ < 1000.f ? 1000.f : (mhz_ > 3000.f ? 3000.f : mhz_); \
        if (blockIdx.x == 0) { const unsigned long long tgt_ = (unsigned long long)((mhz_ - 1000.f) * 100.f); while (__builtin_amdgcn_s_memrealtime() - r1_ < tgt_) __builtin_amdgcn_s_sleep(16); } } } while (0)
#else
#define CLK_BEGIN(sel) do { } while (0)
#define CLK_END(sel) do { } while (0)
#endif
#ifndef MK_NAIVE_MIX
#define MK_NAIVE_MIX 0
#endif
#ifndef MK_NAIVE_MASK
#define MK_NAIVE_MASK 0
#endif

constexpr int D = 1024, NB = 4, T = 4096, M = NB * T, NL = 4, F = 2816, NMOD = 9, NMD = NMOD * D;
constexpr int NIN = 2944, NINP = 3072;
constexpr int C_DQ = 0, C_DK = 384, C_TQ = 768, C_TK = 1024, C_DV = 1280, C_TV = 1664, C_TG = 1920, C_RX = 2176, C_RG = 2560;
constexpr int RW = 384;
constexpr float EPS = 1e-6f;
constexpr float QSCALE = 0.17677669529663687f * 1.4426950408889634f;
constexpr int KC = 32, NKC = D / KC;

constexpr size_t MiB = 1u << 20;
constexpr size_t WS_CTL = 0, CTL_ZERO_BYTES = 1 * MiB;
constexpr size_t WS_MODP = 1 * MiB;
constexpr size_t WS_MOD = 20 * MiB;
constexpr size_t WS_GW = 20 * MiB + 640 * 1024;
constexpr size_t WS_TABD = 21 * MiB;
constexpr size_t WS_TABR = 22 * MiB;
constexpr size_t WS_W = 26 * MiB;
constexpr size_t W_L = 41 * MiB, W_1IN = 0, W_1OUT = 11 * MiB, W_2IN = 16 * MiB + MiB / 2, W_2OUT = 27 * MiB + MiB / 2, W_IN = 33 * MiB, W_OUT = 39 * MiB;
constexpr size_t WS_X = WS_W + NL * W_L;
constexpr size_t WS_H = WS_X + 64 * MiB;
constexpr size_t WS_Y = WS_H + 32 * MiB;
constexpr size_t WS_ACT = WS_Y + 32 * MiB;
constexpr size_t WS_PROJ = WS_ACT;
constexpr size_t WS_TMP = WS_ACT + 96 * MiB;
constexpr size_t WS_SP8 = 21 * MiB + 512 * 1024;
constexpr size_t WS_LAMS = 21 * MiB + 520 * 1024;
constexpr size_t WS_ANORM = 21 * MiB + 528 * 1024;
constexpr size_t WS_BIAS = WS_TMP + 100 * MiB;
constexpr size_t WS_SSQ = WS_TMP + 104 * MiB;
constexpr size_t WS_AGGA = WS_TMP + 110 * MiB, WS_AGGB = WS_TMP + 111 * MiB;
constexpr size_t WS_END = WS_TMP + 112 * MiB;
constexpr int CW_TMO = 0, CW_CODE = 1, CW_Q = 2048  , CW_BAR = 4096;

#define GAS __attribute__((address_space(1)))
#define LAS __attribute__((address_space(3)))
typedef unsigned short bf16_t;
typedef short bf16x8 __attribute__((ext_vector_type(8)));
typedef float f32x4 __attribute__((ext_vector_type(4)));
typedef float f32x2 __attribute__((ext_vector_type(2)));
typedef unsigned u32x4 __attribute__((ext_vector_type(4)));
typedef unsigned u32x2 __attribute__((ext_vector_type(2)));
typedef __bf16 bf16x2_t __attribute__((ext_vector_type(2)));
typedef GAS unsigned gu32;
#define RLX_AGENT __ATOMIC_RELAXED, __HIP_MEMORY_SCOPE_AGENT
#define LDS_WAIT() asm volatile("s_waitcnt lgkmcnt(0)" ::: "memory")
#define VM_WAIT() asm volatile("s_waitcnt vmcnt(0)" ::: "memory")
__device__ __forceinline__ unsigned pk2(float lo, float hi) { f32x2 v = {lo, hi}; bf16x2_t b = __builtin_convertvector(v, bf16x2_t); return __builtin_bit_cast(unsigned, b); }
typedef _Float16 h16x2_t __attribute__((ext_vector_type(2)));
__device__ __forceinline__ unsigned pkh2(float lo, float hi) { f32x2 v = {lo, hi}; h16x2_t h = __builtin_convertvector(v, h16x2_t); return __builtin_bit_cast(unsigned, h); }
__device__ __forceinline__ float hlo(unsigned w) { const h16x2_t h = __builtin_bit_cast(h16x2_t, w); return (float)h[0]; }
__device__ __forceinline__ float hhi(unsigned w) { const h16x2_t h = __builtin_bit_cast(h16x2_t, w); return (float)h[1]; }
__device__ __forceinline__ float bf2f(bf16_t v) { return __uint_as_float((unsigned)v << 16); }
__device__ __forceinline__ float bflo(unsigned w) { return __uint_as_float(w << 16); }
__device__ __forceinline__ float bfhi(unsigned w) { return __uint_as_float(w & 0xffff0000u); }
__device__ __forceinline__ float fast_rcp(float x) { return __builtin_amdgcn_rcpf(x); }
__device__ __forceinline__ float sigmoidf_(float x) { return fast_rcp(1.f + __builtin_amdgcn_exp2f(-1.4426950408889634f * x)); }
__device__ __forceinline__ float siluf_(float x) { return x * sigmoidf_(x); }
__device__ __forceinline__ float gelu_tanh(float x) { const float u = 0.7978845608028654f * (x + 0.044715f * x * x * x); return x * sigmoidf_(2.f * u); }
__device__ __forceinline__ int lane_id() { int l; asm volatile("v_mbcnt_lo_u32_b32 %0, -1, 0\n\tv_mbcnt_hi_u32_b32 %0, -1, %0" : "=v"(l)); return l; }
template <int XM> __device__ __forceinline__ float swz_xor(float v) { return __int_as_float(__builtin_amdgcn_ds_swizzle(__float_as_int(v), (XM << 10) | 0x1F)); }
__device__ __forceinline__ float sum_x32(float v) { const auto r = __builtin_amdgcn_permlane32_swap(__float_as_uint(v), __float_as_uint(v), false, false); return __uint_as_float(r[0]) + __uint_as_float(r[1]); }
__device__ __forceinline__ int imax_x32(int v) { const auto r = __builtin_amdgcn_permlane32_swap((unsigned)v, (unsigned)v, false, false); const int a = (int)r[0], b = (int)r[1]; return a > b ? a : b; }
__device__ __forceinline__ float wave_sum(float v) {
    v += swz_xor<1>(v); v += swz_xor<2>(v); v += swz_xor<4>(v); v += swz_xor<8>(v); v += swz_xor<16>(v);
    return sum_x32(v);
}

__device__ __forceinline__ float lg2gamma(int hh) { return hh == 0 ? -0.04580368961312479f : hh == 1 ? -0.02272007650008353f : hh == 2 ? -0.011315313227834146f : -0.005646563141142063f; }

constexpr int RING_OFF = 0, RING_BYTES = 131072, LDSCTL_OFF = RING_BYTES, MISC_OFF = LDSCTL_OFF + 320, LDS_RSTD_OFF = RING_BYTES + 1024  , LDS_BIAS_OFF = LDS_RSTD_OFF + 6144  , LDS_BYTES = 163840;
extern __shared__ __attribute__((aligned(16))) unsigned char lds_raw[];

namespace pg8 {
#define PG8_LAS __attribute__((address_space(3)))
constexpr int BM = 256, BK = 64, HALF = 128, HTB = HALF * BK * 2, STAGE_BYTES = 8 * HTB, NXCD = 8, WGM = 8;
__host__ __device__ __forceinline__ int lds_byte(int r, int c) { const int st = (r >> 4) * 2 + (c >> 5), rr = r & 15, cc = c & 31, ob = rr * 64 + cc * 2; return st * 1024 + (ob ^ (((ob >> 9) & 1) << 5)); }
__host__ __device__ __forceinline__ void stage_rc(int b, int& R, int& C) { const int st = b / 1024, sb = b % 1024, swz = sb ^ (((sb >> 9) & 1) << 5); R = (st >> 1) * 16 + swz / 64; C = (st & 1) * 32 + (swz % 64) / 2; }
__host__ __device__ __forceinline__ int perm32(int rho) { const int n = rho >> 4, i = rho & 15; return 8 * (i >> 2) + 4 * n + (i & 3); }
struct Unit { int pm, pn, idx; };
struct Gemm { const bf16_t* A; const bf16_t* Bt; int M, N, K, tiled; };
struct StaticOrder {
    int nM, nN, nwg, G, c;
    __host__ __device__ void init(int M_, int N_, int G_, int c_) { nM = M_ / BM; nN = N_ / BM; nwg = nM * nN; G = G_; c = c_;
#if defined(__HIP_DEVICE_COMPILE__)
        asm volatile("" : "+s"(c));
#endif
    }
    __host__ __device__ __forceinline__ bool next(int i, Unit& u) const {
        const long L = (long)i * G + c; if (L >= nwg) return false;
        int wgid = (int)L; { const int q = nwg / NXCD, r = nwg % NXCD, xcd = wgid % NXCD, off = wgid / NXCD; wgid = (xcd < r ? xcd * (q + 1) : r * (q + 1) + (xcd - r) * q) + off; }
        const int nig = WGM * nN, gid = wgid / nig, fm = gid * WGM, gsz = (nM - fm) < WGM ? (nM - fm) : WGM;
        u.pm = fm + ((wgid % nig) % gsz); u.pn = (wgid % nig) / gsz; u.idx = i; return true;
    }
    __device__ __forceinline__ void a_ready(const Unit&) const {}
    __device__ __forceinline__ void done(const Unit&) const {}
};

struct EpiSwiglu {
    static constexpr bool PERM = true, AFTER_DRAIN = false;
    unsigned char* ws; int lg;
    __device__ __forceinline__ void operator()(const f32x4 (&acc)[2][2][4][2], const Unit& u, int wr, int wc, int fr, int fq) const {
        bf16_t* O = (bf16_t*)(ws + WS_ACT); const float* bias = (const float*)(ws + WS_BIAS) + (size_t)lg * NB * (2 * F); const LAS float* rstd = (const LAS float*)((LAS unsigned char*)lds_raw + LDS_RSTD_OFF);
        const int row0 = u.pm * BM + wr * 64 + fr, col0 = u.pn * HALF + wc * 32 + 8 * fq;
        const LAS float* bp = (const LAS float*)((LAS unsigned char*)lds_raw + LDS_BIAS_OFF) + u.idx * BM + wc * 32 + 8 * fq;
        const f32x4 bg0 = *(const LAS f32x4*)bp, bg1 = *(const LAS f32x4*)(bp + 4), bu0 = *(const LAS f32x4*)(bp + HALF), bu1 = *(const LAS f32x4*)(bp + HALF + 4);
#pragma unroll
        for (int ai = 0; ai < 2; ++ai)
#pragma unroll
            for (int m = 0; m < 4; ++m) {
                const float rs = rstd[u.idx * BM + ai * HALF + m * 16 + wr * 64 + fr];
                const int row_ = row0 + ai * HALF + m * 16;
                bf16_t* rowp = O + ((((size_t)(row_ >> 8) * (F / 64) + (col0 >> 6)) * BM + (row_ & 255)) << 6) + (col0 & 63);
                const f32x4 g0 = acc[ai][0][m][0] * rs + bg0, g1 = acc[ai][0][m][1] * rs + bg1, u0 = acc[ai][1][m][0] * rs + bu0, u1 = acc[ai][1][m][1] * rs + bu1;
                u32x4 w;
                w.x = pk2(siluf_(g0[0]) * u0[0], siluf_(g0[1]) * u0[1]); w.y = pk2(siluf_(g0[2]) * u0[2], siluf_(g0[3]) * u0[3]);
                w.z = pk2(siluf_(g1[0]) * u1[0], siluf_(g1[1]) * u1[1]); w.w = pk2(siluf_(g1[2]) * u1[2], siluf_(g1[3]) * u1[3]);
                *(u32x4*)rowp = w;
            }
    }
};
struct EpiResid {
    static constexpr bool PERM = true, AFTER_DRAIN = false;
    unsigned char* ws; int l, gidx, an_idx, slot; float coef;
    __device__ __forceinline__ void operator()(const f32x4 (&acc)[2][2][4][2], const Unit& u, int wr, int wc, int fr, int fq) const {
        bf16_t* X = (bf16_t*)(ws + WS_X); bf16_t* XS = (bf16_t*)(ws + WS_H); float* SSQ = (float*)(ws + WS_SSQ) + (size_t)slot * M * 16;
        const float* gate = (const float*)(ws + WS_MOD) + (size_t)l * NB * NMD + gidx * D; const float* An = (const float*)(ws + WS_ANORM) + (size_t)(an_idx < 0 ? 0 : an_idx) * NB * D; const bool has_an = an_idx >= 0;
        const int row0 = u.pm * BM + wr * 64 + fr, col0 = u.pn * BM + wc * 32 + 8 * fq, b = u.pm >> 4;
        f32x4 gv[2][2], av[2][2];
#pragma unroll
        for (int bj = 0; bj < 2; ++bj)
#pragma unroll
            for (int n = 0; n < 2; ++n) { gv[bj][n] = *(const f32x4*)(gate + (size_t)b * NMD + col0 + bj * HALF + n * 4) * coef;
                av[bj][n] = *(const f32x4*)(An + (size_t)b * D + col0 + bj * HALF + n * 4); }
        u32x4 xin[2][2];
#define RES_LOAD(g_, buf) do { const size_t ro_ = (size_t)(row0 + ((g_) >> 2) * HALF + ((g_) & 3) * 16) * D + col0; \
            _Pragma("unroll") for (int bj = 0; bj < 2; ++bj) xin[buf][bj] = *(const u32x4*)(X + ro_ + bj * HALF); } while (0)
        RES_LOAD(0, 0);
#pragma unroll
        for (int g = 0; g < 8; ++g) { const int ai = g >> 2, m = g & 3, row = row0 + ai * HALF + m * 16; const size_t ro = (size_t)row * D + col0; float ss = 0.f;
            if (g + 1 < 8) RES_LOAD(g + 1, (g + 1) & 1);
#pragma unroll
            for (int bj = 0; bj < 2; ++bj) { const size_t o = ro + bj * HALF; const u32x4 xi = xin[g & 1][bj];
                const f32x4 x0 = (f32x4){hlo(xi.x), hhi(xi.x), hlo(xi.y), hhi(xi.y)} + gv[bj][0] * acc[ai][bj][m][0], x1 = (f32x4){hlo(xi.z), hhi(xi.z), hlo(xi.w), hhi(xi.w)} + gv[bj][1] * acc[ai][bj][m][1];
                { u32x4 w; w.x = pkh2(x0[0], x0[1]); w.y = pkh2(x0[2], x0[3]); w.z = pkh2(x1[0], x1[1]); w.w = pkh2(x1[2], x1[3]); *(u32x4*)(X + o) = w; }
                ss += ((x0[0] * x0[0] + x0[1] * x0[1]) + (x0[2] * x0[2] + x0[3] * x0[3])) + ((x1[0] * x1[0] + x1[1] * x1[1]) + (x1[2] * x1[2] + x1[3] * x1[3]));
                if (has_an) { const f32x4 s0 = x0 * av[bj][0], s1 = x1 * av[bj][1]; u32x4 w; w.x = pk2(s0[0], s0[1]); w.y = pk2(s0[2], s0[3]); w.z = pk2(s1[0], s1[1]); w.w = pk2(s1[2], s1[3]); *(u32x4*)(XS + o) = w; } }
            ss += swz_xor<16>(ss); ss = sum_x32(ss);
            if (fq == 0) SSQ[(size_t)row * 16 + u.pn * 4 + wc] = ss; }
#undef RES_LOAD
    }
};
struct EpiMixIn {
    static constexpr bool PERM = true, AFTER_DRAIN = false;
    unsigned char* ws; int l;
    __device__ __forceinline__ void operator()(const f32x4 (&acc)[2][2][4][2], const Unit& u, int wr, int wc, int fr, int fq) const {
        bf16_t* O = (bf16_t*)(ws + WS_PROJ); const float* tabD = (const float*)(ws + WS_TABD); const float* tabR = (const float*)(ws + WS_TABR);
        const float* bias = (const float*)(ws + WS_BIAS) + (size_t)(3 * l + 1) * NB * (2 * F); const LAS float* rstd = (const LAS float*)((LAS unsigned char*)lds_raw + LDS_RSTD_OFF);
        const int row0 = u.pm * BM + wr * 64 + fr;
#pragma unroll
        for (int bj = 0; bj < 2; ++bj) {
            const int kb = 2 * u.pn + bj, col0 = kb * HALF + wc * 32 + 8 * fq;
            const LAS float* bp = (const LAS float*)((LAS unsigned char*)lds_raw + LDS_BIAS_OFF) + u.idx * BM + bj * HALF + wc * 32 + 8 * fq;
            const f32x4 b0 = *(const LAS f32x4*)bp, b1 = *(const LAS f32x4*)(bp + 4);
            if (kb < 6) {
                const float qs = (kb < 3) ? QSCALE : 1.f;
#pragma unroll
                for (int ai = 0; ai < 2; ++ai)
#pragma unroll
                    for (int m = 0; m < 4; ++m) { const int row = row0 + ai * HALF + m * 16; const float rs = rstd[u.idx * BM + ai * HALF + m * 16 + wr * 64 + fr];
                        f32x4 v0 = acc[ai][bj][m][0] * rs + b0, v1 = acc[ai][bj][m][1] * rs + b1;
                        if (fq == 0) { const f32x4 c = *(const f32x4*)(tabD + (size_t)row * 8), s = *(const f32x4*)(tabD + (size_t)row * 8 + 4); const f32x4 r0 = v0 * c - v1 * s, r1 = v1 * c + v0 * s; v0 = r0; v1 = r1; }
                        v0 = v0 * qs; v1 = v1 * qs;
                        u32x4 w; w.x = pk2(v0[0], v0[1]); w.y = pk2(v0[2], v0[3]); w.z = pk2(v1[0], v1[1]); w.w = pk2(v1[2], v1[3]);
                        *(u32x4*)(O + (size_t)row * NINP + col0) = w; }
            } else if (kb < 10) {
                const bool isk = (kb >= 8); const int i0 = 16 * (wc & 1) + 4 * fq; const float lg = lg2gamma(2 * (kb & 1) + (wc >> 1)) * (isk ? -1.f : 1.f);
#pragma unroll
                for (int ai = 0; ai < 2; ++ai)
#pragma unroll
                    for (int m = 0; m < 4; ++m) { const int row = row0 + ai * HALF + m * 16; const float rs = rstd[u.idx * BM + ai * HALF + m * 16 + wr * 64 + fr];
                        const f32x4 v0 = acc[ai][bj][m][0] * rs + b0, v1 = acc[ai][bj][m][1] * rs + b1;
                        const f32x4 c = *(const f32x4*)(tabR + (size_t)row * 64 + i0), s = *(const f32x4*)(tabR + (size_t)row * 64 + 32 + i0);
                        const float ks = __builtin_amdgcn_exp2f((float)(row & 63) * lg) * (isk ? 0.125f : 1.f);
                        const f32x4 r0 = (v0 * c - v1 * s) * ks, r1 = (v1 * c + v0 * s) * ks;
                        u32x4 w; w.x = pk2(r0[0], r0[1]); w.y = pk2(r0[2], r0[3]); w.z = pk2(r1[0], r1[1]); w.w = pk2(r1[2], r1[3]);
                        *(u32x4*)(O + (size_t)row * NINP + col0) = w; }
            } else {
#pragma unroll
                for (int ai = 0; ai < 2; ++ai)
#pragma unroll
                    for (int m = 0; m < 4; ++m) { const int row = row0 + ai * HALF + m * 16; const float rs = rstd[u.idx * BM + ai * HALF + m * 16 + wr * 64 + fr];
                        const f32x4 v0 = acc[ai][bj][m][0] * rs + b0, v1 = acc[ai][bj][m][1] * rs + b1;
                        u32x4 w; w.x = pk2(v0[0], v0[1]); w.y = pk2(v0[2], v0[3]); w.z = pk2(v1[0], v1[1]); w.w = pk2(v1[2], v1[3]);
                        *(u32x4*)(O + (size_t)row * NINP + col0) = w; }
            }
        }
    }
};

template <class Epi, class Sched, bool ALIGN_EPI = false, bool SP2 = false>
__device__ __forceinline__ void gemm_phase(PG8_LAS unsigned char* lds, const Gemm g, const Sched& S, const Epi& E) {
    int tid_ = threadIdx.x; asm volatile("" : "+v"(tid_));
    const int tid = tid_, wid = __builtin_amdgcn_readfirstlane(tid >> 6), lane = tid & 63, wr = wid >> 2, wc = wid & 3, fr = lane & 15, fq = lane >> 4;
    const int K = g.K, nt = K / BK, ld = g.tiled ? BK : K;
    unsigned voffA[2], voffB[2];
#pragma unroll
    for (int i = 0; i < 2; ++i) { int R, C; stage_rc(tid * 16 + i * 8192, R, C); const int Rb = Epi::PERM ? ((R & ~31) + perm32(R & 31)) : R;
        voffA[i] = (unsigned)(R * ld + C) * 2u; voffB[i] = (unsigned)(Rb * ld + C) * 2u; }
    const size_t kstep = g.tiled ? (size_t)(BM * BK * 2) : (size_t)(BK * 2);
    const size_t hstep = (size_t)HALF * ld * 2;
    const size_t tstep = g.tiled ? (size_t)nt * (BM * BK * 2) : 2 * hstep;
    const unsigned ldsw = (unsigned)wid * 1024u;
    const int aoff = lds_byte(wr * 64 + fr, fq * 8), boff = lds_byte(wc * 32 + fr, fq * 8);
#define PG8_SA(b, h) (((b) * 2 + (h)) * HTB)
#define PG8_SB(b, h) ((4 + (b) * 2 + (h)) * HTB)
#define PG8_STAGE(bufoff, gbase, voff) do { _Pragma("unroll") for (int _i = 0; _i < 2; ++_i) \
        __builtin_amdgcn_global_load_lds((const unsigned*)((const char*)(gbase) + (voff)[_i]), (PG8_LAS unsigned*)(lds + (bufoff) + ldsw + _i * 8192), 16, 0, 0); } while (0)
#define PG8_LDA(dst, b, h) do { _Pragma("unroll") for (int m = 0; m < 4; ++m) _Pragma("unroll") for (int k = 0; k < 2; ++k) dst[m][k] = *(const PG8_LAS bf16x8*)(lds + PG8_SA(b, h) + aoff + m * 2048 + k * 1024); } while (0)
#define PG8_LDB(dst, b, h) do { _Pragma("unroll") for (int n = 0; n < 2; ++n) _Pragma("unroll") for (int k = 0; k < 2; ++k) dst[n][k] = *(const PG8_LAS bf16x8*)(lds + PG8_SB(b, h) + boff + n * 2048 + k * 1024); } while (0)
#define PG8_MMA(ai, bj, At, Bt) do { __builtin_amdgcn_s_setprio(1); _Pragma("unroll") for (int m = 0; m < 4; ++m) _Pragma("unroll") for (int n = 0; n < 2; ++n) _Pragma("unroll") for (int k = 0; k < 2; ++k) \
        acc[ai][bj][m][n] = __builtin_amdgcn_mfma_f32_16x16x32_bf16(Bt[n][k], At[m][k], acc[ai][bj][m][n], 0, 0, 0); __builtin_amdgcn_s_setprio(0); } while (0)
#define PG8_WAIT_V(n) asm volatile("s_waitcnt vmcnt(" #n ")" ::: "memory")
#define PG8_WAIT_L(n) asm volatile("s_waitcnt lgkmcnt(" #n ")" ::: "memory")
#define PG8_BAR __builtin_amdgcn_s_barrier()
#define PG8_SCHED __builtin_amdgcn_sched_barrier(0)
    Unit cur, nxt; int ui = 0;
#if PROBE_EPT
    if (tid == 0) ((volatile PG8_LAS unsigned long long*)((PG8_LAS unsigned char*)lds_raw + MISC_OFF + 160))[2] = __builtin_amdgcn_s_memrealtime();
#endif
    if (!S.next(0, cur)) return;
    f32x4 acc[2][2][4][2];
#pragma unroll
    for (int a = 0; a < 2; ++a)
#pragma unroll
        for (int b = 0; b < 2; ++b)
#pragma unroll
            for (int m = 0; m < 4; ++m)
#pragma unroll
                for (int n = 0; n < 2; ++n) acc[a][b][m][n] = (f32x4){0.f, 0.f, 0.f, 0.f};
    bf16x8 At[4][2], B0[2][2], B1[2][2];
    const char* cA = (const char*)g.A + (size_t)cur.pm * tstep; const char* cB = (const char*)g.Bt + (size_t)cur.pn * tstep;
    S.a_ready(cur);
    if constexpr (SP2) {
        PG8_STAGE(PG8_SB(0, 0), cB, voffB); PG8_STAGE(PG8_SB(0, 1), cB + hstep, voffB); PG8_STAGE(PG8_SA(0, 0), cA, voffA); PG8_STAGE(PG8_SA(0, 1), cA + hstep, voffA);
        if (wr == 1) PG8_BAR;
        PG8_WAIT_V(2); PG8_BAR;
        PG8_STAGE(PG8_SB(1, 0), cB + kstep, voffB); PG8_STAGE(PG8_SA(1, 0), cA + kstep, voffA); PG8_STAGE(PG8_SB(1, 1), cB + hstep + kstep, voffB);
        PG8_WAIT_V(6); PG8_BAR;
    } else {
        PG8_STAGE(PG8_SB(0, 0), cB, voffB); PG8_STAGE(PG8_SA(0, 0), cA, voffA); PG8_STAGE(PG8_SB(0, 1), cB + hstep, voffB); PG8_STAGE(PG8_SA(0, 1), cA + hstep, voffA);
        if (wr == 1) PG8_BAR;
        PG8_WAIT_V(4); PG8_BAR;
        PG8_STAGE(PG8_SB(1, 0), cB + kstep, voffB); PG8_STAGE(PG8_SA(1, 0), cA + kstep, voffA); PG8_STAGE(PG8_SB(1, 1), cB + hstep + kstep, voffB);
        PG8_WAIT_V(6); PG8_BAR;
    }
    for (;;) {
        const bool has_next = S.next(ui + 1, nxt);
        const char* nA = has_next ? (const char*)g.A + (size_t)nxt.pm * tstep : cA; const char* nB = has_next ? (const char*)g.Bt + (size_t)nxt.pn * tstep : cB;
        for (int t = 0; t < nt; t += 2) {
            const bool last = (t == nt - 2);
            const char* a1 = cA + (size_t)(t + 1) * kstep;
            const char* a2 = last ? nA : cA + (size_t)(t + 2) * kstep; const char* b2 = last ? nB : cB + (size_t)(t + 2) * kstep;
            const char* a3 = a2 + kstep; const char* b3 = b2 + kstep;
            if (last && has_next) S.a_ready(nxt);
            if constexpr (SP2) {
            PG8_LDB(B0, 0, 0); PG8_LDB(B1, 0, 1); PG8_SCHED; PG8_LDA(At, 0, 0); PG8_STAGE(PG8_SA(1, 1), a1 + hstep, voffA);
            PG8_WAIT_V(8); PG8_WAIT_L(0); PG8_BAR; PG8_MMA(0, 0, At, B0); PG8_MMA(0, 1, At, B1); PG8_BAR; PG8_SCHED;
            PG8_LDA(At, 0, 1); PG8_STAGE(PG8_SB(0, 0), b2, voffB); PG8_STAGE(PG8_SB(0, 1), b2 + hstep, voffB); PG8_STAGE(PG8_SA(0, 0), a2, voffA);
            PG8_WAIT_V(8); PG8_WAIT_L(0); PG8_BAR; PG8_MMA(1, 0, At, B0); PG8_MMA(1, 1, At, B1); PG8_BAR; PG8_SCHED;
            PG8_LDB(B0, 1, 0); PG8_LDB(B1, 1, 1); PG8_SCHED; PG8_LDA(At, 1, 0); PG8_STAGE(PG8_SA(0, 1), a2 + hstep, voffA);
            PG8_WAIT_V(8); PG8_WAIT_L(0); PG8_BAR; PG8_MMA(0, 0, At, B0); PG8_MMA(0, 1, At, B1); PG8_BAR; PG8_SCHED;
            PG8_LDA(At, 1, 1); PG8_STAGE(PG8_SB(1, 0), b3, voffB); PG8_STAGE(PG8_SB(1, 1), b3 + hstep, voffB); PG8_STAGE(PG8_SA(1, 0), a3, voffA);
            PG8_WAIT_V(8); PG8_WAIT_L(0); PG8_BAR; PG8_MMA(1, 0, At, B0); PG8_MMA(1, 1, At, B1); PG8_BAR; PG8_SCHED;
            } else {
            PG8_LDB(B0, 0, 0); PG8_SCHED; PG8_LDA(At, 0, 0); PG8_STAGE(PG8_SA(1, 1), a1 + hstep, voffA);
            PG8_WAIT_L(8); PG8_BAR; PG8_WAIT_L(0); PG8_MMA(0, 0, At, B0); PG8_BAR; PG8_SCHED;
            PG8_LDB(B1, 0, 1); PG8_STAGE(PG8_SB(0, 0), b2, voffB);
            PG8_BAR; PG8_WAIT_L(0); PG8_MMA(0, 1, At, B1); PG8_BAR;
            PG8_LDA(At, 0, 1); PG8_STAGE(PG8_SA(0, 0), a2, voffA);
            PG8_BAR; PG8_WAIT_L(0); PG8_MMA(1, 0, At, B0); PG8_BAR; PG8_SCHED;
            PG8_STAGE(PG8_SB(0, 1), b2 + hstep, voffB);
            PG8_WAIT_V(6); PG8_BAR; PG8_MMA(1, 1, At, B1); PG8_BAR;
            PG8_LDB(B0, 1, 0); PG8_SCHED; PG8_LDA(At, 1, 0); PG8_STAGE(PG8_SA(0, 1), a2 + hstep, voffA);
            PG8_WAIT_L(8); PG8_BAR; PG8_WAIT_L(0); PG8_MMA(0, 0, At, B0); PG8_BAR; PG8_SCHED;
            PG8_LDB(B1, 1, 1); PG8_STAGE(PG8_SB(1, 0), b3, voffB);
            PG8_BAR; PG8_WAIT_L(0); PG8_MMA(0, 1, At, B1); PG8_BAR;
            PG8_LDA(At, 1, 1); PG8_STAGE(PG8_SA(1, 0), a3, voffA);
            PG8_BAR; PG8_WAIT_L(0); PG8_MMA(1, 0, At, B0); PG8_BAR; PG8_SCHED;
            PG8_STAGE(PG8_SB(1, 1), b3 + hstep, voffB);
            PG8_WAIT_V(6); PG8_BAR; PG8_MMA(1, 1, At, B1); PG8_BAR;
            }
        }
        if constexpr (ALIGN_EPI) { if (wr == 0) PG8_BAR; }
#if PROBE_EPT
        if (tid == 0) ((volatile PG8_LAS unsigned long long*)((PG8_LAS unsigned char*)lds_raw + MISC_OFF + 160))[0] = __builtin_amdgcn_s_memrealtime();
#endif
        if constexpr (!Epi::AFTER_DRAIN) { E(acc, cur, wr, wc, fr, fq);
#if PROBE_EPT
            asm volatile("s_waitcnt vmcnt(0)" ::: "memory");
            if (tid == 0) ((volatile PG8_LAS unsigned long long*)((PG8_LAS unsigned char*)lds_raw + MISC_OFF + 160))[1] = __builtin_amdgcn_s_memrealtime();
#endif
#if PROBE_EPI2
            if constexpr (Epi::PERM) { asm volatile("" ::: "memory"); E(acc, cur, wr, wc, fr, fq); }
#elif PROBE_EPIR2
            if constexpr (!Epi::PERM) { asm volatile("s_waitcnt vmcnt(0)" ::: "memory"); Epi E2 = E; E2.coef = 0.f; E2(acc, cur, wr, wc, fr, fq); }
#endif
            S.done(cur); }
        if (!has_next) break;
#pragma unroll
        for (int a = 0; a < 2; ++a)
#pragma unroll
            for (int b = 0; b < 2; ++b)
#pragma unroll
                for (int m = 0; m < 4; ++m)
#pragma unroll
                    for (int n = 0; n < 2; ++n) acc[a][b][m][n] = (f32x4){0.f, 0.f, 0.f, 0.f};
        cur = nxt; cA = nA; cB = nB; ++ui;
        if constexpr (ALIGN_EPI) { if (wr == 1) PG8_BAR; }
    }
    PG8_WAIT_V(0);
    if constexpr (!ALIGN_EPI) { if (wr == 0) PG8_BAR; }
    PG8_BAR;
#undef PG8_SA
#undef PG8_SB
#undef PG8_STAGE
#undef PG8_LDA
#undef PG8_LDB
#undef PG8_MMA
#undef PG8_WAIT_V
#undef PG8_WAIT_L
#undef PG8_BAR
#undef PG8_SCHED
}
}

#define XB_TMO      128
#define XB_XCNT(j)  (256  + 64 * (j))
#define XB_XSUB(j)  (1280 + 64 * (j))
#define XB_XGEN(j)  (2304 + 64 * (j))
#define XB_TOP      3328
#define XB_TOPGEN   3392
#define XCD_BAR_WORDS 3456
#define XB_SPIN_CAP (1u << 18)
__device__ __forceinline__ unsigned xb_ld(unsigned* p)              { return __hip_atomic_load(p, __ATOMIC_RELAXED, __HIP_MEMORY_SCOPE_AGENT); }
__device__ __forceinline__ unsigned xb_add(unsigned* p, unsigned v) { return __hip_atomic_fetch_add(p, v, __ATOMIC_RELAXED, __HIP_MEMORY_SCOPE_AGENT); }
__device__ __forceinline__ unsigned xb_xcc_id() { return (unsigned)__builtin_amdgcn_s_getreg((3 << 11) | 20) & 0xFu; }
#define XB_SPIN(cond, bar) do { unsigned _sp = 0; while (cond) { __builtin_amdgcn_s_sleep(1); \
    if ((++_sp & 255u) == 0u) { if (xb_ld(&(bar)[XB_TMO])) break; if (_sp > XB_SPIN_CAP) { atomicAdd(&(bar)[XB_TMO], 1u); break; } } } } while (0)
struct XcdBarrier { unsigned* bar; unsigned x; volatile LAS unsigned* st; };
__device__ __forceinline__ XcdBarrier xcd_barrier_post(unsigned* bar, volatile LAS unsigned* st) {
    XcdBarrier b; b.bar = bar; b.x = xb_xcc_id(); b.st = st;
    if (threadIdx.x == 0) (void)xb_add(&bar[XB_XCNT(b.x)], 1u);
    return b;
}
__device__ __forceinline__ void xcd_barrier_complete(unsigned* bar, unsigned x, unsigned& nloc, unsigned& nx) {
    const unsigned G = gridDim.x * gridDim.y * gridDim.z;
    unsigned sum, cnt, mine, sp = 0u;
    for (;;) {
        sum = 0u; cnt = 0u; mine = 0u;
#pragma unroll
        for (unsigned j = 0; j < 16; ++j) { const unsigned c = xb_ld(&bar[XB_XCNT(j)]); sum += c; cnt += (c > 0u) ? 1u : 0u; mine = (j == x) ? c : mine; }
        if (sum == G) break;
        __builtin_amdgcn_s_sleep(1);
        if ((++sp & 255u) == 0u) { if (xb_ld(&bar[XB_TMO])) break; if (sp > XB_SPIN_CAP) { atomicAdd(&bar[XB_TMO], 1u); break; } }
    }
    nloc = mine > 0u ? mine : 1u; nx = cnt > 0u ? cnt : 1u;
}
__device__ __forceinline__ void xcd_barrier(const XcdBarrier& b) {
    asm volatile("s_waitcnt vmcnt(0)" ::: "memory");
    __syncthreads();
    if (threadIdx.x == 0) {
        unsigned* bar = b.bar; asm volatile("" : "+s"(bar));
        __builtin_amdgcn_s_waitcnt(0);
        unsigned nloc = b.st[0], nx = b.st[1];
        if (nloc == 0u) { xcd_barrier_complete(bar, b.x, nloc, nx); b.st[0] = nloc; b.st[1] = nx; }
        const unsigned old = xb_add(&bar[XB_XSUB(b.x)], 1u);
        const unsigned gen = old / nloc;
        if (old + 1u == (gen + 1u) * nloc) {
            __builtin_amdgcn_fence(__ATOMIC_RELEASE, "agent");
            asm volatile("s_waitcnt vmcnt(0)" ::: "memory");
            const unsigned og = xb_add(&bar[XB_TOP], 1u);
            const unsigned tg = og / nx;
            if (og + 1u == (tg + 1u) * nx) xb_add(&bar[XB_TOPGEN], 1u);
            else XB_SPIN(xb_ld(&bar[XB_TOPGEN]) == tg, bar);
            __builtin_amdgcn_fence(__ATOMIC_ACQUIRE, "agent");
            xb_add(&bar[XB_XGEN(b.x)], 1u);
            asm volatile("s_waitcnt vmcnt(0)" ::: "memory");
        } else {
            XB_SPIN(xb_ld(&bar[XB_XGEN(b.x)]) == gen, bar);
            __builtin_amdgcn_fence(__ATOMIC_ACQUIRE, "agent");
            asm volatile("s_waitcnt vmcnt(0)" ::: "memory");
        }
    }
    __syncthreads();
}

namespace mix {
typedef float f32x16 __attribute__((ext_vector_type(16)));
typedef short s16x4 __attribute__((ext_vector_type(4)));
typedef short v4i16_t __attribute__((ext_vector_type(4)));
typedef LAS const char* lds_cptr;
constexpr int SLOTB = 8192, LDS_K = 0, LDS_V = 2 * SLOTB, LDS_QW = 4 * SLOTB, LDS_QF = 4 * SLOTB + 1024;
constexpr int N_DIFF = 24 * 16, N_RET = 16, N_ITEMS = N_DIFF + N_RET;
__device__ __forceinline__ int crow(int r, int hi) { return (r & 3) + 8 * (r >> 2) + 4 * hi; }
__device__ __forceinline__ int imax(int a, int b) { return a > b ? a : b; }
__device__ __forceinline__ void glds16(const void* g, unsigned lds_base) { unsigned sv; asm volatile("s_mov_b32 %0, m0\n\ts_mov_b32 m0, %2\n\ts_nop 0\n\tglobal_load_lds_dwordx4 %1, off\n\ts_mov_b32 m0, %0" : "=&s"(sv) : "v"(g), "s"(lds_base) : "memory"); }
__device__ __forceinline__ s16x4 vtr(lds_cptr p) { return __builtin_bit_cast(s16x4, __builtin_amdgcn_ds_read_tr16_b64_v4i16((LAS v4i16_t*)p)); }
#define MFMA32(a, b, c) __builtin_amdgcn_mfma_f32_32x32x16_bf16(a, b, c, 0, 0, 0)
#define MFMA16(a, b, c) __builtin_amdgcn_mfma_f32_16x16x32_bf16(a, b, c, 0, 0, 0)

struct ItemTab { unsigned short v[N_ITEMS]; };
constexpr ItemTab make_items() {
    ItemTab t{}; int n = 0;
    for (int bh = 0; bh < 16; ++bh) t.v[n++] = (unsigned short)(0x8000 | bh);
    for (int qb = 15; qb >= 0; --qb) for (int bh = 0; bh < 24; ++bh) t.v[n++] = (unsigned short)((qb << 8) | bh);
    return t;
}
__device__ const ItemTab g_items = make_items();

template <int MODE, int VAR = 0>
__device__ __forceinline__ void attn_unit(int b, int h, int qb, const bf16_t* PROJ, bf16_t* Y, LAS unsigned char* lds, float lam, float lam_init, const float* subg) {
    int tid_ = threadIdx.x; asm volatile("" : "+v"(tid_));
    const int tid = tid_, lane = tid & 63, r32 = lane & 31, hi = lane >> 5; const int wid = __builtin_amdgcn_readfirstlane(tid >> 6);
    constexpr int CQ = MODE == 0 ? C_DQ : C_TQ, CK = MODE == 0 ? C_DK : C_TK, CV = MODE == 0 ? C_DV : C_TV;
    const size_t rowbase = (size_t)b * T; const int q0 = qb * 256, NT = 4 * (qb + 1), my_last = 4 * qb + (wid >> 1);
    const bf16_t* Qw = PROJ + (rowbase + q0 + wid * 32) * NINP + CQ + 64 * h;
    const bf16_t* ksrc = PROJ + (rowbase + lane) * NINP + CK + 64 * h + wid * 8;
    const bf16_t* vsrc = PROJ + (rowbase + 16 * (wid & 3) + (lane >> 2)) * NINP + CV + 64 * h + (wid >> 2) * 32 + (lane & 3) * 8;
    const unsigned lds0 = (unsigned)(uintptr_t)lds;
    const unsigned kdst = lds0 + LDS_K + wid * 1024, vdst = lds0 + LDS_V + wid * 1024;
    const lds_cptr kp0 = (lds_cptr)lds + LDS_K + hi * 1024 + r32 * 16;
    const lds_cptr vp0 = (lds_cptr)lds + LDS_V + ((lane >> 4) & 1) * 32 + (lane & 3) * 8 + (4 * hi + ((lane & 15) >> 2)) * 64;
#define DMA_K(t, slot) glds16(ksrc + (size_t)(t) * 64 * NINP, (unsigned)__builtin_amdgcn_readfirstlane(kdst + (slot)))
#define DMA_V(t, slot) glds16(vsrc + (size_t)(t) * 64 * NINP, (unsigned)__builtin_amdgcn_readfirstlane(vdst + (slot)))
    DMA_K(0, 0); DMA_V(0, 0);
#pragma unroll
    for (int p = 0; p < 4; ++p) glds16(Qw + (size_t)(lane & 31) * NINP + (2 * p + (lane >> 5)) * 8, (unsigned)__builtin_amdgcn_readfirstlane(lds0 + LDS_QF + wid * 4096 + p * 1024));
    const lds_cptr qp0 = (lds_cptr)lds + LDS_QF + wid * 4096 + hi * 512 + r32 * 16;
    f32x16 oA[2], oB[2];
    oA[0] = f32x16{}; oA[1] = f32x16{}; oB[0] = f32x16{}; oB[1] = f32x16{};
    float mref = 0.f, lA = 0.f, lB = 0.f; f32x16 nm = f32x16{};
    const int qabs = q0 + wid * 32 + r32;
    const float lg2 = lg2gamma(h);
    bf16x8 qr[4];
    for (int t = 0; t < NT; ++t) {
        if constexpr ((VAR & 18) == 0) asm volatile("s_waitcnt vmcnt(0) lgkmcnt(0)\n\ts_barrier" ::: "memory");
        else if constexpr ((VAR & 18) == 2) asm volatile("s_waitcnt vmcnt(0) lgkmcnt(0)" ::: "memory");
        else if constexpr ((VAR & 18) == 16) asm volatile("s_waitcnt lgkmcnt(0)\n\ts_barrier" ::: "memory");
        else asm volatile("s_waitcnt lgkmcnt(0)" ::: "memory");
        const int sl = (t & 1) * SLOTB;
        if (t + 1 < NT) { DMA_K(t + 1, SLOTB - sl); DMA_V(t + 1, SLOTB - sl); }
        if (t <= my_last) {
            bf16x8 kf[8], vf[8];
            if (t == 0) {
#pragma unroll
                for (int d0 = 0; d0 < 4; ++d0) qr[d0] = *(const LAS bf16x8*)(qp0 + d0 * 1024); }
#pragma unroll
            for (int d0 = 0; d0 < 4; ++d0) { kf[2 * d0] = *(const LAS bf16x8*)(kp0 + sl + d0 * 2048); kf[2 * d0 + 1] = *(const LAS bf16x8*)(kp0 + sl + d0 * 2048 + 512); }
#define LOAD_VF() do { _Pragma("unroll") for (int i = 0; i < 8; ++i) { const s16x4 lo = vtr(vp0 + sl + (i >> 2) * 4096 + (i & 3) * 1024), hh = vtr(vp0 + sl + (i >> 2) * 4096 + (i & 3) * 1024 + 512); \
                vf[i] = (bf16x8){lo[0], lo[1], lo[2], lo[3], hh[0], hh[1], hh[2], hh[3]}; } } while (0)
            const bool diag = (t == my_last);
            const int kv0 = 64 * t + 4 * hi;
            const f32x16 z16 = f32x16{};
            if constexpr (MODE == 0) {
                f32x16 paA, pbA, paB, pbB;
                if constexpr (VAR & 8) { paA = nm; pbA = nm; paB = nm; pbB = nm; asm volatile("" :: "v"(kf[0]), "v"(kf[1]), "v"(kf[2]), "v"(kf[3]), "v"(kf[4]), "v"(kf[5]), "v"(kf[6]), "v"(kf[7]), "v"(qr[0]), "v"(qr[1]), "v"(qr[2]), "v"(qr[3])); }
                else {
                paA = MFMA32(kf[0], qr[0], nm); paA = MFMA32(kf[2], qr[1], paA);
                pbA = MFMA32(kf[1], qr[0], nm); pbA = MFMA32(kf[3], qr[1], pbA);
                paB = MFMA32(kf[4], qr[2], nm); paB = MFMA32(kf[6], qr[3], paB);
                pbB = MFMA32(kf[5], qr[2], nm); pbB = MFMA32(kf[7], qr[3], pbB); }
                if ((t & 7) == 0) {
                int ti = imax(imax(__float_as_int(paA[0]), __float_as_int(pbA[0])), imax(__float_as_int(paB[0]), __float_as_int(pbB[0])));
#pragma unroll
                for (int r = 1; r < 16; ++r) ti = imax(imax(ti, imax(__float_as_int(paA[r]), __float_as_int(pbA[r]))), imax(__float_as_int(paB[r]), __float_as_int(pbB[r])));
                ti = imax_x32(ti);
                if (t == 0 || __any(ti > 0x41000000)) {
                    const float tmf = __int_as_float(ti); const float dl = (t == 0) ? tmf : fmaxf(tmf, 0.f); mref += dl;
#pragma unroll
                    for (int r = 0; r < 16; ++r) { paA[r] -= dl; pbA[r] -= dl; paB[r] -= dl; pbB[r] -= dl; nm[r] = -mref; }
                    if (t > 0) { const float f = __builtin_amdgcn_exp2f(-dl); lA *= f; lB *= f; oA[0] = oA[0] * f; oA[1] = oA[1] * f; oB[0] = oB[0] * f; oB[1] = oB[1] * f; } }
                }
                if (diag) {
#pragma unroll
                    for (int r = 0; r < 16; ++r) { const int kv = kv0 + (r & 3) + 8 * (r >> 2); if (kv > qabs) { paA[r] = -1e30f; paB[r] = -1e30f; } if (kv + 32 > qabs) { pbA[r] = -1e30f; pbB[r] = -1e30f; } } }
#define EXP_PACK(pa, pb, L_, pf) do { \
                float rs0 = 0.f, rs1 = 0.f; \
                  \
                if constexpr (!(VAR & 1)) { _Pragma("unroll") for (int r = 0; r < 16; ++r) { pa[r] = __builtin_amdgcn_exp2f(pa[r]); pb[r] = __builtin_amdgcn_exp2f(pb[r]); rs0 += pa[r]; asm("" : "+v"(rs0)); rs1 += pb[r]; asm("" : "+v"(rs1)); } } \
                L_ += rs0 + rs1; \
                PROBE_EXTRA_EXP(pa, pb); \
                _Pragma("unroll") for (int s = 0; s < 2; ++s) { \
                    u32x4 w0, w1; \
                    w0.x = pk2(pa[8 * s + 0], pa[8 * s + 1]); w0.y = pk2(pa[8 * s + 2], pa[8 * s + 3]); w0.z = pk2(pa[8 * s + 4], pa[8 * s + 5]); w0.w = pk2(pa[8 * s + 6], pa[8 * s + 7]); \
                    w1.x = pk2(pb[8 * s + 0], pb[8 * s + 1]); w1.y = pk2(pb[8 * s + 2], pb[8 * s + 3]); w1.z = pk2(pb[8 * s + 4], pb[8 * s + 5]); w1.w = pk2(pb[8 * s + 6], pb[8 * s + 7]); \
                    pf[s] = __builtin_bit_cast(bf16x8, w0); pf[2 + s] = __builtin_bit_cast(bf16x8, w1); } } while (0)
#define PV_ACC(O, pf) do { if constexpr (VAR & 4) { asm volatile("" :: "v"(pf[0]), "v"(pf[1]), "v"(pf[2]), "v"(pf[3]), "v"(vf[0]), "v"(vf[1]), "v"(vf[2]), "v"(vf[3]), "v"(vf[4]), "v"(vf[5]), "v"(vf[6]), "v"(vf[7])); } else { _Pragma("unroll") for (int dh = 0; dh < 2; ++dh) _Pragma("unroll") for (int s = 0; s < 4; ++s) O[dh] = MFMA32(vf[4 * dh + s], pf[s], O[dh]); } } while (0)
                __builtin_amdgcn_sched_barrier(0);
                LOAD_VF();
                bf16x8 pfA[4], pfB[4];
                EXP_PACK(paA, pbA, lA, pfA);
                __builtin_amdgcn_sched_barrier(0);
                PV_ACC(oA, pfA);
                EXP_PACK(paB, pbB, lB, pfB);
#pragma unroll
                for (int i = 0; i < 8; ++i) { __builtin_amdgcn_sched_group_barrier(0x008, 1, 0); __builtin_amdgcn_sched_group_barrier(0x402, 10, 0); }
                __builtin_amdgcn_sched_barrier(0);
                PV_ACC(oB, pfB);
#undef EXP_PACK
#undef PV_ACC
            } else {
                f32x16 pa = MFMA32(kf[0], qr[0], z16), pb = MFMA32(kf[1], qr[0], z16);
#pragma unroll
                for (int d0 = 1; d0 < 4; ++d0) { pa = MFMA32(kf[2 * d0], qr[d0], pa); pb = MFMA32(kf[2 * d0 + 1], qr[d0], pb); }
                const int qt = (q0 + wid * 32) >> 6;
                const float tf = __builtin_amdgcn_exp2f(64.0f * (float)(qt - t) * lg2);
#pragma unroll
                for (int r = 0; r < 16; ++r) { pa[r] *= tf; pb[r] *= tf; }
                if (diag) {
#pragma unroll
                    for (int r = 0; r < 16; ++r) { const int kv = kv0 + (r & 3) + 8 * (r >> 2); if (kv > qabs) pa[r] = 0.f; if (kv + 32 > qabs) pb[r] = 0.f; } }
                LOAD_VF();
                bf16x8 pf[4];
#pragma unroll
                for (int s = 0; s < 2; ++s) {
                    u32x4 w0, w1;
                    w0.x = pk2(pa[8 * s + 0], pa[8 * s + 1]); w0.y = pk2(pa[8 * s + 2], pa[8 * s + 3]); w0.z = pk2(pa[8 * s + 4], pa[8 * s + 5]); w0.w = pk2(pa[8 * s + 6], pa[8 * s + 7]);
                    w1.x = pk2(pb[8 * s + 0], pb[8 * s + 1]); w1.y = pk2(pb[8 * s + 2], pb[8 * s + 3]); w1.z = pk2(pb[8 * s + 4], pb[8 * s + 5]); w1.w = pk2(pb[8 * s + 6], pb[8 * s + 7]);
                    pf[s] = __builtin_bit_cast(bf16x8, w0); pf[2 + s] = __builtin_bit_cast(bf16x8, w1); }
#pragma unroll
                for (int dh = 0; dh < 2; ++dh)
#pragma unroll
                    for (int s = 0; s < 4; ++s) oA[dh] = MFMA32(vf[4 * dh + s], pf[s], oA[dh]);
            }
        }
    }
#undef DMA_K
#undef DMA_V
#undef LOAD_VF
    const size_t mrow = rowbase + qabs;
    if constexpr (MODE == 0) {
        lA = sum_x32(lA); lB = sum_x32(lB);
        const float rA = 1.0f / lA, rB = lam / lB;
        float ss = 0.f;
#pragma unroll
        for (int dh = 0; dh < 2; ++dh)
#pragma unroll
            for (int r = 0; r < 16; ++r) { const float v = oA[dh][r] * rA - oB[dh][r] * rB; oA[dh][r] = v; ss += v * v; }
        ss = sum_x32(ss);
        float li_ = lam_init; asm volatile("" : "+v"(li_));
        const float rn = (1.0f / sqrtf(ss * (1.f / 64.f) + EPS)) * (1.0f - li_);
#pragma unroll
        for (int dh = 0; dh < 2; ++dh)
#pragma unroll
            for (int g = 0; g < 4; ++g) { const int d = 32 * dh + 8 * g + 4 * hi; const f32x4 sg = *(const f32x4*)(subg + d);
                u32x2 w; w.x = pk2(oA[dh][4 * g] * rn * sg[0], oA[dh][4 * g + 1] * rn * sg[1]); w.y = pk2(oA[dh][4 * g + 2] * rn * sg[2], oA[dh][4 * g + 3] * rn * sg[3]);
                *(u32x2*)(Y + mrow * D + RW + 64 * h + d) = w; }
    } else {
        float ss = 0.f;
#pragma unroll
        for (int dh = 0; dh < 2; ++dh)
#pragma unroll
            for (int r = 0; r < 16; ++r) ss += oA[dh][r] * oA[dh][r];
        ss = sum_x32(ss);
        const float rn = 1.0f / sqrtf(ss * (1.f / 64.f) + EPS);
#pragma unroll
        for (int dh = 0; dh < 2; ++dh)
#pragma unroll
            for (int g = 0; g < 4; ++g) { const int d = 32 * dh + 8 * g + 4 * hi; const u32x2 tg = *(const u32x2*)(PROJ + mrow * NINP + C_TG + 64 * h + d);
                u32x2 w; w.x = pk2(siluf_(bflo(tg.x)) * oA[dh][4 * g] * rn, siluf_(bfhi(tg.x)) * oA[dh][4 * g + 1] * rn); w.y = pk2(siluf_(bflo(tg.y)) * oA[dh][4 * g + 2] * rn, siluf_(bfhi(tg.y)) * oA[dh][4 * g + 3] * rn);
                *(u32x2*)(Y + mrow * D + 768 + 64 * h + d) = w; }
    }
}

namespace rseq { constexpr int SLOT = 40960, KB_ = 0, KT_ = 8192, VT_ = 16384, QB_ = 24576, TG_ = 32768, RS_ = 139264, RSB = 8192; }
__device__ __forceinline__ void ret_seq(int b, int h, const bf16_t* PROJ, bf16_t* Y, LAS unsigned char* lds) {
    using namespace rseq;
    int tid_ = threadIdx.x; asm volatile("" : "+v"(tid_));
    const int tid = tid_, lane = tid & 63, r32 = lane & 31, hi = lane >> 5; const int wid = __builtin_amdgcn_readfirstlane(tid >> 6);
    const size_t rowbase = (size_t)b * T;
    const unsigned lds0 = (unsigned)(uintptr_t)lds;
    const bf16_t* kb_src = PROJ + (rowbase + lane) * NINP + C_TK + 64 * h + wid * 8;
    const bf16_t* qb_src = PROJ + (rowbase + lane) * NINP + C_TQ + 64 * h + wid * 8;
    const size_t tr_off = (size_t)(16 * (wid & 3) + (lane >> 2)) * NINP + (wid >> 2) * 32 + (lane & 3) * 8;
    const bf16_t* kt_src = PROJ + rowbase * NINP + C_TK + 64 * h + tr_off;
    const bf16_t* vt_src = PROJ + rowbase * NINP + C_TV + 64 * h + tr_off;
    const bf16_t* tg_src = PROJ + (rowbase + 8 * wid + (lane >> 3)) * NINP + C_TG + 64 * h + (lane & 7) * 8;
#define RS_DMA(blk, slot_) do { const size_t go_ = (size_t)(blk) * 64 * NINP; const unsigned d_ = lds0 + (slot_) * SLOT + wid * 1024; \
        glds16(kb_src + go_, (unsigned)__builtin_amdgcn_readfirstlane(d_ + KB_)); glds16(kt_src + go_, (unsigned)__builtin_amdgcn_readfirstlane(d_ + KT_)); \
        glds16(vt_src + go_, (unsigned)__builtin_amdgcn_readfirstlane(d_ + VT_)); glds16(qb_src + go_, (unsigned)__builtin_amdgcn_readfirstlane(d_ + QB_)); \
        glds16(tg_src + go_, (unsigned)__builtin_amdgcn_readfirstlane(d_ + TG_)); } while (0)
    RS_DMA(0, 0); RS_DMA(1, 1);
    { unsigned z = 0u; asm volatile("" : "+v"(z)); for (int i = tid; i < RSB / 16; i += 512) ((LAS u32x4*)(lds + RS_))[i] = (u32x4){z, z, z, z}; }
    const int qh = wid & 1;
    const int dvh = (wid >> 1) & 1, dkh = wid & 1;
    f32x16 Rq = f32x16{};
    const float g64 = __builtin_amdgcn_exp2f(64.0f * lg2gamma(h));
    const lds_cptr trb = (lds_cptr)lds + ((lane >> 4) & 1) * 32 + (lane & 3) * 8 + (4 * hi + ((lane & 15) >> 2)) * 64;
    for (int i = 0; i < T / 64; ++i) {
        if (i + 1 < T / 64) { if (wid < 2 && i > 0) asm volatile("s_waitcnt vmcnt(13) lgkmcnt(0)\n\ts_barrier" ::: "memory"); else asm volatile("s_waitcnt vmcnt(5) lgkmcnt(0)\n\ts_barrier" ::: "memory"); }
        else asm volatile("s_waitcnt vmcnt(0) lgkmcnt(0)\n\ts_barrier" ::: "memory");
        const int sl = (i % 3) * SLOT, rb = (i & 1) * RSB;
        if (i + 2 < T / 64) RS_DMA(i + 2, (i + 2) % 3);
        if (wid < 2) {
            bf16x8 kf[8], qr[4];
#pragma unroll
            for (int d0 = 0; d0 < 4; ++d0) { qr[d0] = *(const LAS bf16x8*)((lds_cptr)lds + sl + QB_ + (2 * d0 + hi) * 1024 + (32 * qh + r32) * 16);
                kf[2 * d0] = *(const LAS bf16x8*)((lds_cptr)lds + sl + KB_ + (2 * d0 + hi) * 1024 + r32 * 16); kf[2 * d0 + 1] = *(const LAS bf16x8*)((lds_cptr)lds + sl + KB_ + (2 * d0 + hi) * 1024 + 512 + r32 * 16); }
            const f32x16 z16 = f32x16{};
            f32x16 pa = MFMA32(kf[0], qr[0], z16), pb = z16;
#pragma unroll
            for (int d0 = 1; d0 < 4; ++d0) pa = MFMA32(kf[2 * d0], qr[d0], pa);
            if (qh) {
#pragma unroll
                for (int d0 = 0; d0 < 4; ++d0) pb = MFMA32(kf[2 * d0 + 1], qr[d0], pb); }
#pragma unroll
            for (int r = 0; r < 16; ++r) { const int kv = (r & 3) + 8 * (r >> 2) + 4 * hi;
                if (qh == 0) { if (kv > r32) pa[r] = 0.f; }
                else { if (kv > r32) pb[r] = 0.f; } }
            bf16x8 pf[4];
#pragma unroll
            for (int s = 0; s < 2; ++s) { u32x4 w0, w1;
                w0.x = pk2(pa[8 * s + 0], pa[8 * s + 1]); w0.y = pk2(pa[8 * s + 2], pa[8 * s + 3]); w0.z = pk2(pa[8 * s + 4], pa[8 * s + 5]); w0.w = pk2(pa[8 * s + 6], pa[8 * s + 7]);
                w1.x = pk2(pb[8 * s + 0], pb[8 * s + 1]); w1.y = pk2(pb[8 * s + 2], pb[8 * s + 3]); w1.z = pk2(pb[8 * s + 4], pb[8 * s + 5]); w1.w = pk2(pb[8 * s + 6], pb[8 * s + 7]);
                pf[s] = __builtin_bit_cast(bf16x8, w0); pf[2 + s] = __builtin_bit_cast(bf16x8, w1); }
            f32x16 o[2]; o[0] = z16; o[1] = z16;
#pragma unroll
            for (int dh = 0; dh < 2; ++dh)
#pragma unroll
                for (int s = 0; s < 4; ++s) {
                    if (s < 2 || qh) { const s16x4 lo = vtr(trb + sl + VT_ + dh * 4096 + s * 1024), hh = vtr(trb + sl + VT_ + dh * 4096 + s * 1024 + 512);
                        o[dh] = MFMA32(((bf16x8){lo[0], lo[1], lo[2], lo[3], hh[0], hh[1], hh[2], hh[3]}), pf[s], o[dh]); }
                    const bf16x8 rf = *(const LAS bf16x8*)((lds_cptr)lds + RS_ + rb + (2 * s + hi) * 1024 + (32 * dh + r32) * 16);
                    o[dh] = MFMA32(rf, qr[s], o[dh]); }
            const size_t mrow = rowbase + (size_t)i * 64 + 32 * qh + r32;
            float ss = 0.f;
#pragma unroll
            for (int dh = 0; dh < 2; ++dh)
#pragma unroll
                for (int r = 0; r < 16; ++r) ss += o[dh][r] * o[dh][r];
            ss = sum_x32(ss);
            const float rn = 1.0f / sqrtf(ss * (1.f / 64.f) + EPS);
#pragma unroll
            for (int dh = 0; dh < 2; ++dh)
#pragma unroll
                for (int g = 0; g < 4; ++g) { const int d = 32 * dh + 8 * g + 4 * hi; const u32x2 tg = *(const LAS u32x2*)((lds_cptr)lds + sl + TG_ + (32 * qh + r32) * 128 + d * 2);
                    u32x2 w; w.x = pk2(siluf_(bflo(tg.x)) * o[dh][4 * g] * rn, siluf_(bfhi(tg.x)) * o[dh][4 * g + 1] * rn); w.y = pk2(siluf_(bflo(tg.y)) * o[dh][4 * g + 2] * rn, siluf_(bfhi(tg.y)) * o[dh][4 * g + 3] * rn);
                    *(u32x2*)(Y + mrow * D + 768 + 64 * h + d) = w; }
        } else if (wid >= 4) {
#pragma unroll
            for (int s = 0; s < 4; ++s) {
                const s16x4 vl = vtr(trb + sl + VT_ + dvh * 4096 + s * 1024), vh = vtr(trb + sl + VT_ + dvh * 4096 + s * 1024 + 512);
                const s16x4 kl = vtr(trb + sl + KT_ + dkh * 4096 + s * 1024), kh = vtr(trb + sl + KT_ + dkh * 4096 + s * 1024 + 512);
                Rq = MFMA32(((bf16x8){vl[0], vl[1], vl[2], vl[3], vh[0], vh[1], vh[2], vh[3]}), ((bf16x8){kl[0], kl[1], kl[2], kl[3], kh[0], kh[1], kh[2], kh[3]}), Rq); }
            Rq = Rq * g64;
            LAS bf16_t* rs = (LAS bf16_t*)(lds + RS_ + (RSB - rb));
            const int dk = 32 * dkh + r32;
#pragma unroll
            for (int r = 0; r < 16; ++r) { const int dv = 32 * dvh + (r & 3) + 8 * (r >> 2) + 4 * hi; rs[(dk >> 3) * 512 + dv * 8 + (dk & 7)] = (bf16_t)(pk2(Rq[r], 0.f) & 0xffffu); }
        }
    }
    asm volatile("s_waitcnt lgkmcnt(0)\n\ts_barrier" ::: "memory");
#undef RS_DMA
}

__device__ __forceinline__ float em1(float x) {
    if (x > -0.25f) { float p = 1.f / 720.f; p = p * x + 1.f / 120.f; p = p * x + 1.f / 24.f; p = p * x + 1.f / 6.f; p = p * x + 0.5f; p = p * x + 1.f; return p * x; }
    return expm1f(x);
}
template <int DD> __device__ __forceinline__ float dpp_shr(float v) { return __int_as_float(__builtin_amdgcn_update_dpp(__float_as_int(v), __float_as_int(v), 0x110 + DD, 0xF, 0xF, false)); }
template <int DD> __device__ __forceinline__ f32x4 shup4(f32x4 v) { f32x4 r; r[0] = dpp_shr<DD>(v[0]); r[1] = dpp_shr<DD>(v[1]); r[2] = dpp_shr<DD>(v[2]); r[3] = dpp_shr<DD>(v[3]); return r; }
__device__ __forceinline__ float bc15f(float v) { return __int_as_float(__builtin_amdgcn_ds_swizzle(__float_as_int(v), (0x0F << 5) | 0x10)); }
__device__ __forceinline__ f32x4 bc15(f32x4 v) { f32x4 r; r[0] = bc15f(v[0]); r[1] = bc15f(v[1]); r[2] = bc15f(v[2]); r[3] = bc15f(v[3]); return r; }
template <int PASS>
__device__ __forceinline__ void rglru_item(int wi, const bf16_t* PROJ, const bf16_t* GWl, const float* SP8l, const float* cw, const float* cb, const float* ba, const float* bx, float* AGGA, float* AGGB, bf16_t* Y, int lane_in) {
    int lane = lane_in; asm volatile("" : "+v"(lane));
    const int fr = lane & 15, fq = lane >> 4;
    const int h = wi % 6, chunk = (wi / 6) & 63, b = wi / 384;
    const long m0 = (long)b * T + chunk * 64;
    const int chb = 64 * h + 4 * fq;
    bf16x8 wf[2][4][2];
#pragma unroll
    for (int g = 0; g < 2; ++g)
#pragma unroll
        for (int nbo = 0; nbo < 4; ++nbo)
#pragma unroll
            for (int ks = 0; ks < 2; ++ks) { const bf16_t* p = GWl + (((size_t)g * 6 + h) * 64 + 16 * nbo + fr) * 64 + 32 * ks + 4 * fq; const u32x2 lo = *(const u32x2*)p, hi2 = *(const u32x2*)(p + 16);
                wf[g][nbo][ks] = __builtin_bit_cast(bf16x8, (u32x4){lo.x, lo.y, hi2.x, hi2.y}); }
    f32x4 bav[4], bxv[4], spv[4], hc[4], At[4];
#pragma unroll
    for (int nb = 0; nb < 4; ++nb) { bav[nb] = *(const f32x4*)(ba + chb + 16 * nb); bxv[nb] = *(const f32x4*)(bx + chb + 16 * nb); spv[nb] = *(const f32x4*)(SP8l + chb + 16 * nb);
        hc[nb] = (f32x4){0.f, 0.f, 0.f, 0.f}; At[nb] = (f32x4){1.f, 1.f, 1.f, 1.f}; }
#define KS_STEP(DD, A_, B_) do { const f32x4 As = shup4<DD>(A_), Bs = shup4<DD>(B_); if (fr >= DD) { B_ = A_ * Bs + B_; A_ = A_ * As; } } while (0)
    if constexpr (PASS == 2) {
        f32x4 FA[4], FB[4];
#pragma unroll
        for (int nb = 0; nb < 4; ++nb) { FA[nb] = (f32x4){1.f, 1.f, 1.f, 1.f}; FB[nb] = (f32x4){0.f, 0.f, 0.f, 0.f}; }
#pragma unroll
        for (int k = 0; k < 4; ++k) { const int ci = 4 * fr + k;
            if (ci < chunk) {
#pragma unroll
                for (int nb = 0; nb < 4; ++nb) { const size_t o = ((size_t)(b * 64 + ci)) * RW + chb + 16 * nb; const f32x4 a = *(const f32x4*)(AGGA + o), bb = *(const f32x4*)(AGGB + o);
                    FB[nb] = a * FB[nb] + bb; FA[nb] = a * FA[nb]; } } }
#pragma unroll
        for (int nb = 0; nb < 4; ++nb) { KS_STEP(1, FA[nb], FB[nb]); KS_STEP(2, FA[nb], FB[nb]); KS_STEP(4, FA[nb], FB[nb]); KS_STEP(8, FA[nb], FB[nb]); }
#pragma unroll
        for (int nb = 0; nb < 4; ++nb) hc[nb] = bc15(FB[nb]);
    }
#pragma unroll 1
    for (int mb = 0; mb < 4; ++mb) {
        const int tl = 16 * mb + fr;
        f32x4 xc[4];
#pragma unroll
        for (int nb = 0; nb < 4; ++nb) { f32x4 acc = *(const f32x4*)(cb + chb + 16 * nb);
#pragma unroll
            for (int j = 0; j < 4; ++j) { const int tj = tl - 3 + j;
                if (chunk > 0 || tj >= 0) { const u32x2 w = *(const u32x2*)(PROJ + (size_t)(m0 + tj) * NINP + C_RX + chb + 16 * nb); const f32x4 cwv = *(const f32x4*)(cw + j * RW + chb + 16 * nb);
                    acc += cwv * (f32x4){bflo(w.x), bfhi(w.x), bflo(w.y), bfhi(w.y)}; } }
            xc[nb] = acc; }
        bf16x8 bfr[2];
#pragma unroll
        for (int ks = 0; ks < 2; ++ks) { u32x4 w; w.x = pk2(xc[2 * ks][0], xc[2 * ks][1]); w.y = pk2(xc[2 * ks][2], xc[2 * ks][3]); w.z = pk2(xc[2 * ks + 1][0], xc[2 * ks + 1][1]); w.w = pk2(xc[2 * ks + 1][2], xc[2 * ks + 1][3]);
            bfr[ks] = __builtin_bit_cast(bf16x8, w); }
#pragma unroll
        for (int nb = 0; nb < 4; ++nb) {
            f32x4 ra = bav[nb], ia = bxv[nb];
#pragma unroll
            for (int ks = 0; ks < 2; ++ks) { ra = MFMA16(wf[0][nb][ks], bfr[ks], ra); ia = MFMA16(wf[1][nb][ks], bfr[ks], ia); }
            f32x4 A, B;
#pragma unroll
            for (int r = 0; r < 4; ++r) { const float rg = sigmoidf_(ra[r]), ig = sigmoidf_(ia[r]); const float la = spv[nb][r] * rg;
                A[r] = 1.0f + em1(la); B[r] = sqrtf(-em1(2.0f * la)) * ig * xc[nb][r]; }
            KS_STEP(1, A, B); KS_STEP(2, A, B); KS_STEP(4, A, B); KS_STEP(8, A, B);
            const f32x4 hv = B + A * hc[nb];
            hc[nb] = bc15(hv);
            if constexpr (PASS == 1) { At[nb] = At[nb] * bc15(A); }
            else { const size_t mr = (size_t)(m0 + tl); const u32x2 gw = *(const u32x2*)(PROJ + mr * NINP + C_RG + chb + 16 * nb);
                u32x2 w; w.x = pk2(gelu_tanh(bflo(gw.x)) * hv[0], gelu_tanh(bfhi(gw.x)) * hv[1]); w.y = pk2(gelu_tanh(bflo(gw.y)) * hv[2], gelu_tanh(bfhi(gw.y)) * hv[3]);
                *(u32x2*)(Y + mr * D + chb + 16 * nb) = w; }
        }
    }
    if constexpr (PASS == 1) {
        if (fr == 15) {
#pragma unroll
            for (int nb = 0; nb < 4; ++nb) { const size_t o = ((size_t)(b * 64 + chunk)) * RW + chb + 16 * nb; *(f32x4*)(AGGA + o) = At[nb]; *(f32x4*)(AGGB + o) = hc[nb]; } }
    }
}
#undef KS_STEP
#undef MFMA32
#undef MFMA16
}

constexpr int NWAVES = 8;
struct Args { const float* in[27]; const int* pos; float* out; unsigned char* ws; float lam_init[4]; int ph_lo, ph_hi, li, pad; };
constexpr int PH_L0 = 3, NPH = 8, PH_FINAL = PH_L0 + NL * NPH, PH_END = PH_FINAL + 1;

struct Frame { LAS unsigned char* lds; int wave, vcu, G, gw, NGW; };

template <class Map>
__device__ __forceinline__ void transpose_item(const float* W, int K, int Nsrc, bf16_t* WT, int NT, LAS float* scr, int item, int lane, Map src, bool tiled = false) {
    const int nblk = NT / 32, kb = item / nblk, nb = item % nblk, k0 = 64 * kb, n0 = 32 * nb;
    const int sc = src(n0 + (lane & 31));
    float wv_[32];
#pragma unroll
    for (int i = 0; i < 32; ++i) { const int kk = 2 * i + (lane >> 5); wv_[i] = sc >= 0 ? __builtin_nontemporal_load(W + (size_t)(k0 + kk) * Nsrc + sc) : 0.f; }
#pragma unroll
    for (int i = 0; i < 32; ++i) { const int kk = 2 * i + (lane >> 5); scr[kk * 33 + (lane & 31)] = wv_[i]; }
    LDS_WAIT(); asm volatile("" ::: "memory");
    const int c = lane & 7;
#pragma unroll
    for (int j = 0; j < 4; ++j) { const int n = (lane >> 3) + 8 * j; const LAS float* s = scr + (8 * c) * 33 + n;
        u32x4 o; o.x = pk2(s[0 * 33], s[1 * 33]); o.y = pk2(s[2 * 33], s[3 * 33]); o.z = pk2(s[4 * 33], s[5 * 33]); o.w = pk2(s[6 * 33], s[7 * 33]);
        const size_t off = tiled ? (((size_t)((n0 + n) >> 8) * (K / 64) + kb) * 256 + ((n0 + n) & 255)) * 64 + 8 * c : (size_t)(n0 + n) * K + k0 + 8 * c;
        __builtin_nontemporal_store(o, (GAS u32x4*)(WT + off)); }
    LDS_WAIT(); asm volatile("" ::: "memory");
}
struct MapId { __device__ __forceinline__ int operator()(int n) const { return n; } };
struct MapFfnIn { __device__ __forceinline__ int operator()(int n) const { const int pn = n >> 8, bj = (n >> 7) & 1, cc = n & 127; return bj * F + pn * 128 + cc; } };
__device__ __forceinline__ int ret_dim(int pos) { const int w = pos >> 5, rem = pos & 31, fq = rem >> 3, n = (rem >> 2) & 1, j = rem & 3; return 32 * n + 16 * w + 4 * fq + j; }
struct MapMixIn { __device__ __forceinline__ int operator()(int p) const {
    if (p < C_DK) return 768 + p;
    if (p < C_TQ) return 1152 + (p - C_DK);
    if (p < C_TK) { const int q = p - C_TQ; return 1920 + (q & ~63) + ret_dim(q & 63); }
    if (p < C_DV) { const int q = p - C_TK; return 2176 + (q & ~63) + ret_dim(q & 63); }
    if (p < C_TV) return 1536 + (p - C_DV);
    if (p < C_TG) return 2432 + (p - C_TV);
    if (p < C_RX) return 2688 + (p - C_TG);
    if (p < C_RG) return p - C_RX;
    if (p < NIN) return 384 + (p - C_RG);
    return -1; } };

constexpr int I_FI = (D / 64) * (2 * F / 32), I_FO = (F / 64) * (D / 32), I_MI = (D / 64) * (NINP / 32), I_MO = (D / 64) * (D / 32), CONV_ITEMS_L = 2 * I_FI + 2 * I_FO + I_MI + I_MO;
constexpr int CONV_WG_ITEMS = (CONV_ITEMS_L + NWAVES - 1) / NWAVES;
struct ConvSrc { const float *f1i, *f1o, *f2i, *f2o, *mi, *mo; };
__device__ __forceinline__ void conv_item(const ConvSrc cs, unsigned char* ws, int l, int r, LAS float* scr, int lane) {
    unsigned char* wl = ws + WS_W + (size_t)l * W_L;
    if (r < I_FI) { transpose_item(cs.f1i + (size_t)l * D * 2 * F, D, 2 * F, (bf16_t*)(wl + W_1IN), 2 * F, scr, r, lane, MapFfnIn()); return; } r -= I_FI;
    if (r < I_FI) { transpose_item(cs.f2i + (size_t)l * D * 2 * F, D, 2 * F, (bf16_t*)(wl + W_2IN), 2 * F, scr, r, lane, MapFfnIn()); return; } r -= I_FI;
    if (r < I_FO) { transpose_item(cs.f1o + (size_t)l * F * D, F, D, (bf16_t*)(wl + W_1OUT), D, scr, r, lane, MapId(), true); return; } r -= I_FO;
    if (r < I_FO) { transpose_item(cs.f2o + (size_t)l * F * D, F, D, (bf16_t*)(wl + W_2OUT), D, scr, r, lane, MapId(), true); return; } r -= I_FO;
    if (r < I_MI) { transpose_item(cs.mi + (size_t)l * D * NIN, D, NIN, (bf16_t*)(wl + W_IN), NINP, scr, r, lane, MapMixIn()); return; } r -= I_MI;
    transpose_item(cs.mo + (size_t)l * D * D, D, D, (bf16_t*)(wl + W_OUT), D, scr, r, lane, MapId());
}
__device__ __forceinline__ void bias_layer(unsigned char* ws, int l, int gw, int ngw, int lane) {
    const float* MOD = (const float*)(ws + WS_MOD); float* BIAS = (float*)(ws + WS_BIAS);
    for (int g = 0; g < 3; ++g) {
        const int lg = l * 3 + g; const int Nw = (g == 1) ? NINP : 2 * F;
        const bf16_t* Wt = (const bf16_t*)(ws + WS_W + (size_t)l * W_L + (g == 0 ? W_1IN : g == 1 ? W_IN : W_2IN));
        f32x4 Sv[4][4];
#pragma unroll
        for (int b = 0; b < 4; ++b)
#pragma unroll
            for (int q = 0; q < 4; ++q) Sv[b][q] = *(const f32x4*)(MOD + ((size_t)l * NB + b) * NMD + (3 * g) * D + 16 * lane + 4 * q);
        for (int n = gw; n < Nw; n += ngw) {
            const u32x4 w0 = *(const u32x4*)(Wt + (size_t)n * D + 16 * lane), w1 = *(const u32x4*)(Wt + (size_t)n * D + 16 * lane + 8);
            const f32x4 wv[4] = {{bflo(w0.x), bfhi(w0.x), bflo(w0.y), bfhi(w0.y)}, {bflo(w0.z), bfhi(w0.z), bflo(w0.w), bfhi(w0.w)}, {bflo(w1.x), bfhi(w1.x), bflo(w1.y), bfhi(w1.y)}, {bflo(w1.z), bfhi(w1.z), bflo(w1.w), bfhi(w1.w)}};
            float acc4[4];
#pragma unroll
            for (int b = 0; b < 4; ++b) { f32x4 a = Sv[b][0] * wv[0] + Sv[b][1] * wv[1] + Sv[b][2] * wv[2] + Sv[b][3] * wv[3]; acc4[b] = wave_sum((a[0] + a[1]) + (a[2] + a[3])); }
            if (lane < 4) BIAS[((size_t)lg * NB + lane) * (2 * F) + n] = lane == 0 ? acc4[0] : lane == 1 ? acc4[1] : lane == 2 ? acc4[2] : acc4[3];
        }
    }
}

__device__ __forceinline__ void bias_layer_mma(unsigned char* ws, int l, LAS unsigned char* lds, int j, int stride, int lane) {
    const float* MOD = (const float*)(ws + WS_MOD); float* BIAS = (float*)(ws + WS_BIAS);
    int tid_ = threadIdx.x; asm volatile("" : "+v"(tid_));
    for (int c = tid_; c < 3 * 4 * 128; c += NWAVES * 64) {
        const int g = c >> 9, b = (c >> 7) & 3, kc = c & 127;
        const float* sp = MOD + ((size_t)l * NB + b) * NMD + (3 * g) * D + 8 * kc;
        const f32x4 s0 = *(const f32x4*)sp, s1 = *(const f32x4*)(sp + 4);
        u32x4 hi, lo;
        hi.x = pk2(s0[0], s0[1]); hi.y = pk2(s0[2], s0[3]); hi.z = pk2(s1[0], s1[1]); hi.w = pk2(s1[2], s1[3]);
        lo.x = pk2(s0[0] - bflo(hi.x), s0[1] - bfhi(hi.x)); lo.y = pk2(s0[2] - bflo(hi.y), s0[3] - bfhi(hi.y)); lo.z = pk2(s1[0] - bflo(hi.z), s1[1] - bfhi(hi.z)); lo.w = pk2(s1[2] - bflo(hi.w), s1[3] - bfhi(hi.w));
        const int off = ((g * 2) * 32 + (kc >> 2)) * 256 + (kc & 3) * 64 + b * 16;
        *(LAS u32x4*)(lds + off) = hi; *(LAS u32x4*)(lds + off + 8192) = lo; }
    if (tid_ == 0) { unsigned z_ = 0u; asm volatile("" : "+v"(z_)); *(LAS u32x4*)(lds + 49152) = (u32x4){z_, z_, z_, z_}; }
    __syncthreads();
    int ln = lane; asm volatile("" : "+v"(ln));
    const int fr = ln & 15, fq = ln >> 4;
    for (int grp = j; grp < 896; grp += stride) {
        const int g = grp < 352 ? 0 : grp < 544 ? 1 : 2; const int n0 = 16 * (grp - (g == 0 ? 0 : g == 1 ? 352 : 544));
        const bf16_t* Wt = (const bf16_t*)(ws + WS_W + (size_t)l * W_L + (g == 0 ? W_1IN : g == 1 ? W_IN : W_2IN)) + (size_t)(n0 + fr) * D + 8 * fq;
        bf16x8 wf[32];
#pragma unroll
        for (int ks = 0; ks < 32; ++ks) wf[ks] = *(const bf16x8*)(Wt + 32 * ks);
        const bool act = fr < 4; const int sb = act ? g * 16384 + fq * 64 + fr * 16 : 49152, st = act ? 256 : 0, lo_ = act ? 8192 : 0;
        f32x4 acc = {0.f, 0.f, 0.f, 0.f};
#pragma unroll
        for (int ks = 0; ks < 32; ++ks) { const bf16x8 sh = *(const LAS bf16x8*)(lds + sb + ks * st), sl = *(const LAS bf16x8*)(lds + sb + lo_ + ks * st);
            acc = __builtin_amdgcn_mfma_f32_16x16x32_bf16(wf[ks], sh, acc, 0, 0, 0); acc = __builtin_amdgcn_mfma_f32_16x16x32_bf16(wf[ks], sl, acc, 0, 0, 0); }
        if (act) *(f32x4*)(BIAS + ((size_t)(l * 3 + g) * NB + fr) * (2 * F) + n0 + 4 * fq) = acc;
    }
    __syncthreads();
}

__global__ void __launch_bounds__(NWAVES * 64, 2) mega(Args args) {
    Frame FR;
    FR.lds = (LAS unsigned char*)lds_raw;
    volatile LAS unsigned* MISC = (volatile LAS unsigned*)(FR.lds + MISC_OFF);
    FR.wave = __builtin_amdgcn_readfirstlane((int)threadIdx.x >> 6);
    FR.G = gridDim.x; { const int bx = blockIdx.x; FR.vcu = (FR.G % 8 == 0) ? (bx % 8) * (FR.G / 8) + bx / 8 : bx; }
    FR.gw = FR.vcu * NWAVES + FR.wave; FR.NGW = FR.G * NWAVES;
    unsigned char* ws = args.ws;
    gu32* ctl = (gu32*)(ws + WS_CTL);
    for (int u = (int)threadIdx.x; u < (LDS_BYTES - LDSCTL_OFF) / 4; u += NWAVES * 64) ((LAS unsigned*)(FR.lds + LDSCTL_OFF))[u] = 0u;
    __syncthreads();
#if PROBE_PRO
    if (blockIdx.x == 0 && (int)threadIdx.x == 0) ((volatile LAS unsigned long long*)((LAS unsigned char*)lds_raw + MISC_OFF + 200))[0] = __builtin_amdgcn_s_memrealtime();
#endif
    const int lo = args.ph_lo, hi = args.ph_hi;
    if (MK_ONE_LAUNCH || hi - lo > 1) (void)xcd_barrier_post((unsigned*)(ctl + CW_BAR) + args.li * XCD_BAR_WORDS, MISC + 8);
#define bar (XcdBarrier{(unsigned*)((gu32*)(args.ws + WS_CTL) + CW_BAR) + args.li * XCD_BAR_WORDS, xb_xcc_id(), (volatile LAS unsigned*)((LAS unsigned char*)lds_raw + MISC_OFF) + 8})
#if MK_ONE_LAUNCH
#define IN(k) true
#if PROBE_BAR2
#define SEAM(k) do { xcd_barrier(bar); xcd_barrier(bar); } while (0)
#else
#define SEAM(k) xcd_barrier(bar)
#endif
#else
#define IN(k) (lo <= (k) && (k) < hi)
#define SEAM(k) do { if (IN(k) && IN((k) + 1)) xcd_barrier(bar); } while (0)
#endif
    float* X = (float*)(ws + WS_X); bf16_t* H = (bf16_t*)(ws + WS_H); bf16_t* Y = (bf16_t*)(ws + WS_Y); bf16_t* ACT = (bf16_t*)(ws + WS_ACT); bf16_t* PROJ = (bf16_t*)(ws + WS_PROJ);
    float* MODP = (float*)(ws + WS_MODP); float* MOD = (float*)(ws + WS_MOD); float* TABD = (float*)(ws + WS_TABD); float* TABR = (float*)(ws + WS_TABR);

    float* ANORM = (float*)(ws + WS_ANORM); float* BIAS = (float*)(ws + WS_BIAS); float* SSQ = (float*)(ws + WS_SSQ); bf16_t* XS = H;
    for (int repp = 0; repp < PROBE_REPP; ++repp) {
    if (IN(0)) {
        for (int i = FR.gw * 64 + lane_id(); i < M * 36; i += FR.NGW * 64) {
            const int m = i / 36, f = i % 36; const float p = (float)args.pos[m];
            if (f < 4) { const float inv = powf(500000.0f, -0.25f * (float)f); float s, c; sincosf(p * (f == 0 ? 1.0f : inv), &s, &c); TABD[m * 8 + f] = c; TABD[m * 8 + 4 + f] = s; }
            else { const int g = f - 4; const float inv = powf(10000.0f, -(float)g * (2.0f / 64.0f)); float s, c; sincosf(p * inv, &s, &c); TABR[m * 64 + g] = c; TABR[m * 64 + 32 + g] = s; }
        }
        LAS float* sc = (LAS float*)(FR.lds + RING_OFF);
        for (int i = (int)threadIdx.x; i < NB * D; i += NWAVES * 64) sc[i] = siluf_(args.in[1][i]);
        __syncthreads();
        for (int it = FR.gw; it < NL * NKC * (NMD / 256); it += FR.NGW) {
            const int nb = it % (NMD / 256), kc = (it / (NMD / 256)) % NKC, l = it / ((NMD / 256) * NKC);
            const float* W = args.in[6] + ((size_t)l * D + kc * KC) * NMD + nb * 256 + lane_id() * 4;
            f32x4 a0 = {0, 0, 0, 0}, a1 = a0, a2 = a0, a3 = a0;
#pragma unroll 8
            for (int k = 0; k < KC; ++k) { const f32x4 w = __builtin_nontemporal_load((const GAS f32x4*)(W + (size_t)k * NMD)); const int kk = kc * KC + k;
                a0 += w * sc[kk]; a1 += w * sc[D + kk]; a2 += w * sc[2 * D + kk]; a3 += w * sc[3 * D + kk]; }
            float* P = MODP + ((size_t)(kc * NL + l) * NB) * NMD + nb * 256 + lane_id() * 4;
            *(f32x4*)(P) = a0; *(f32x4*)(P + NMD) = a1; *(f32x4*)(P + 2 * NMD) = a2; *(f32x4*)(P + 3 * NMD) = a3;
        }
        __syncthreads();
        { LAS float* scr = (LAS float*)(FR.lds + RING_OFF + FR.wave * 16384);
          for (int it = FR.gw; it < CONV_ITEMS_L; it += FR.NGW) conv_item(ConvSrc{args.in[8], args.in[9], args.in[10], args.in[11], args.in[12], args.in[13]}, ws, 0, it, scr, lane_id()); }
        __syncthreads();
    }
    SEAM(0);
    if (IN(1)) {
        for (int i = FR.gw * 64 + lane_id(); i < NL * NB * NMD; i += FR.NGW * 64) {
            const int l = i / (NB * NMD), b = (i / NMD) % NB, n = i % NMD; float s = args.in[7][l * NMD + n];
            for (int kc = 0; kc < NKC; ++kc) s += MODP[(size_t)kc * NL * NB * NMD + i];
            MOD[i] = s;
            const int part = n / D, k = n % D;
            if (part % 3 == 1) { const int j = part / 3; ANORM[(((size_t)l * 3 + j) * NB + b) * D + k] = args.in[3 + j][l * D + k] * (1.0f + s); } }
        { bf16_t* GW = (bf16_t*)(ws + WS_GW); float* SP8 = (float*)(ws + WS_SP8); float* LAMS = (float*)(ws + WS_LAMS);
          for (int i = FR.gw * 64 + lane_id(); i < NL * 2 * 6 * 64 * 64; i += FR.NGW * 64) { const int in_ = i & 63, out = (i >> 6) & 63, h = (i >> 12) % 6, g = ((i >> 12) / 6) & 1, l = (i >> 12) / 12;
              const float v = args.in[g ? 18 : 16][(((size_t)l * 6 + h) * 64 + in_) * 64 + out]; GW[i] = (bf16_t)(pk2(v, 0.f) & 0xffffu); }
          for (int i = FR.gw * 64 + lane_id(); i < NL * RW; i += FR.NGW * 64) SP8[i] = -8.0f * log1pf(expf(-args.in[20][i]));
          if (FR.gw < NL) { const int l = FR.gw; float s1 = 0.f, s2 = 0.f; if (lane_id() < 32) { s1 = args.in[21][l * 32 + lane_id()] * args.in[22][l * 32 + lane_id()]; s2 = args.in[23][l * 32 + lane_id()] * args.in[24][l * 32 + lane_id()]; }
              s1 = wave_sum(s1); s2 = wave_sum(s2); if (lane_id() == 0) LAMS[l] = expf(s1) - expf(s2) + args.lam_init[l]; } }
    }
    SEAM(1);
    if (IN(2)) {
        { const int b = FR.gw >> 9; const float* ap = ANORM + (size_t)b * D; f32x4 Av[4];
#pragma unroll
          for (int jj = 0; jj < 4; ++jj) Av[jj] = *(const f32x4*)(ap + 4 * lane_id() + 256 * jj);
          for (int rr = 0; rr < 8; ++rr) { const int m = FR.gw * 8 + rr; const GAS f32x4* xr = (const GAS f32x4*)(args.in[0] + (size_t)m * D) + lane_id(); f32x4 v[4]; float s2 = 0.f;
#pragma unroll
              for (int jj = 0; jj < 4; ++jj) { v[jj] = __builtin_nontemporal_load(xr + 64 * jj); s2 += (v[jj].x * v[jj].x + v[jj].y * v[jj].y) + (v[jj].z * v[jj].z + v[jj].w * v[jj].w); }
              s2 = wave_sum(s2);
              if (lane_id() < 16) SSQ[(size_t)m * 16 + lane_id()] = lane_id() == 0 ? s2 : 0.f;
              GAS u32x2* o8 = (GAS u32x2*)(XS + (size_t)m * D) + lane_id();
#pragma unroll
              for (int jj = 0; jj < 4; ++jj) { const f32x4 h = v[jj] * Av[jj]; u32x2 w; w.x = pk2(h.x, h.y); w.y = pk2(h.z, h.w); o8[64 * jj] = w;
                  u32x2 xw; xw.x = pkh2(v[jj].x, v[jj].y); xw.y = pkh2(v[jj].z, v[jj].w); ((GAS u32x2*)((bf16_t*)(ws + WS_X) + (size_t)m * D) + lane_id())[64 * jj] = xw; } } }
        bias_layer_mma(ws, 0, FR.lds + RING_OFF, FR.gw, FR.NGW, lane_id());
        __syncthreads();
    }
#if PROBE_PRO == 1
    if (blockIdx.x == 0 && (int)threadIdx.x == 0) { asm volatile("s_waitcnt vmcnt(0)" ::: "memory"); const unsigned long long r0_ = __builtin_amdgcn_s_memrealtime(), d_ = (r0_ - ((volatile LAS unsigned long long*)((LAS unsigned char*)lds_raw + MISC_OFF + 200))[0]) * 3ull;
        while (__builtin_amdgcn_s_memrealtime() - r0_ < d_ && __builtin_amdgcn_s_memrealtime() - r0_ < 2000000ull) __builtin_amdgcn_s_sleep(16); }
#endif
    SEAM(2);

    }
    LAS float* rstd_lds = (LAS float*)(FR.lds + LDS_RSTD_OFF);
    for (int l = 0; l < NL; ++l) {
        const int pb = PH_L0 + l * NPH;
        unsigned char* wl = ws + WS_W + (size_t)l * W_L;
        const float* modl = MOD + (size_t)l * NB * NMD;
#define RSTD_TABLE(Ncols, slot, lg_) do { int tl_ = (int)threadIdx.x; asm volatile("" : "+v"(tl_)); pg8::StaticOrder S_; S_.init(M, (Ncols), FR.G, (int)blockIdx.x); const float* sq_ = SSQ + (size_t)(slot) * M * 16; \
            int pmv_[6], pnv_[6];     \
            _Pragma("unroll") for (int i_ = 0; i_ < 6; ++i_) { pg8::Unit u_{0, 0, 0}; const bool k_ = S_.next(i_, u_); pmv_[i_] = __builtin_amdgcn_readfirstlane(k_ ? u_.pm : -1); pnv_[i_] = __builtin_amdgcn_readfirstlane(k_ ? u_.pn : 0); } \
            if (tl_ < 256) { f32x4 a_[6];     \
                _Pragma("unroll") for (int i_ = 0; i_ < 6; ++i_) { const GAS f32x4* q_ = (const GAS f32x4*)(sq_ + ((size_t)(pmv_[i_] < 0 ? 0 : pmv_[i_]) * 256 + tl_) * 16); a_[i_] = (q_[0] + q_[1]) + (q_[2] + q_[3]); } \
                _Pragma("unroll") for (int i_ = 0; i_ < 6; ++i_) if (pmv_[i_] >= 0) rstd_lds[i_ * 256 + tl_] = 1.0f / sqrtf(((a_[i_][0] + a_[i_][1]) + (a_[i_][2] + a_[i_][3])) * (1.f / D) + EPS); } \
            else { float b_[6]; const GAS float* bs_ = (const GAS float*)(BIAS + (size_t)(lg_) * NB * (2 * F)) + (tl_ - 256);     \
                _Pragma("unroll") for (int i_ = 0; i_ < 6; ++i_) b_[i_] = bs_[(size_t)((pmv_[i_] < 0 ? 0 : pmv_[i_]) >> 4) * (2 * F) + pnv_[i_] * 256]; \
                _Pragma("unroll") for (int i_ = 0; i_ < 6; ++i_) if (pmv_[i_] >= 0) ((LAS float*)(FR.lds + LDS_BIAS_OFF))[i_ * 256 + tl_ - 256] = b_[i_]; } \
            __syncthreads(); } while (0)
#define FFN_IN_PHASE(k, c, WOFF, g) do { if (IN(pb + (k))) { RSTD_TABLE(2 * F, (c) & 1, l * 3 + (g)); \
            pg8::Gemm g_{XS, (const bf16_t*)(wl + (WOFF)), M, 2 * F, D, 0}; pg8::StaticOrder S; S.init(M, 2 * F, FR.G, (int)blockIdx.x); pg8::EpiSwiglu E{ws, l * 3 + (g)}; \
            if ((k) == 0) CLK_BEGIN(1); pg8::gemm_phase<pg8::EpiSwiglu, pg8::StaticOrder, true, MK_SP2>(FR.lds + RING_OFF, g_, S, E); if ((k) == 0) { CLK_END(1); EPT_END(1); } } } while (0)
#define OUT_PHASE(k, c, Aop, WOFF, Kdim, gidx, coef_, jn) do { if (IN(pb + (k))) { \
            const bool last_ = (l == NL - 1) && ((jn) == 3); \
            pg8::Gemm g_{Aop, (const bf16_t*)(wl + (WOFF)), M, D, (Kdim), (Kdim) == F ? 1 : 0}; pg8::StaticOrder S; S.init(M, D, FR.G, (int)blockIdx.x); \
            pg8::EpiResid E{ws, l, (gidx), last_ ? -1 : ((jn) == 3 ? (l + 1) * 3 : l * 3 + (jn)), ((c) + 1) & 1, (coef_)}; \
            if ((k) == 1) CLK_BEGIN(3); pg8::gemm_phase<pg8::EpiResid, pg8::StaticOrder, true, MK_SP2>(FR.lds + RING_OFF, g_, S, E); if ((k) == 1) { CLK_END(3); EPT_END(3); } } } while (0)
        const int c0 = 3 * l;
        FFN_IN_PHASE(0, c0, W_1IN, 0);
#if PROBE_REPG > 1
        if (IN(pb + 0)) xcd_barrier(bar);
        FFN_IN_PHASE(0, c0, W_1IN, 0);
#endif
        SEAM_P(pb + 0);
        OUT_PHASE(1, c0, ACT, W_1OUT, F, 2, 0.5f, 1);
#if PROBE_REPO > 1
        xcd_barrier(bar); OUT_PHASE(1, (c0) + 2, ACT, W_1OUT, F, 2, 0.0f, 1);
#endif
        SEAM_P(pb + 1);
        if (IN(pb + 2)) { RSTD_TABLE(NINP, (c0 + 1) & 1, l * 3 + 1);
            pg8::Gemm g{XS, (const bf16_t*)(wl + W_IN), M, NINP, D, 0}; pg8::StaticOrder S; S.init(M, NINP, FR.G, (int)blockIdx.x); pg8::EpiMixIn E{ws, l};
            pg8::gemm_phase<pg8::EpiMixIn, pg8::StaticOrder, true, MK_SP2>(FR.lds + RING_OFF, g, S, E); EPT_END(5); }
        SEAM_P(pb + 2);
#if !MK_NAIVE_MIX
        for (int rep5 = 0; rep5 < PROBE_REP5; ++rep5) { if (rep5) xcd_barrier(bar);
        if (IN(pb + 3)) {
            const bf16_t* GWl = (const bf16_t*)(ws + WS_GW) + (size_t)l * 2 * 6 * 64 * 64;
            const float lam = ((const float*)(ws + WS_LAMS))[l], lam_init = args.lam_init[l];
            LAS unsigned* qw = (LAS unsigned*)(FR.lds + LDSCTL_OFF + 256);
            CLK_BEGIN(2);
            constexpr unsigned N_RG = NB * 64 * 6 / NWAVES, Q_R1 = (unsigned)mix::N_RET, Q_DIFF = Q_R1 + N_RG, Q_R2 = Q_DIFF + (unsigned)mix::N_DIFF, Q_CONV = Q_R2 + N_RG;
            unsigned* r1done = (unsigned*)(ctl + CW_Q + 64 * (l + NL * rep5) + 32);
            bool pub = false;
            for (;;) {
                if ((int)threadIdx.x == 0) {
                    if (pub) { __builtin_amdgcn_fence(__ATOMIC_RELEASE, "agent"); (void)__hip_atomic_fetch_add(r1done, 1u, RLX_AGENT); }
                    *qw = __hip_atomic_fetch_add((unsigned*)(ctl + CW_Q + 64 * (l + NL * rep5)), 1u, RLX_AGENT); }
                __syncthreads();
                pub = false;
                const unsigned it = __builtin_amdgcn_readfirstlane(*qw);
                if (it >= Q_R1 && it < Q_DIFF) { const int wi = (int)(it - Q_R1) * NWAVES + FR.wave;
                    if (!((PROBE_MIXV & 4) && rep5 == 0)) mix::rglru_item<1>(wi, PROJ, GWl, (const float*)(ws + WS_SP8) + l * RW, args.in[14] + l * 4 * RW, args.in[15] + l * RW, args.in[17] + l * RW, args.in[19] + l * RW, (float*)(ws + WS_AGGA), (float*)(ws + WS_AGGB), Y, lane_id());
                    asm volatile("s_waitcnt vmcnt(0)" ::: "memory"); __syncthreads();
                    pub = true;
                    continue; }
                if (it >= Q_R2 && it < Q_CONV) {
                    if ((int)threadIdx.x == 0) { unsigned sp_ = 0; while (__hip_atomic_load(r1done, RLX_AGENT) < N_RG) { __builtin_amdgcn_s_sleep(2); if (++sp_ > (1u << 17)) break; } __builtin_amdgcn_fence(__ATOMIC_ACQUIRE, "agent"); }
                    __syncthreads();
                    const int wi = (int)(it - Q_R2) * NWAVES + FR.wave;
                    if (!((PROBE_MIXV & 4) && rep5 == 0)) mix::rglru_item<2>(wi, PROJ, GWl, (const float*)(ws + WS_SP8) + l * RW, args.in[14] + l * 4 * RW, args.in[15] + l * RW, args.in[17] + l * RW, args.in[19] + l * RW, (float*)(ws + WS_AGGA), (float*)(ws + WS_AGGB), Y, lane_id());
                    continue; }
                if (it >= Q_CONV) {
                    const int cw = (int)(it - Q_CONV);
                    if (l + 1 >= NL || cw >= CONV_WG_ITEMS) break;
                    const int r = cw * NWAVES + FR.wave;
                    if (r < CONV_ITEMS_L && !((PROBE_MIXV & 8) && rep5 == 0)) conv_item(ConvSrc{args.in[8], args.in[9], args.in[10], args.in[11], args.in[12], args.in[13]}, ws, l + 1, r, (LAS float*)(FR.lds + RING_OFF + FR.wave * 16384), lane_id());
                    continue; }
                const unsigned code = mix::g_items.v[it < Q_R1 ? it : it - N_RG]; const int qb = (code >> 8) & 15, bh = code & 31;
                if ((PROBE_MIXV & 3) && rep5 == 0 && ((code & 0x8000u) ? (PROBE_MIXV & 2) : (PROBE_MIXV & 1))) continue;
                if (code & 0x8000u) mix::ret_seq(bh >> 2, bh & 3, PROJ, Y, FR.lds + RING_OFF);
#if PROBE_DV
                else if (rep5 == 0) mix::attn_unit<0, PROBE_DV>(bh / 6, bh % 6, qb, PROJ, Y, FR.lds + RING_OFF, lam, lam_init, args.in[25] + l * 64);
#endif
                else mix::attn_unit<0>(bh / 6, bh % 6, qb, PROJ, Y, FR.lds + RING_OFF, lam, lam_init, args.in[25] + l * 64);
            }
            CLK_END(2);
        } }
#endif
        SEAM_P(pb + 3);
        OUT_PHASE(5, c0 + 1, Y, W_OUT, D, 5, 1.0f, 2);
#if PROBE_REPO > 1
        xcd_barrier(bar); OUT_PHASE(5, (c0 + 1) + 2, Y, W_OUT, D, 5, 0.0f, 2);
#endif
        SEAM_P(pb + 5);
        FFN_IN_PHASE(6, c0 + 2, W_2IN, 2);
        if (IN(pb + 6) && l + 1 < NL) {
            const int nfull = ((M / 256) * (2 * F / 256)) % FR.G;
            if (nfull > 0) { if ((int)blockIdx.x >= nfull) bias_layer_mma(ws, l + 1, FR.lds + RING_OFF, ((int)blockIdx.x - nfull) * NWAVES + FR.wave, (FR.G - nfull) * NWAVES, lane_id()); }
            else bias_layer_mma(ws, l + 1, FR.lds + RING_OFF, FR.gw, FR.NGW, lane_id());
        }
        SEAM_P(pb + 6);
        OUT_PHASE(7, c0 + 2, ACT, W_2OUT, F, 8, 0.5f, 3);
#if PROBE_REPO > 1
        xcd_barrier(bar); OUT_PHASE(7, (c0 + 2) + 2, ACT, W_2OUT, F, 8, 0.0f, 3);
#endif
        SEAM_P(pb + 7);
#if PROBE_PRO >= 30
        if (l == PROBE_PRO % 10 && blockIdx.x == 0 && (int)threadIdx.x == 0) ((volatile LAS unsigned long long*)((LAS unsigned char*)lds_raw + MISC_OFF + 200))[1] = __builtin_amdgcn_s_memrealtime();
#elif PROBE_PRO >= 10
        if (l == PROBE_PRO % 10 && blockIdx.x == 0 && (int)threadIdx.x == 0) { const unsigned long long r0_ = __builtin_amdgcn_s_memrealtime(), d_ = PROBE_PRO >= 20 ? 20000ull : (r0_ - ((volatile LAS unsigned long long*)((LAS unsigned char*)lds_raw + MISC_OFF + 200))[0]);
            while (__builtin_amdgcn_s_memrealtime() - r0_ < d_ && __builtin_amdgcn_s_memrealtime() - r0_ < 2000000ull) __builtin_amdgcn_s_sleep(16); }
#endif
    }
    if (IN(PH_FINAL)) {
        int lnf = lane_id(); asm volatile("" : "+v"(lnf));
        const float* gp = args.in[26]; f32x4 Gv[4];
#pragma unroll
        for (int jj = 0; jj < 4; ++jj) Gv[jj] = *(const f32x4*)(gp + 4 * lnf + 256 * jj);
        for (int rr = 0; rr < 8; ++rr) { const int m = FR.gw * 8 + rr; const GAS u32x2* xr = (const GAS u32x2*)((const bf16_t*)(ws + WS_X) + (size_t)m * D) + lnf; f32x4 v[4]; float s2 = 0.f;
#pragma unroll
            for (int jj = 0; jj < 4; ++jj) { const u32x2 xw = xr[64 * jj]; v[jj] = (f32x4){hlo(xw.x), hhi(xw.x), hlo(xw.y), hhi(xw.y)}; s2 += (v[jj].x * v[jj].x + v[jj].y * v[jj].y) + (v[jj].z * v[jj].z + v[jj].w * v[jj].w); }
            const float rstd = 1.0f / sqrtf(wave_sum(s2) * (1.f / D) + EPS);
            GAS f32x4* o = (GAS f32x4*)(args.out + (size_t)m * D) + lnf;
#pragma unroll
            for (int jj = 0; jj < 4; ++jj) o[64 * jj] = v[jj] * rstd * Gv[jj]; }
    }
#if PROBE_PRO == 2 || PROBE_PRO >= 30
    if (blockIdx.x == 0 && (int)threadIdx.x == 0) { asm volatile("s_waitcnt vmcnt(0)" ::: "memory"); volatile LAS unsigned long long* st_ = (volatile LAS unsigned long long*)((LAS unsigned char*)lds_raw + MISC_OFF + 200); const unsigned long long r0_ = __builtin_amdgcn_s_memrealtime(), d_ = (PROBE_PRO >= 30 ? st_[1] : r0_) - st_[0];
        while (__builtin_amdgcn_s_memrealtime() - r0_ < d_ && __builtin_amdgcn_s_memrealtime() - r0_ < 2000000ull) __builtin_amdgcn_s_sleep(16); }
#endif
#if PROBE_TL
    if (blockIdx.x == 0 && (int)threadIdx.x == 0) { asm volatile("s_waitcnt vmcnt(0)" ::: "memory"); volatile LAS unsigned long long* st_ = (volatile LAS unsigned long long*)((LAS unsigned char*)lds_raw + MISC_OFF + 256);
        const int p_ = PROBE_TL - 1, q_ = p_ == 0 ? -1 : (p_ == 5 ? 3 : p_ - 1); const unsigned long long d_ = (st_[1 + p_] - st_[1 + q_]) * 2ull, r0_ = __builtin_amdgcn_s_memrealtime();
        while (__builtin_amdgcn_s_memrealtime() - r0_ < d_ && __builtin_amdgcn_s_memrealtime() - r0_ < 2000000ull) __builtin_amdgcn_s_sleep(16); }
#endif
#undef IN
#undef SEAM
#undef bar
}

__global__ void nv_conv(const bf16_t* PROJ, const float* cw, const float* cb, float* xc) {
    const int idx = blockIdx.x * 256 + threadIdx.x; if (idx >= M * RW) return;
    const int m = idx / RW, c = idx % RW, t = m & (T - 1); float s = cb[c];
    for (int j = 0; j < 4; ++j) { const int tt = t - 3 + j; if (tt >= 0) s += cw[j * RW + c] * bf2f(PROJ[(size_t)(m - 3 + j) * NINP + C_RX + c]); }
    xc[idx] = s;
}
__global__ void nv_gates(const float* xc, const float* wa, const float* ba, const float* wx, const float* bx, const float* lam, float* av, float* bv) {
    const int idx = blockIdx.x * 256 + threadIdx.x; if (idx >= M * RW) return;
    const int m = idx / RW, c = idx % RW, h = c >> 6, cc = c & 63; float sr = ba[c], si = bx[c];
    for (int i = 0; i < 64; ++i) { const float xv = xc[(size_t)m * RW + 64 * h + i]; sr += xv * wa[(h * 64 + i) * 64 + cc]; si += xv * wx[(h * 64 + i) * 64 + cc]; }
    const float r = 1.f / (1.f + expf(-sr)), ig = 1.f / (1.f + expf(-si)); const float sp = log1pf(expf(-lam[c])); const float la = -8.0f * r * sp;
    av[idx] = expf(la); bv[idx] = sqrtf(-expm1f(2.f * la)) * ig * xc[idx];
}
__global__ void nv_scan(const float* av, const float* bv, const bf16_t* PROJ, bf16_t* Y) {
    const int idx = blockIdx.x * 64 + threadIdx.x; if (idx >= NB * RW) return;
    const int b = idx / RW, c = idx % RW; float h = 0.f;
    for (int t = 0; t < T; ++t) { const size_t m = (size_t)b * T + t; h = av[m * RW + c] * h + bv[m * RW + c];
        const float g = bf2f(PROJ[m * NINP + C_RG + c]); const float u = 0.7978845608028654f * (g + 0.044715f * g * g * g); const float y = 0.5f * g * (1.f + tanhf(u)) * h;
        Y[m * D + c] = (bf16_t)(pk2(y, 0.f) & 0xffffu); }
}
__global__ void __launch_bounds__(64) nv_diff(const bf16_t* PROJ, float* OT) {
    const int t = blockIdx.x * 64 + threadIdx.x, hc = blockIdx.y, h = hc >> 1, comp = hc & 1, b = blockIdx.z;
    const size_t m = (size_t)b * T + t;
    float q[32], o[64];
#pragma unroll
    for (int i = 0; i < 32; ++i) q[i] = bf2f(PROJ[m * NINP + C_DQ + 64 * h + 32 * comp + i]);
#pragma unroll
    for (int i = 0; i < 64; ++i) o[i] = 0.f;
    float mx = -INFINITY, lsum = 0.f; const int tmax = blockIdx.x * 64 + 63;
    for (int j = 0; j <= tmax; ++j) {
        const bf16_t* kr = PROJ + ((size_t)b * T + j) * NINP + C_DK + 64 * h + 32 * comp; const bf16_t* vr = PROJ + ((size_t)b * T + j) * NINP + C_DV + 64 * h;
        float s = 0.f;
#pragma unroll
        for (int i = 0; i < 32; ++i) s += q[i] * bf2f(kr[i]);
        if (j <= t) { const float mn = fmaxf(mx, s); const float al = exp2f(mx - mn), p = exp2f(s - mn); lsum = lsum * al + p; mx = mn;
#pragma unroll
            for (int i = 0; i < 64; ++i) o[i] = o[i] * al + p * bf2f(vr[i]); }
    }
    const float il = 1.f / lsum; float* op = OT + ((m * 6 + h) * 2 + comp) * 64;
#pragma unroll
    for (int i = 0; i < 64; ++i) op[i] = o[i] * il;
}
__global__ void nv_diff_fin(const float* OT, const float* lq1, const float* lk1, const float* lq2, const float* lk2, const float* subg, float lambda_init, bf16_t* Y) {
    const int idx = blockIdx.x * 256 + threadIdx.x; if (idx >= M * 6) return;
    float s1 = 0.f, s2 = 0.f; for (int i = 0; i < 32; ++i) { s1 += lq1[i] * lk1[i]; s2 += lq2[i] * lk2[i]; }
    const float lam = expf(s1) - expf(s2) + lambda_init;
    const int m = idx / 6, h = idx % 6; const float* o1 = OT + ((size_t)idx * 2) * 64; const float* o2 = o1 + 64; float ss = 0.f;
    for (int i = 0; i < 64; ++i) { const float v = o1[i] - lam * o2[i]; ss += v * v; }
    const float r = 1.0f / sqrtf(ss * (1.f / 64.f) + EPS) * (1.f - lambda_init);
    for (int i = 0; i < 64; ++i) { const float v = (o1[i] - lam * o2[i]) * r * subg[i]; Y[(size_t)m * D + RW + 64 * h + i] = (bf16_t)(pk2(v, 0.f) & 0xffffu); }
}
__global__ void __launch_bounds__(64) nv_ret(const bf16_t* PROJ, bf16_t* Y) {
    const int t = blockIdx.x * 64 + threadIdx.x, h = blockIdx.y, b = blockIdx.z; const size_t m = (size_t)b * T + t;
    float q[64], o[64];
#pragma unroll
    for (int i = 0; i < 64; ++i) { q[i] = bf2f(PROJ[m * NINP + C_TQ + 64 * h + i]); o[i] = 0.f; }
    const float lg2 = log2f(1.0f - exp2f(-5.0f - (float)h)); const int tmax = blockIdx.x * 64 + 63;
    for (int j = 0; j <= tmax; ++j) {
        const bf16_t* kr = PROJ + ((size_t)b * T + j) * NINP + C_TK + 64 * h; const bf16_t* vr = PROJ + ((size_t)b * T + j) * NINP + C_TV + 64 * h;
        float s = 0.f;
#pragma unroll
        for (int i = 0; i < 64; ++i) s += q[i] * bf2f(kr[i]);
        if (j <= t) { const float p = s * exp2f(64.0f * (float)((t >> 6) - (j >> 6)) * lg2);
#pragma unroll
            for (int i = 0; i < 64; ++i) o[i] += p * bf2f(vr[i]); }
    }
    float ss = 0.f;
#pragma unroll
    for (int i = 0; i < 64; ++i) ss += o[i] * o[i];
    const float r = 1.0f / sqrtf(ss * (1.f / 64.f) + EPS);
#pragma unroll
    for (int i = 0; i < 64; ++i) { const float g = bf2f(PROJ[m * NINP + C_TG + 64 * h + i]); const float v = g / (1.f + expf(-g)) * o[i] * r; Y[m * D + 768 + 64 * h + i] = (bf16_t)(pk2(v, 0.f) & 0xffffu); }
}

extern "C" void kernel_launch(void* const* d_in, const int* in_sizes, int n_in, void* d_out, int out_size, void* d_ws, size_t ws_size, hipStream_t stream) {
    static int grid = 0;
    if (grid == 0) {
        if (n_in != 27 || in_sizes[0] != M * D || out_size != M * D || ws_size < WS_END) { fprintf(stderr, "kernel_launch: unexpected shapes (n_in %d, ws %zu < %zu)\n", n_in, ws_size, (size_t)WS_END); grid = -1; return; }
        int dev = 0, cus = 0;
        if (hipGetDevice(&dev) != hipSuccess || hipDeviceGetAttribute(&cus, hipDeviceAttributeMultiprocessorCount, dev) != hipSuccess) { grid = -1; return; }
        if (hipFuncSetAttribute((const void*)mega, hipFuncAttributeMaxDynamicSharedMemorySize, LDS_BYTES) != hipSuccess) { fprintf(stderr, "kernel_launch: hipFuncSetAttribute failed\n"); grid = -1; return; }
        int per_cu = 0;
        if (hipOccupancyMaxActiveBlocksPerMultiprocessor(&per_cu, (const void*)mega, NWAVES * 64, LDS_BYTES) != hipSuccess || per_cu < 1) fprintf(stderr, "kernel_launch: occupancy query says %d\n", per_cu);
        (void)hipGetLastError();
        grid = cus;
        if (grid != 256) { fprintf(stderr, "kernel_launch: built for 256 CUs, got %d\n", grid); }
    }
    if (grid < 0) return;
    (void)hipMemsetAsync((char*)d_ws + WS_CTL, 0, CTL_ZERO_BYTES, stream);
    Args a{};
    for (int i = 0; i < 27; ++i) a.in[i] = (const float*)d_in[i];
    a.pos = (const int*)d_in[2]; a.out = (float*)d_out; a.ws = (unsigned char*)d_ws;
    for (int l = 0; l < NL; ++l) a.lam_init[l] = (float)(0.8 - 0.6 * exp(-0.3 * (double)l));
    unsigned char* ws = (unsigned char*)d_ws;
#if MK_ONE_LAUNCH
    a.ph_lo = 0; a.ph_hi = PH_END;
    hipLaunchKernelGGL(mega, dim3(grid), dim3(NWAVES * 64), LDS_BYTES, stream, a);
#else
    int nrun = 0; auto run = [&](int lo, int hi) { a.ph_lo = lo; a.ph_hi = hi; a.li = nrun++; hipLaunchKernelGGL(mega, dim3(grid), dim3(NWAVES * 64), LDS_BYTES, stream, a); };
    int seg_lo = 0;
    for (int l = 0; l < NL; ++l) {
        const int pb = PH_L0 + l * NPH;
        run(seg_lo, pb + 3); seg_lo = pb + 5;
#if !MK_NAIVE_MIX
        run(pb + 3, pb + 4); run(pb + 4, pb + 5);
#endif
        if (MK_NAIVE_MASK) {
            const bf16_t* PROJ = (const bf16_t*)(ws + WS_PROJ); bf16_t* Y = (bf16_t*)(ws + WS_Y);
            float* xc = (float*)(ws + WS_TMP); float* av = xc + (size_t)M * RW; float* bv = av + (size_t)M * RW; float* OT = (float*)(ws + WS_TMP);
            if (MK_NAIVE_MASK & 1) {
                hipLaunchKernelGGL(nv_conv, dim3(M * RW / 256), dim3(256), 0, stream, PROJ, a.in[14] + l * 4 * RW, a.in[15] + l * RW, xc);
                hipLaunchKernelGGL(nv_gates, dim3(M * RW / 256), dim3(256), 0, stream, xc, a.in[16] + l * 6 * 64 * 64, a.in[17] + l * RW, a.in[18] + l * 6 * 64 * 64, a.in[19] + l * RW, a.in[20] + l * RW, av, bv);
                hipLaunchKernelGGL(nv_scan, dim3(NB * RW / 64), dim3(64), 0, stream, av, bv, PROJ, Y); }
            if (MK_NAIVE_MASK & 2) {
                hipLaunchKernelGGL(nv_diff, dim3(T / 64, 12, NB), dim3(64), 0, stream, PROJ, OT);
                hipLaunchKernelGGL(nv_diff_fin, dim3(M * 6 / 256), dim3(256), 0, stream, OT, a.in[21] + l * 32, a.in[22] + l * 32, a.in[23] + l * 32, a.in[24] + l * 32, a.in[25] + l * 64, a.lam_init[l], Y); }
            if (MK_NAIVE_MASK & 4) hipLaunchKernelGGL(nv_ret, dim3(T / 64, 4, NB), dim3(64), 0, stream, PROJ, Y);
        }
    }
    run(seg_lo, PH_END);
#endif
}
```

```cpp
#include <hip/hip_runtime.h>
#include <cstdio>
#include <cstdint>
#include <cmath>

#ifndef MK_ONE_LAUNCH
#define MK_ONE_LAUNCH 1
#endif
#ifndef PROBE_REP5
#define PROBE_REP5 1
#endif
#ifndef PROBE_EPIR2
#define PROBE_EPIR2 0
#endif
#ifndef PROBE_EPI2
#define PROBE_EPI2 0
#endif
#ifndef PROBE_XEXP
#define PROBE_XEXP 0
#endif
#if PROBE_XEXP
#define PROBE_EXTRA_EXP(pa, pb) do { _Pragma("unroll") for (int r = 0; r < 16; ++r) { float d0_, d1_; asm volatile("v_exp_f32 %0, %2\n\tv_exp_f32 %1, %3" : "=v"(d0_), "=v"(d1_) : "v"(pa[r]), "v"(pb[r])); } } while (0)
#else
#define PROBE_EXTRA_EXP(pa, pb) do { } while (0)
#endif
#ifndef MK_SP2
#define MK_SP2 true
#endif
#ifndef PROBE_REPO
#define PROBE_REPO 1
#endif
#ifndef PROBE_REPP
#define PROBE_REPP 1
#endif
#ifndef PROBE_REPR
#define PROBE_REPR 1
#endif
#ifndef PROBE_BAR2
#define PROBE_BAR2 0
#endif
#ifndef PROBE_REPG
#define PROBE_REPG 1
#endif
#ifndef PROBE_CLK
#define PROBE_CLK 0
#endif
#ifndef PROBE_EPT
#define PROBE_EPT 0
#endif
#ifndef PROBE_BARW
#define PROBE_BARW 0
#endif
#ifndef PROBE_BARW_WG
#define PROBE_BARW_WG 0
#endif
#ifndef PROBE_PRO
#define PROBE_PRO 0
#endif
#ifndef PROBE_MIXV
#define PROBE_MIXV 0
#endif
#ifndef PROBE_DV
#define PROBE_DV 0
#endif
#ifndef PROBE_TL
#define PROBE_TL 0
#endif
#ifndef PROBE_PHT
#define PROBE_PHT 0
#endif
#if PROBE_BARW
#define SEAM_P(k) do { unsigned long long b0_ = 0; const bool me_ = (PROBE_BARW - 1 == (k) - pb) && l == 1 && blockIdx.x == PROBE_BARW_WG && (int)threadIdx.x == 0; if (me_) b0_ = __builtin_amdgcn_s_memrealtime(); SEAM(k); \
        if (me_) { const unsigned long long r0_ = __builtin_amdgcn_s_memrealtime(), d_ = (r0_ - b0_) * 20ull; while (__builtin_amdgcn_s_memrealtime() - r0_ < d_ && __builtin_amdgcn_s_memrealtime() - r0_ < 2000000ull) __builtin_amdgcn_s_sleep(16); } } while (0)
#elif PROBE_PHT
#define SEAM_P(k) do { if (blockIdx.x == 0 && (int)threadIdx.x == 0 && l == 1 && (k) - pb == PROBE_PHT - 1) { volatile LAS unsigned long long* lt_ = (volatile LAS unsigned long long*)((LAS unsigned char*)lds_raw + MISC_OFF + 192); \
        asm volatile("s_waitcnt vmcnt(0)" ::: "memory"); const unsigned long long r0_ = __builtin_amdgcn_s_memrealtime(), d_ = (r0_ - lt_[0]) * 5ull; while (__builtin_amdgcn_s_memrealtime() - r0_ < d_ && __builtin_amdgcn_s_memrealtime() - r0_ < 2000000ull) __builtin_amdgcn_s_sleep(16); } \
        SEAM(k); if (blockIdx.x == 0 && (int)threadIdx.x == 0) { volatile LAS unsigned long long* lt_ = (volatile LAS unsigned long long*)((LAS unsigned char*)lds_raw + MISC_OFF + 192); lt_[0] = __builtin_amdgcn_s_memrealtime(); } } while (0)
#elif PROBE_TL
#define SEAM_P(k) do { SEAM(k); if (blockIdx.x == 0 && (int)threadIdx.x == 0 && (l == 1 || (l == 0 && (k) - pb == 7))) ((volatile LAS unsigned long long*)((LAS unsigned char*)lds_raw + MISC_OFF + 256))[l == 0 ? 0 : 1 + (k) - pb] = __builtin_amdgcn_s_memrealtime(); } while (0)
#else
#define SEAM_P(k) SEAM(k)
#endif
#if PROBE_EPT
#define EPT_END(sel) do { if ((PROBE_EPT % 10) == (sel) && (int)threadIdx.x == 0 && l == 1 && blockIdx.x == 0) { volatile LAS unsigned long long* ep_ = (volatile LAS unsigned long long*)((LAS unsigned char*)lds_raw + MISC_OFF + 160); \
        const unsigned long long d_ = (PROBE_EPT >= 10) ? (ep_[0] - ep_[2]) * 5ull : (ep_[1] - ep_[0]) * 100ull; const unsigned long long r0_ = __builtin_amdgcn_s_memrealtime(); \
        while (__builtin_amdgcn_s_memrealtime() - r0_ < d_ && __builtin_amdgcn_s_memrealtime() - r0_ < 2000000ull) __builtin_amdgcn_s_sleep(16); } } while (0)
#else
#define EPT_END(sel) do { } while (0)
#endif
#if PROBE_CLK
#define CLK_BEGIN(sel) do { if (PROBE_CLK == (sel) && (int)threadIdx.x == 0 && l == 1) { volatile LAS unsigned long long* ck_ = (volatile LAS unsigned long long*)((LAS unsigned char*)lds_raw + MISC_OFF + 128); ck_[0] = __builtin_amdgcn_s_memtime(); ck_[1] = __builtin_amdgcn_s_memrealtime(); } } while (0)
#define CLK_END(sel) do { if (PROBE_CLK == (sel) && (int)threadIdx.x == 0 && l == 1) { volatile LAS unsigned long long* ck_ = (volatile LAS unsigned long long*)((LAS unsigned char*)lds_raw + MISC_OFF + 128); \
        const unsigned long long t1_ = __builtin_amdgcn_s_memtime(), r1_ = __builtin_amdgcn_s_memrealtime(); const float dt_ = (float)(t1_ - ck_[0]), dr_ = (float)(r1_ - ck_[1]); \
        float mhz_ = dr_ > 0.f ? dt_ * 100.f / dr_ : 1000.f; mhz_ = mhz_ < 1000.f ? 1000.f : (mhz_ > 3000.f ? 3000.f : mhz_); \
        if (blockIdx.x == 0) { const unsigned long long tgt_ = (unsigned long long)((mhz_ - 1000.f) * 100.f); while (__builtin_amdgcn_s_memrealtime() - r1_ < tgt_) __builtin_amdgcn_s_sleep(16); } } } while (0)
#else
#define CLK_BEGIN(sel) do { } while (0)
#define CLK_END(sel) do { } while (0)
#endif
#ifndef MK_NAIVE_MIX
#define MK_NAIVE_MIX 0
#endif
#ifndef MK_NAIVE_MASK
#define MK_NAIVE_MASK 0
#endif

constexpr int D = 1024, NB = 4, T = 4096, M = NB * T, NL = 4, F = 2816, NMOD = 9, NMD = NMOD * D;
constexpr int NIN = 2944, NINP = 3072;
constexpr int C_DQ = 0, C_DK = 384, C_TQ = 768, C_TK = 1024, C_DV = 1280, C_TV = 1664, C_TG = 1920, C_RX = 2176, C_RG = 2560;
constexpr int RW = 384;
constexpr float EPS = 1e-6f;
constexpr float QSCALE = 0.17677669529663687f * 1.4426950408889634f;
constexpr int KC = 32, NKC = D / KC;

constexpr size_t MiB = 1u << 20;
constexpr size_t WS_CTL = 0, CTL_ZERO_BYTES = 1 * MiB;
constexpr size_t WS_MODP = 1 * MiB;
constexpr size_t WS_MOD = 20 * MiB;
constexpr size_t WS_GW = 20 * MiB + 640 * 1024;
constexpr size_t WS_TABD = 21 * MiB;
constexpr size_t WS_TABR = 22 * MiB;
constexpr size_t WS_W = 26 * MiB;
constexpr size_t W_L = 41 * MiB, W_1IN = 0, W_1OUT = 11 * MiB, W_2IN = 16 * MiB + MiB / 2, W_2OUT = 27 * MiB + MiB / 2, W_IN = 33 * MiB, W_OUT = 39 * MiB;
constexpr size_t WS_X = WS_W + NL * W_L;
constexpr size_t WS_H = WS_X + 64 * MiB;
constexpr size_t WS_Y = WS_H + 32 * MiB;
constexpr size_t WS_ACT = WS_Y + 32 * MiB;
constexpr size_t WS_PROJ = WS_ACT;
constexpr size_t WS_TMP = WS_ACT + 96 * MiB;
constexpr size_t WS_SP8 = 21 * MiB + 512 * 1024;
constexpr size_t WS_LAMS = 21 * MiB + 520 * 1024;
constexpr size_t WS_ANORM = 21 * MiB + 528 * 1024;
constexpr size_t WS_BIAS = WS_TMP + 100 * MiB;
constexpr size_t WS_SSQ = WS_TMP + 104 * MiB;
constexpr size_t WS_AGGA = WS_TMP + 110 * MiB, WS_AGGB = WS_TMP + 111 * MiB;
constexpr size_t WS_END = WS_TMP + 112 * MiB;
constexpr int CW_TMO = 0, CW_CODE = 1, CW_Q = 2048  , CW_BAR = 4096;

#define GAS __attribute__((address_space(1)))
#define LAS __attribute__((address_space(3)))
typedef unsigned short bf16_t;
typedef short bf16x8 __attribute__((ext_vector_type(8)));
typedef float f32x4 __attribute__((ext_vector_type(4)));
typedef float f32x2 __attribute__((ext_vector_type(2)));
typedef unsigned u32x4 __attribute__((ext_vector_type(4)));
typedef unsigned u32x2 __attribute__((ext_vector_type(2)));
typedef __bf16 bf16x2_t __attribute__((ext_vector_type(2)));
typedef GAS unsigned gu32;
#define RLX_AGENT __ATOMIC_RELAXED, __HIP_MEMORY_SCOPE_AGENT
#define LDS_WAIT() asm volatile("s_waitcnt lgkmcnt(0)" ::: "memory")
#define VM_WAIT() asm volatile("s_waitcnt vmcnt(0)" ::: "memory")
__device__ __forceinline__ unsigned pk2(float lo, float hi) { f32x2 v = {lo, hi}; bf16x2_t b = __builtin_convertvector(v, bf16x2_t); return __builtin_bit_cast(unsigned, b); }
typedef _Float16 h16x2_t __attribute__((ext_vector_type(2)));
__device__ __forceinline__ unsigned pkh2(float lo, float hi) { f32x2 v = {lo, hi}; h16x2_t h = __builtin_convertvector(v, h16x2_t); return __builtin_bit_cast(unsigned, h); }
__device__ __forceinline__ float hlo(unsigned w) { const h16x2_t h = __builtin_bit_cast(h16x2_t, w); return (float)h[0]; }
__device__ __forceinline__ float hhi(unsigned w) { const h16x2_t h = __builtin_bit_cast(h16x2_t, w); return (float)h[1]; }
__device__ __forceinline__ float bf2f(bf16_t v) { return __uint_as_float((unsigned)v << 16); }
__device__ __forceinline__ float bflo(unsigned w) { return __uint_as_float(w << 16); }
__device__ __forceinline__ float bfhi(unsigned w) { return __uint_as_float(w & 0xffff0000u); }
__device__ __forceinline__ float fast_rcp(float x) { return __builtin_amdgcn_rcpf(x); }
__device__ __forceinline__ float sigmoidf_(float x) { return fast_rcp(1.f + __builtin_amdgcn_exp2f(-1.4426950408889634f * x)); }
__device__ __forceinline__ float siluf_(float x) { return x * sigmoidf_(x); }
__device__ __forceinline__ float gelu_tanh(float x) { const float u = 0.7978845608028654f * (x + 0.044715f * x * x * x); return x * sigmoidf_(2.f * u); }
__device__ __forceinline__ float gelu_mul(float x, float h) {
    constexpr float k1 = -2.f * 1.4426950408889634f * 0.7978845608028654f, k2 = k1 * 0.044715f;
    const float t = (k2 * (x * x) + k1) * x; return (x * h) * fast_rcp(1.f + __builtin_amdgcn_exp2f(t)); }
__device__ __forceinline__ int lane_id() { int l; asm volatile("v_mbcnt_lo_u32_b32 %0, -1, 0\n\tv_mbcnt_hi_u32_b32 %0, -1, %0" : "=v"(l)); return l; }
template <int XM> __device__ __forceinline__ float swz_xor(float v) { return __int_as_float(__builtin_amdgcn_ds_swizzle(__float_as_int(v), (XM << 10) | 0x1F)); }
__device__ __forceinline__ float sum_x32(float v) { const auto r = __builtin_amdgcn_permlane32_swap(__float_as_uint(v), __float_as_uint(v), false, false); return __uint_as_float(r[0]) + __uint_as_float(r[1]); }
__device__ __forceinline__ int imax_x32(int v) { const auto r = __builtin_amdgcn_permlane32_swap((unsigned)v, (unsigned)v, false, false); const int a = (int)r[0], b = (int)r[1]; return a > b ? a : b; }
__device__ __forceinline__ float wave_sum(float v) {
    v += swz_xor<1>(v); v += swz_xor<2>(v); v += swz_xor<4>(v); v += swz_xor<8>(v); v += swz_xor<16>(v);
    return sum_x32(v);
}

__device__ __forceinline__ float lg2gamma(int hh) { return hh == 0 ? -0.04580368961312479f : hh == 1 ? -0.02272007650008353f : hh == 2 ? -0.011315313227834146f : -0.005646563141142063f; }

constexpr int RING_OFF = 0, RING_BYTES = 131072, LDSCTL_OFF = RING_BYTES, MISC_OFF = LDSCTL_OFF + 320, LDS_RSTD_OFF = RING_BYTES + 1024  , LDS_BIAS_OFF = LDS_RSTD_OFF + 6144  , LDS_BYTES = 163840;
extern __shared__ __attribute__((aligned(16))) unsigned char lds_raw[];

namespace pg8 {
#define PG8_LAS __attribute__((address_space(3)))
constexpr int BM = 256, BK = 64, HALF = 128, HTB = HALF * BK * 2, STAGE_BYTES = 8 * HTB, NXCD = 8, WGM = 8;
__host__ __device__ __forceinline__ int lds_byte(int r, int c) { const int st = (r >> 4) * 2 + (c >> 5), rr = r & 15, cc = c & 31, ob = rr * 64 + cc * 2; return st * 1024 + (ob ^ (((ob >> 9) & 1) << 5)); }
__host__ __device__ __forceinline__ void stage_rc(int b, int& R, int& C) { const int st = b / 1024, sb = b % 1024, swz = sb ^ (((sb >> 9) & 1) << 5); R = (st >> 1) * 16 + swz / 64; C = (st & 1) * 32 + (swz % 64) / 2; }
__host__ __device__ __forceinline__ int perm32(int rho) { const int n = rho >> 4, i = rho & 15; return 8 * (i >> 2) + 4 * n + (i & 3); }
struct Unit { int pm, pn, idx; };
struct Gemm { const bf16_t* A; const bf16_t* Bt; int M, N, K, tiled; };
struct StaticOrder {
    int nM, nN, nwg, G, c;
    __host__ __device__ void init(int M_, int N_, int G_, int c_) { nM = M_ / BM; nN = N_ / BM; nwg = nM * nN; G = G_; c = c_;
#if defined(__HIP_DEVICE_COMPILE__)
        asm volatile("" : "+s"(c));
#endif
    }
    __host__ __device__ __forceinline__ bool next(int i, Unit& u) const {
        const long L = (long)i * G + c; if (L >= nwg) return false;
        int wgid = (int)L; { const int q = nwg / NXCD, r = nwg % NXCD, xcd = wgid % NXCD, off = wgid / NXCD; wgid = (xcd < r ? xcd * (q + 1) : r * (q + 1) + (xcd - r) * q) + off; }
        const int nig = WGM * nN, gid = wgid / nig, fm = gid * WGM, gsz = (nM - fm) < WGM ? (nM - fm) : WGM;
        u.pm = fm + ((wgid % nig) % gsz); u.pn = (wgid % nig) / gsz; u.idx = i; return true;
    }
    __device__ __forceinline__ void a_ready(const Unit&) const {}
    __device__ __forceinline__ void done(const Unit&) const {}
};

struct EpiSwiglu {
    static constexpr bool PERM = true, AFTER_DRAIN = false;
    unsigned char* ws; int lg;
    __device__ __forceinline__ void operator()(const f32x4 (&acc)[2][2][4][2], const Unit& u, int wr, int wc, int fr, int fq) const {
        bf16_t* O = (bf16_t*)(ws + WS_ACT); const float* bias = (const float*)(ws + WS_BIAS) + (size_t)lg * NB * (2 * F); const LAS float* rstd = (const LAS float*)((LAS unsigned char*)lds_raw + LDS_RSTD_OFF);
        const int row0 = u.pm * BM + wr * 64 + fr, col0 = u.pn * HALF + wc * 32 + 8 * fq;
        const LAS float* bp = (const LAS float*)((LAS unsigned char*)lds_raw + LDS_BIAS_OFF) + u.idx * BM + wc * 32 + 8 * fq;
        const f32x4 bg0 = *(const LAS f32x4*)bp, bg1 = *(const LAS f32x4*)(bp + 4), bu0 = *(const LAS f32x4*)(bp + HALF), bu1 = *(const LAS f32x4*)(bp + HALF + 4);
#pragma unroll
        for (int ai = 0; ai < 2; ++ai)
#pragma unroll
            for (int m = 0; m < 4; ++m) {
                const float rs = rstd[u.idx * BM + ai * HALF + m * 16 + wr * 64 + fr];
                const int row_ = row0 + ai * HALF + m * 16;
                bf16_t* rowp = O + ((((size_t)(row_ >> 8) * (F / 64) + (col0 >> 6)) * BM + (row_ & 255)) << 6) + (col0 & 63);
                const f32x4 g0 = acc[ai][0][m][0] * rs + bg0, g1 = acc[ai][0][m][1] * rs + bg1, u0 = acc[ai][1][m][0] * rs + bu0, u1 = acc[ai][1][m][1] * rs + bu1;
                u32x4 w;
                w.x = pk2(siluf_(g0[0]) * u0[0], siluf_(g0[1]) * u0[1]); w.y = pk2(siluf_(g0[2]) * u0[2], siluf_(g0[3]) * u0[3]);
                w.z = pk2(siluf_(g1[0]) * u1[0], siluf_(g1[1]) * u1[1]); w.w = pk2(siluf_(g1[2]) * u1[2], siluf_(g1[3]) * u1[3]);
                *(u32x4*)rowp = w;
            }
    }
};
struct EpiResid {
    static constexpr bool PERM = true, AFTER_DRAIN = false;
    unsigned char* ws; int l, gidx, an_idx, slot; float coef;
    __device__ __forceinline__ void operator()(const f32x4 (&acc)[2][2][4][2], const Unit& u, int wr, int wc, int fr, int fq) const {
        bf16_t* X = (bf16_t*)(ws + WS_X); bf16_t* XS = (bf16_t*)(ws + WS_H); float* SSQ = (float*)(ws + WS_SSQ) + (size_t)slot * M * 16;
        const float* gate = (const float*)(ws + WS_MOD) + (size_t)l * NB * NMD + gidx * D; const float* An = (const float*)(ws + WS_ANORM) + (size_t)(an_idx < 0 ? 0 : an_idx) * NB * D; const bool has_an = an_idx >= 0;
        const int row0 = u.pm * BM + wr * 64 + fr, col0 = u.pn * BM + wc * 32 + 8 * fq, b = u.pm >> 4;
        f32x4 gv[2][2], av[2][2];
#pragma unroll
        for (int bj = 0; bj < 2; ++bj)
#pragma unroll
            for (int n = 0; n < 2; ++n) { gv[bj][n] = *(const f32x4*)(gate + (size_t)b * NMD + col0 + bj * HALF + n * 4) * coef;
                av[bj][n] = *(const f32x4*)(An + (size_t)b * D + col0 + bj * HALF + n * 4); }
        u32x4 xin[2][2];
#define RES_LOAD(g_, buf) do { const size_t ro_ = (size_t)(row0 + ((g_) >> 2) * HALF + ((g_) & 3) * 16) * D + col0; \
            _Pragma("unroll") for (int bj = 0; bj < 2; ++bj) xin[buf][bj] = *(const u32x4*)(X + ro_ + bj * HALF); } while (0)
        RES_LOAD(0, 0);
#pragma unroll
        for (int g = 0; g < 8; ++g) { const int ai = g >> 2, m = g & 3, row = row0 + ai * HALF + m * 16; const size_t ro = (size_t)row * D + col0; float ss = 0.f;
            if (g + 1 < 8) RES_LOAD(g + 1, (g + 1) & 1);
#pragma unroll
            for (int bj = 0; bj < 2; ++bj) { const size_t o = ro + bj * HALF; const u32x4 xi = xin[g & 1][bj];
                const f32x4 x0 = (f32x4){hlo(xi.x), hhi(xi.x), hlo(xi.y), hhi(xi.y)} + gv[bj][0] * acc[ai][bj][m][0], x1 = (f32x4){hlo(xi.z), hhi(xi.z), hlo(xi.w), hhi(xi.w)} + gv[bj][1] * acc[ai][bj][m][1];
                { u32x4 w; w.x = pkh2(x0[0], x0[1]); w.y = pkh2(x0[2], x0[3]); w.z = pkh2(x1[0], x1[1]); w.w = pkh2(x1[2], x1[3]); *(u32x4*)(X + o) = w; }
                ss += ((x0[0] * x0[0] + x0[1] * x0[1]) + (x0[2] * x0[2] + x0[3] * x0[3])) + ((x1[0] * x1[0] + x1[1] * x1[1]) + (x1[2] * x1[2] + x1[3] * x1[3]));
                if (has_an) { const f32x4 s0 = x0 * av[bj][0], s1 = x1 * av[bj][1]; u32x4 w; w.x = pk2(s0[0], s0[1]); w.y = pk2(s0[2], s0[3]); w.z = pk2(s1[0], s1[1]); w.w = pk2(s1[2], s1[3]); *(u32x4*)(XS + o) = w; } }
            ss += swz_xor<16>(ss); ss = sum_x32(ss);
            if (fq == 0) SSQ[(size_t)row * 16 + u.pn * 4 + wc] = ss; }
#undef RES_LOAD
    }
};
struct EpiFinal {
    static constexpr bool PERM = true, AFTER_DRAIN = false;
    unsigned char* ws; float* out; const float* gfin; unsigned* cnt; int l, gidx; float coef;
    __device__ __forceinline__ void operator()(const f32x4 (&acc_)[2][2][4][2], const Unit& u, int wr, int wc, int fr, int fq) const {
        f32x4 (&acc)[2][2][4][2] = const_cast<f32x4 (&)[2][2][4][2]>(acc_);
        const bf16_t* X = (const bf16_t*)(ws + WS_X); float* SSQ = (float*)(ws + WS_SSQ);
        const float* gate = (const float*)(ws + WS_MOD) + (size_t)l * NB * NMD + gidx * D;
        const int row0 = u.pm * BM + wr * 64 + fr, col0 = u.pn * BM + wc * 32 + 8 * fq, b = u.pm >> 4;
        f32x4 gv[2][2];
#pragma unroll
        for (int bj = 0; bj < 2; ++bj)
#pragma unroll
            for (int n = 0; n < 2; ++n) gv[bj][n] = *(const f32x4*)(gate + (size_t)b * NMD + col0 + bj * HALF + n * 4) * coef;
        u32x4 xin[2][2];
#define RES_LOAD(g_, buf) do { const size_t ro_ = (size_t)(row0 + ((g_) >> 2) * HALF + ((g_) & 3) * 16) * D + col0; \
            _Pragma("unroll") for (int bj = 0; bj < 2; ++bj) xin[buf][bj] = *(const u32x4*)(X + ro_ + bj * HALF); } while (0)
        RES_LOAD(0, 0);
#pragma unroll
        for (int g = 0; g < 8; ++g) { const int ai = g >> 2, m = g & 3, row = row0 + ai * HALF + m * 16; float ss = 0.f;
            if (g + 1 < 8) RES_LOAD(g + 1, (g + 1) & 1);
#pragma unroll
            for (int bj = 0; bj < 2; ++bj) { const u32x4 xi = xin[g & 1][bj];
                const f32x4 x0 = (f32x4){hlo(xi.x), hhi(xi.x), hlo(xi.y), hhi(xi.y)} + gv[bj][0] * acc[ai][bj][m][0], x1 = (f32x4){hlo(xi.z), hhi(xi.z), hlo(xi.w), hhi(xi.w)} + gv[bj][1] * acc[ai][bj][m][1];
                acc[ai][bj][m][0] = x0; acc[ai][bj][m][1] = x1;
                ss += ((x0[0] * x0[0] + x0[1] * x0[1]) + (x0[2] * x0[2] + x0[3] * x0[3])) + ((x1[0] * x1[0] + x1[1] * x1[1]) + (x1[2] * x1[2] + x1[3] * x1[3])); }
            ss += swz_xor<16>(ss); ss = sum_x32(ss);
            if (fq == 0) __hip_atomic_store((unsigned*)(SSQ + (size_t)row * 16 + u.pn * 4 + wc), __float_as_uint(ss), __ATOMIC_RELAXED, __HIP_MEMORY_SCOPE_AGENT); }
#undef RES_LOAD
        asm volatile("s_waitcnt vmcnt(0)" ::: "memory"); __syncthreads();
        if ((int)threadIdx.x == 0) { unsigned* c_ = cnt + u.pm * 32; (void)__hip_atomic_fetch_add(c_, 1u, __ATOMIC_RELAXED, __HIP_MEMORY_SCOPE_AGENT);
            unsigned sp_ = 0; while (__hip_atomic_load(c_, __ATOMIC_RELAXED, __HIP_MEMORY_SCOPE_AGENT) < (unsigned)(D / BM)) { __builtin_amdgcn_s_sleep(2); if (++sp_ > (1u << 17)) break; }
            __builtin_amdgcn_fence(__ATOMIC_ACQUIRE, "agent"); }
        __syncthreads();
        f32x4 Gv[2][2];
#pragma unroll
        for (int bj = 0; bj < 2; ++bj)
#pragma unroll
            for (int n = 0; n < 2; ++n) Gv[bj][n] = *(const f32x4*)(gfin + col0 + bj * HALF + n * 4);
#pragma unroll
        for (int g = 0; g < 8; ++g) { const int ai = g >> 2, m = g & 3, row = row0 + ai * HALF + m * 16;
            const f32x4 q = *(const f32x4*)(SSQ + (size_t)row * 16 + 4 * fq); float tot = (q[0] + q[1]) + (q[2] + q[3]); tot += swz_xor<16>(tot); tot = sum_x32(tot);
            const float rstd = 1.0f / sqrtf(tot * (1.f / D) + EPS);
#pragma unroll
            for (int bj = 0; bj < 2; ++bj) { float* o = out + (size_t)row * D + col0 + bj * HALF;
                *(f32x4*)o = acc[ai][bj][m][0] * rstd * Gv[bj][0]; *(f32x4*)(o + 4) = acc[ai][bj][m][1] * rstd * Gv[bj][1]; } }
    }
};
struct EpiMixIn {
    static constexpr bool PERM = true, AFTER_DRAIN = false;
    unsigned char* ws; int l;
    __device__ __forceinline__ void operator()(const f32x4 (&acc)[2][2][4][2], const Unit& u, int wr, int wc, int fr, int fq) const {
        bf16_t* O = (bf16_t*)(ws + WS_PROJ); const float* tabD = (const float*)(ws + WS_TABD); const float* tabR = (const float*)(ws + WS_TABR);
        const float* bias = (const float*)(ws + WS_BIAS) + (size_t)(3 * l + 1) * NB * (2 * F); const LAS float* rstd = (const LAS float*)((LAS unsigned char*)lds_raw + LDS_RSTD_OFF);
        const int row0 = u.pm * BM + wr * 64 + fr;
#pragma unroll
        for (int bj = 0; bj < 2; ++bj) {
            const int kb = 2 * u.pn + bj, col0 = kb * HALF + wc * 32 + 8 * fq;
            const LAS float* bp = (const LAS float*)((LAS unsigned char*)lds_raw + LDS_BIAS_OFF) + u.idx * BM + bj * HALF + wc * 32 + 8 * fq;
            const f32x4 b0 = *(const LAS f32x4*)bp, b1 = *(const LAS f32x4*)(bp + 4);
            if (kb < 6) {
                const float qs = (kb < 3) ? QSCALE : 1.f;
#pragma unroll
                for (int ai = 0; ai < 2; ++ai)
#pragma unroll
                    for (int m = 0; m < 4; ++m) { const int row = row0 + ai * HALF + m * 16; const float rs = rstd[u.idx * BM + ai * HALF + m * 16 + wr * 64 + fr];
                        f32x4 v0 = acc[ai][bj][m][0] * rs + b0, v1 = acc[ai][bj][m][1] * rs + b1;
                        if (fq == 0) { const f32x4 c = *(const f32x4*)(tabD + (size_t)row * 8), s = *(const f32x4*)(tabD + (size_t)row * 8 + 4); const f32x4 r0 = v0 * c - v1 * s, r1 = v1 * c + v0 * s; v0 = r0; v1 = r1; }
                        v0 = v0 * qs; v1 = v1 * qs;
                        u32x4 w; w.x = pk2(v0[0], v0[1]); w.y = pk2(v0[2], v0[3]); w.z = pk2(v1[0], v1[1]); w.w = pk2(v1[2], v1[3]);
                        *(u32x4*)(O + (size_t)row * NINP + col0) = w; }
            } else if (kb < 10) {
                const bool isk = (kb >= 8); const int i0 = 16 * (wc & 1) + 4 * fq; const float lg = lg2gamma(2 * (kb & 1) + (wc >> 1)) * (isk ? -1.f : 1.f);
#pragma unroll
                for (int ai = 0; ai < 2; ++ai)
#pragma unroll
                    for (int m = 0; m < 4; ++m) { const int row = row0 + ai * HALF + m * 16; const float rs = rstd[u.idx * BM + ai * HALF + m * 16 + wr * 64 + fr];
                        const f32x4 v0 = acc[ai][bj][m][0] * rs + b0, v1 = acc[ai][bj][m][1] * rs + b1;
                        const f32x4 c = *(const f32x4*)(tabR + (size_t)row * 64 + i0), s = *(const f32x4*)(tabR + (size_t)row * 64 + 32 + i0);
                        const float ks = __builtin_amdgcn_exp2f((float)(row & 63) * lg) * (isk ? 0.125f : 1.f);
                        const f32x4 r0 = (v0 * c - v1 * s) * ks, r1 = (v1 * c + v0 * s) * ks;
                        u32x4 w; w.x = pk2(r0[0], r0[1]); w.y = pk2(r0[2], r0[3]); w.z = pk2(r1[0], r1[1]); w.w = pk2(r1[2], r1[3]);
                        *(u32x4*)(O + (size_t)row * NINP + col0) = w; }
            } else {
#pragma unroll
                for (int ai = 0; ai < 2; ++ai)
#pragma unroll
                    for (int m = 0; m < 4; ++m) { const int row = row0 + ai * HALF + m * 16; const float rs = rstd[u.idx * BM + ai * HALF + m * 16 + wr * 64 + fr];
                        const f32x4 v0 = acc[ai][bj][m][0] * rs + b0, v1 = acc[ai][bj][m][1] * rs + b1;
                        u32x4 w; w.x = pk2(v0[0], v0[1]); w.y = pk2(v0[2], v0[3]); w.z = pk2(v1[0], v1[1]); w.w = pk2(v1[2], v1[3]);
                        *(u32x4*)(O + (size_t)row * NINP + col0) = w; }
            }
        }
    }
};

template <class Epi, class Sched, bool ALIGN_EPI = false, bool SP2 = false>
__device__ __forceinline__ void gemm_phase(PG8_LAS unsigned char* lds, const Gemm g, const Sched& S, const Epi& E) {
    int tid_ = threadIdx.x; asm volatile("" : "+v"(tid_));
    const int tid = tid_, wid = __builtin_amdgcn_readfirstlane(tid >> 6), lane = tid & 63, wr = wid >> 2, wc = wid & 3, fr = lane & 15, fq = lane >> 4;
    const int K = g.K, nt = K / BK, ldA = (g.tiled & 1) ? BK : K, ldB = (g.tiled & 2) ? BK : K;
    unsigned voffA[2], voffB[2];
#pragma unroll
    for (int i = 0; i < 2; ++i) { int R, C; stage_rc(tid * 16 + i * 8192, R, C); const int Rb = Epi::PERM ? ((R & ~31) + perm32(R & 31)) : R;
        voffA[i] = (unsigned)(R * ldA + C) * 2u; voffB[i] = (unsigned)(Rb * ldB + C) * 2u; }
    const size_t kstepA = (g.tiled & 1) ? (size_t)(BM * BK * 2) : (size_t)(BK * 2), kstepB = (g.tiled & 2) ? (size_t)(BM * BK * 2) : (size_t)(BK * 2);
    const size_t hstepA = (size_t)HALF * ldA * 2, hstepB = (size_t)HALF * ldB * 2;
    const size_t tstepA = (g.tiled & 1) ? (size_t)nt * (BM * BK * 2) : 2 * hstepA, tstepB = (g.tiled & 2) ? (size_t)nt * (BM * BK * 2) : 2 * hstepB;
    const unsigned ldsw = (unsigned)wid * 1024u;
    const int aoff = lds_byte(wr * 64 + fr, fq * 8), boff = lds_byte(wc * 32 + fr, fq * 8);
#define PG8_SA(b, h) (((b) * 2 + (h)) * HTB)
#define PG8_SB(b, h) ((4 + (b) * 2 + (h)) * HTB)
#define PG8_STAGE(bufoff, gbase, voff) do { _Pragma("unroll") for (int _i = 0; _i < 2; ++_i) \
        __builtin_amdgcn_global_load_lds((const unsigned*)((const char*)(gbase) + (voff)[_i]), (PG8_LAS unsigned*)(lds + (bufoff) + ldsw + _i * 8192), 16, 0, 0); } while (0)
#define PG8_LDA(dst, b, h) do { _Pragma("unroll") for (int m = 0; m < 4; ++m) _Pragma("unroll") for (int k = 0; k < 2; ++k) dst[m][k] = *(const PG8_LAS bf16x8*)(lds + PG8_SA(b, h) + aoff + m * 2048 + k * 1024); } while (0)
#define PG8_LDB(dst, b, h) do { _Pragma("unroll") for (int n = 0; n < 2; ++n) _Pragma("unroll") for (int k = 0; k < 2; ++k) dst[n][k] = *(const PG8_LAS bf16x8*)(lds + PG8_SB(b, h) + boff + n * 2048 + k * 1024); } while (0)
#define PG8_MMA(ai, bj, At, Bt) do { __builtin_amdgcn_s_setprio(1); _Pragma("unroll") for (int m = 0; m < 4; ++m) _Pragma("unroll") for (int n = 0; n < 2; ++n) _Pragma("unroll") for (int k = 0; k < 2; ++k) \
        acc[ai][bj][m][n] = __builtin_amdgcn_mfma_f32_16x16x32_bf16(Bt[n][k], At[m][k], acc[ai][bj][m][n], 0, 0, 0); __builtin_amdgcn_s_setprio(0); } while (0)
#define PG8_WAIT_V(n) asm volatile("s_waitcnt vmcnt(" #n ")" ::: "memory")
#define PG8_WAIT_L(n) asm volatile("s_waitcnt lgkmcnt(" #n ")" ::: "memory")
#define PG8_BAR __builtin_amdgcn_s_barrier()
#define PG8_SCHED __builtin_amdgcn_sched_barrier(0)
    Unit cur, nxt; int ui = 0;
#if PROBE_EPT
    if (tid == 0) ((volatile PG8_LAS unsigned long long*)((PG8_LAS unsigned char*)lds_raw + MISC_OFF + 160))[2] = __builtin_amdgcn_s_memrealtime();
#endif
    if (!S.next(0, cur)) return;
    f32x4 acc[2][2][4][2];
#pragma unroll
    for (int a = 0; a < 2; ++a)
#pragma unroll
        for (int b = 0; b < 2; ++b)
#pragma unroll
            for (int m = 0; m < 4; ++m)
#pragma unroll
                for (int n = 0; n < 2; ++n) acc[a][b][m][n] = (f32x4){0.f, 0.f, 0.f, 0.f};
    bf16x8 At[4][2], B0[2][2], B1[2][2];
    const char* cA = (const char*)g.A + (size_t)cur.pm * tstepA; const char* cB = (const char*)g.Bt + (size_t)cur.pn * tstepB;
    S.a_ready(cur);
    if constexpr (SP2) {
        PG8_STAGE(PG8_SB(0, 0), cB, voffB); PG8_STAGE(PG8_SB(0, 1), cB + hstepB, voffB); PG8_STAGE(PG8_SA(0, 0), cA, voffA); PG8_STAGE(PG8_SA(0, 1), cA + hstepA, voffA);
        if (wr == 1) PG8_BAR;
        PG8_WAIT_V(2); PG8_BAR;
        PG8_STAGE(PG8_SB(1, 0), cB + kstepB, voffB); PG8_STAGE(PG8_SA(1, 0), cA + kstepA, voffA); PG8_STAGE(PG8_SB(1, 1), cB + hstepB + kstepB, voffB);
        PG8_WAIT_V(6); PG8_BAR;
    } else {
        PG8_STAGE(PG8_SB(0, 0), cB, voffB); PG8_STAGE(PG8_SA(0, 0), cA, voffA); PG8_STAGE(PG8_SB(0, 1), cB + hstepB, voffB); PG8_STAGE(PG8_SA(0, 1), cA + hstepA, voffA);
        if (wr == 1) PG8_BAR;
        PG8_WAIT_V(4); PG8_BAR;
        PG8_STAGE(PG8_SB(1, 0), cB + kstepB, voffB); PG8_STAGE(PG8_SA(1, 0), cA + kstepA, voffA); PG8_STAGE(PG8_SB(1, 1), cB + hstepB + kstepB, voffB);
        PG8_WAIT_V(6); PG8_BAR;
    }
    for (;;) {
        const bool has_next = S.next(ui + 1, nxt);
        const char* nA = has_next ? (const char*)g.A + (size_t)nxt.pm * tstepA : cA; const char* nB = has_next ? (const char*)g.Bt + (size_t)nxt.pn * tstepB : cB;
        for (int t = 0; t < nt; t += 2) {
            const bool last = (t == nt - 2);
            const char* a1 = cA + (size_t)(t + 1) * kstepA;
            const char* a2 = last ? nA : cA + (size_t)(t + 2) * kstepA; const char* b2 = last ? nB : cB + (size_t)(t + 2) * kstepB;
            const char* a3 = a2 + kstepA; const char* b3 = b2 + kstepB;
            if (last && has_next) S.a_ready(nxt);
            if constexpr (SP2) {
            PG8_LDB(B0, 0, 0); PG8_LDB(B1, 0, 1); PG8_SCHED; PG8_LDA(At, 0, 0); PG8_STAGE(PG8_SA(1, 1), a1 + hstepA, voffA);
            PG8_WAIT_V(8); PG8_WAIT_L(0); PG8_BAR; PG8_MMA(0, 0, At, B0); PG8_MMA(0, 1, At, B1); PG8_BAR; PG8_SCHED;
            PG8_LDA(At, 0, 1); PG8_STAGE(PG8_SB(0, 0), b2, voffB); PG8_STAGE(PG8_SB(0, 1), b2 + hstepB, voffB); PG8_STAGE(PG8_SA(0, 0), a2, voffA);
            PG8_WAIT_V(8); PG8_WAIT_L(0); PG8_BAR; PG8_MMA(1, 0, At, B0); PG8_MMA(1, 1, At, B1); PG8_BAR; PG8_SCHED;
            PG8_LDB(B0, 1, 0); PG8_LDB(B1, 1, 1); PG8_SCHED; PG8_LDA(At, 1, 0); PG8_STAGE(PG8_SA(0, 1), a2 + hstepA, voffA);
            PG8_WAIT_V(8); PG8_WAIT_L(0); PG8_BAR; PG8_MMA(0, 0, At, B0); PG8_MMA(0, 1, At, B1); PG8_BAR; PG8_SCHED;
            PG8_LDA(At, 1, 1); PG8_STAGE(PG8_SB(1, 0), b3, voffB); PG8_STAGE(PG8_SB(1, 1), b3 + hstepB, voffB); PG8_STAGE(PG8_SA(1, 0), a3, voffA);
            PG8_WAIT_V(8); PG8_WAIT_L(0); PG8_BAR; PG8_MMA(1, 0, At, B0); PG8_MMA(1, 1, At, B1); PG8_BAR; PG8_SCHED;
            } else {
            PG8_LDB(B0, 0, 0); PG8_SCHED; PG8_LDA(At, 0, 0); PG8_STAGE(PG8_SA(1, 1), a1 + hstepA, voffA);
            PG8_WAIT_L(8); PG8_BAR; PG8_WAIT_L(0); PG8_MMA(0, 0, At, B0); PG8_BAR; PG8_SCHED;
            PG8_LDB(B1, 0, 1); PG8_STAGE(PG8_SB(0, 0), b2, voffB);
            PG8_BAR; PG8_WAIT_L(0); PG8_MMA(0, 1, At, B1); PG8_BAR;
            PG8_LDA(At, 0, 1); PG8_STAGE(PG8_SA(0, 0), a2, voffA);
            PG8_BAR; PG8_WAIT_L(0); PG8_MMA(1, 0, At, B0); PG8_BAR; PG8_SCHED;
            PG8_STAGE(PG8_SB(0, 1), b2 + hstepB, voffB);
            PG8_WAIT_V(6); PG8_BAR; PG8_MMA(1, 1, At, B1); PG8_BAR;
            PG8_LDB(B0, 1, 0); PG8_SCHED; PG8_LDA(At, 1, 0); PG8_STAGE(PG8_SA(0, 1), a2 + hstepA, voffA);
            PG8_WAIT_L(8); PG8_BAR; PG8_WAIT_L(0); PG8_MMA(0, 0, At, B0); PG8_BAR; PG8_SCHED;
            PG8_LDB(B1, 1, 1); PG8_STAGE(PG8_SB(1, 0), b3, voffB);
            PG8_BAR; PG8_WAIT_L(0); PG8_MMA(0, 1, At, B1); PG8_BAR;
            PG8_LDA(At, 1, 1); PG8_STAGE(PG8_SA(1, 0), a3, voffA);
            PG8_BAR; PG8_WAIT_L(0); PG8_MMA(1, 0, At, B0); PG8_BAR; PG8_SCHED;
            PG8_STAGE(PG8_SB(1, 1), b3 + hstepB, voffB);
            PG8_WAIT_V(6); PG8_BAR; PG8_MMA(1, 1, At, B1); PG8_BAR;
            }
        }
        if constexpr (ALIGN_EPI) { if (wr == 0) PG8_BAR; }
#if PROBE_EPT
        if (tid == 0) ((volatile PG8_LAS unsigned long long*)((PG8_LAS unsigned char*)lds_raw + MISC_OFF + 160))[0] = __builtin_amdgcn_s_memrealtime();
#endif
        if constexpr (!Epi::AFTER_DRAIN) { E(acc, cur, wr, wc, fr, fq);
#if PROBE_EPT
            asm volatile("s_waitcnt vmcnt(0)" ::: "memory");
            if (tid == 0) ((volatile PG8_LAS unsigned long long*)((PG8_LAS unsigned char*)lds_raw + MISC_OFF + 160))[1] = __builtin_amdgcn_s_memrealtime();
#endif
#if PROBE_EPI2
            if constexpr (Epi::PERM) { asm volatile("" ::: "memory"); E(acc, cur, wr, wc, fr, fq); }
#elif PROBE_EPIR2
            if constexpr (!Epi::PERM) { asm volatile("s_waitcnt vmcnt(0)" ::: "memory"); Epi E2 = E; E2.coef = 0.f; E2(acc, cur, wr, wc, fr, fq); }
#endif
            S.done(cur); }
        if (!has_next) break;
#pragma unroll
        for (int a = 0; a < 2; ++a)
#pragma unroll
            for (int b = 0; b < 2; ++b)
#pragma unroll
                for (int m = 0; m < 4; ++m)
#pragma unroll
                    for (int n = 0; n < 2; ++n) acc[a][b][m][n] = (f32x4){0.f, 0.f, 0.f, 0.f};
        cur = nxt; cA = nA; cB = nB; ++ui;
        if constexpr (ALIGN_EPI) { if (wr == 1) PG8_BAR; }
    }
    PG8_WAIT_V(0);
    if constexpr (!ALIGN_EPI) { if (wr == 0) PG8_BAR; }
    PG8_BAR;
#undef PG8_SA
#undef PG8_SB
#undef PG8_STAGE
#undef PG8_LDA
#undef PG8_LDB
#undef PG8_MMA
#undef PG8_WAIT_V
#undef PG8_WAIT_L
#undef PG8_BAR
#undef PG8_SCHED
}
}

#define XB_TMO      128
#define XB_XCNT(j)  (256  + 64 * (j))
#define XB_XSUB(j)  (1280 + 64 * (j))
#define XB_XGEN(j)  (2304 + 64 * (j))
#define XB_TOP      3328
#define XB_TOPGEN   3392
#define XCD_BAR_WORDS 3456
#define XB_SPIN_CAP (1u << 18)
__device__ __forceinline__ unsigned xb_ld(unsigned* p)              { return __hip_atomic_load(p, __ATOMIC_RELAXED, __HIP_MEMORY_SCOPE_AGENT); }
__device__ __forceinline__ unsigned xb_add(unsigned* p, unsigned v) { return __hip_atomic_fetch_add(p, v, __ATOMIC_RELAXED, __HIP_MEMORY_SCOPE_AGENT); }
__device__ __forceinline__ unsigned xb_xcc_id() { return (unsigned)__builtin_amdgcn_s_getreg((3 << 11) | 20) & 0xFu; }
#define XB_SPIN(cond, bar) do { unsigned _sp = 0; while (cond) { __builtin_amdgcn_s_sleep(1); \
    if ((++_sp & 255u) == 0u) { if (xb_ld(&(bar)[XB_TMO])) break; if (_sp > XB_SPIN_CAP) { atomicAdd(&(bar)[XB_TMO], 1u); break; } } } } while (0)
struct XcdBarrier { unsigned* bar; unsigned x; volatile LAS unsigned* st; };
__device__ __forceinline__ XcdBarrier xcd_barrier_post(unsigned* bar, volatile LAS unsigned* st) {
    XcdBarrier b; b.bar = bar; b.x = xb_xcc_id(); b.st = st;
    if (threadIdx.x == 0) (void)xb_add(&bar[XB_XCNT(b.x)], 1u);
    return b;
}
__device__ __forceinline__ void xcd_barrier_complete(unsigned* bar, unsigned x, unsigned& nloc, unsigned& nx) {
    const unsigned G = gridDim.x * gridDim.y * gridDim.z;
    unsigned sum, cnt, mine, sp = 0u;
    for (;;) {
        sum = 0u; cnt = 0u; mine = 0u;
#pragma unroll
        for (unsigned j = 0; j < 16; ++j) { const unsigned c = xb_ld(&bar[XB_XCNT(j)]); sum += c; cnt += (c > 0u) ? 1u : 0u; mine = (j == x) ? c : mine; }
        if (sum == G) break;
        __builtin_amdgcn_s_sleep(1);
        if ((++sp & 255u) == 0u) { if (xb_ld(&bar[XB_TMO])) break; if (sp > XB_SPIN_CAP) { atomicAdd(&bar[XB_TMO], 1u); break; } }
    }
    nloc = mine > 0u ? mine : 1u; nx = cnt > 0u ? cnt : 1u;
}
__device__ __forceinline__ void xcd_barrier(const XcdBarrier& b) {
    asm volatile("s_waitcnt vmcnt(0)" ::: "memory");
    __syncthreads();
    if (threadIdx.x == 0) {
        unsigned* bar = b.bar; asm volatile("" : "+s"(bar));
        __builtin_amdgcn_s_waitcnt(0);
        unsigned nloc = b.st[0], nx = b.st[1];
        if (nloc == 0u) { xcd_barrier_complete(bar, b.x, nloc, nx); b.st[0] = nloc; b.st[1] = nx; }
        const unsigned old = xb_add(&bar[XB_XSUB(b.x)], 1u);
        const unsigned gen = old / nloc;
        if (old + 1u == (gen + 1u) * nloc) {
            __builtin_amdgcn_fence(__ATOMIC_RELEASE, "agent");
            asm volatile("s_waitcnt vmcnt(0)" ::: "memory");
            const unsigned og = xb_add(&bar[XB_TOP], 1u);
            const unsigned tg = og / nx;
            if (og + 1u == (tg + 1u) * nx) xb_add(&bar[XB_TOPGEN], 1u);
            else XB_SPIN(xb_ld(&bar[XB_TOPGEN]) == tg, bar);
            __builtin_amdgcn_fence(__ATOMIC_ACQUIRE, "agent");
            xb_add(&bar[XB_XGEN(b.x)], 1u);
            asm volatile("s_waitcnt vmcnt(0)" ::: "memory");
        } else {
            XB_SPIN(xb_ld(&bar[XB_XGEN(b.x)]) == gen, bar);
            __builtin_amdgcn_fence(__ATOMIC_ACQUIRE, "agent");
            asm volatile("s_waitcnt vmcnt(0)" ::: "memory");
        }
    }
    __syncthreads();
}

namespace mix {
typedef float f32x16 __attribute__((ext_vector_type(16)));
typedef short s16x4 __attribute__((ext_vector_type(4)));
typedef short v4i16_t __attribute__((ext_vector_type(4)));
typedef LAS const char* lds_cptr;
constexpr int SLOTB = 8192, LDS_K = 0, LDS_V = 2 * SLOTB, LDS_QW = 4 * SLOTB, LDS_QF = 4 * SLOTB + 1024;
constexpr int N_DIFF = 24 * 16, N_RET = 16, N_ITEMS = N_DIFF + N_RET;
__device__ __forceinline__ int crow(int r, int hi) { return (r & 3) + 8 * (r >> 2) + 4 * hi; }
__device__ __forceinline__ int imax(int a, int b) { return a > b ? a : b; }
__device__ __forceinline__ void glds16(const void* g, unsigned lds_base) { unsigned sv; asm volatile("s_mov_b32 %0, m0\n\ts_mov_b32 m0, %2\n\ts_nop 0\n\tglobal_load_lds_dwordx4 %1, off\n\ts_mov_b32 m0, %0" : "=&s"(sv) : "v"(g), "s"(lds_base) : "memory"); }
__device__ __forceinline__ s16x4 vtr(lds_cptr p) { return __builtin_bit_cast(s16x4, __builtin_amdgcn_ds_read_tr16_b64_v4i16((LAS v4i16_t*)p)); }
#define MFMA32(a, b, c) __builtin_amdgcn_mfma_f32_32x32x16_bf16(a, b, c, 0, 0, 0)
#define MFMA16(a, b, c) __builtin_amdgcn_mfma_f32_16x16x32_bf16(a, b, c, 0, 0, 0)

struct ItemTab { unsigned short v[N_ITEMS]; };
constexpr ItemTab make_items() {
    ItemTab t{}; int n = 0;
    for (int bh = 0; bh < 16; ++bh) t.v[n++] = (unsigned short)(0x8000 | bh);
    for (int qb = 15; qb >= 0; --qb) for (int bh = 0; bh < 24; ++bh) t.v[n++] = (unsigned short)((qb << 8) | bh);
    return t;
}
__device__ const ItemTab g_items = make_items();

template <int MODE, int VAR = 0>
__device__ __forceinline__ void attn_unit(int b, int h, int qb, const bf16_t* PROJ, bf16_t* Y, LAS unsigned char* lds, float lam, float lam_init, const float* subg) {
    int tid_ = threadIdx.x; asm volatile("" : "+v"(tid_));
    const int tid = tid_, lane = tid & 63, r32 = lane & 31, hi = lane >> 5; const int wid = __builtin_amdgcn_readfirstlane(tid >> 6);
    constexpr int CQ = MODE == 0 ? C_DQ : C_TQ, CK = MODE == 0 ? C_DK : C_TK, CV = MODE == 0 ? C_DV : C_TV;
    const size_t rowbase = (size_t)b * T; const int q0 = qb * 256, NT = 4 * (qb + 1), my_last = 4 * qb + (wid >> 1);
    const bf16_t* Qw = PROJ + (rowbase + q0 + wid * 32) * NINP + CQ + 64 * h;
    const bf16_t* ksrc = PROJ + (rowbase + lane) * NINP + CK + 64 * h + wid * 8;
    const bf16_t* vsrc = PROJ + (rowbase + 16 * (wid & 3) + (lane >> 2)) * NINP + CV + 64 * h + (wid >> 2) * 32 + (lane & 3) * 8;
    const unsigned lds0 = (unsigned)(uintptr_t)lds;
    const unsigned kdst = lds0 + LDS_K + wid * 1024, vdst = lds0 + LDS_V + wid * 1024;
    const lds_cptr kp0 = (lds_cptr)lds + LDS_K + hi * 1024 + r32 * 16;
    const lds_cptr vp0 = (lds_cptr)lds + LDS_V + ((lane >> 4) & 1) * 32 + (lane & 3) * 8 + (4 * hi + ((lane & 15) >> 2)) * 64;
#define DMA_K(t, slot) glds16(ksrc + (size_t)(t) * 64 * NINP, (unsigned)__builtin_amdgcn_readfirstlane(kdst + (slot)))
#define DMA_V(t, slot) glds16(vsrc + (size_t)(t) * 64 * NINP, (unsigned)__builtin_amdgcn_readfirstlane(vdst + (slot)))
    DMA_K(0, 0); DMA_V(0, 0);
#pragma unroll
    for (int p = 0; p < 4; ++p) glds16(Qw + (size_t)(lane & 31) * NINP + (2 * p + (lane >> 5)) * 8, (unsigned)__builtin_amdgcn_readfirstlane(lds0 + LDS_QF + wid * 4096 + p * 1024));
    const lds_cptr qp0 = (lds_cptr)lds + LDS_QF + wid * 4096 + hi * 512 + r32 * 16;
    f32x16 oA[2], oB[2];
    oA[0] = f32x16{}; oA[1] = f32x16{}; oB[0] = f32x16{}; oB[1] = f32x16{};
    float mref = 0.f, lA = 0.f, lB = 0.f; f32x16 nm = f32x16{};
    const int qabs = q0 + wid * 32 + r32;
    const float lg2 = lg2gamma(h);
    bf16x8 qr[4];
    for (int t = 0; t < NT; ++t) {
        if constexpr ((VAR & 18) == 0) asm volatile("s_waitcnt vmcnt(0) lgkmcnt(0)\n\ts_barrier" ::: "memory");
        else if constexpr ((VAR & 18) == 2) asm volatile("s_waitcnt vmcnt(0) lgkmcnt(0)" ::: "memory");
        else if constexpr ((VAR & 18) == 16) asm volatile("s_waitcnt lgkmcnt(0)\n\ts_barrier" ::: "memory");
        else asm volatile("s_waitcnt lgkmcnt(0)" ::: "memory");
        const int sl = (t & 1) * SLOTB;
        if (t + 1 < NT) { DMA_K(t + 1, SLOTB - sl); DMA_V(t + 1, SLOTB - sl); }
        if (t <= my_last) {
            bf16x8 kf[8], vf[8];
            if (t == 0) {
#pragma unroll
                for (int d0 = 0; d0 < 4; ++d0) qr[d0] = *(const LAS bf16x8*)(qp0 + d0 * 1024); }
#pragma unroll
            for (int d0 = 0; d0 < 4; ++d0) { kf[2 * d0] = *(const LAS bf16x8*)(kp0 + sl + d0 * 2048); kf[2 * d0 + 1] = *(const LAS bf16x8*)(kp0 + sl + d0 * 2048 + 512); }
#define LOAD_VF() do { _Pragma("unroll") for (int i = 0; i < 8; ++i) { const s16x4 lo = vtr(vp0 + sl + (i >> 2) * 4096 + (i & 3) * 1024), hh = vtr(vp0 + sl + (i >> 2) * 4096 + (i & 3) * 1024 + 512); \
                vf[i] = (bf16x8){lo[0], lo[1], lo[2], lo[3], hh[0], hh[1], hh[2], hh[3]}; } } while (0)
            const bool diag = (t == my_last);
            const int kv0 = 64 * t + 4 * hi;
            const f32x16 z16 = f32x16{};
            if constexpr (MODE == 0) {
                f32x16 paA, pbA, paB, pbB;
                if constexpr (VAR & 8) { paA = nm; pbA = nm; paB = nm; pbB = nm; asm volatile("" :: "v"(kf[0]), "v"(kf[1]), "v"(kf[2]), "v"(kf[3]), "v"(kf[4]), "v"(kf[5]), "v"(kf[6]), "v"(kf[7]), "v"(qr[0]), "v"(qr[1]), "v"(qr[2]), "v"(qr[3])); }
                else {
                paA = MFMA32(kf[0], qr[0], nm); paA = MFMA32(kf[2], qr[1], paA);
                pbA = MFMA32(kf[1], qr[0], nm); pbA = MFMA32(kf[3], qr[1], pbA);
                paB = MFMA32(kf[4], qr[2], nm); paB = MFMA32(kf[6], qr[3], paB);
                pbB = MFMA32(kf[5], qr[2], nm); pbB = MFMA32(kf[7], qr[3], pbB); }
                if ((t & 7) == 0) {
                int ti = imax(imax(__float_as_int(paA[0]), __float_as_int(pbA[0])), imax(__float_as_int(paB[0]), __float_as_int(pbB[0])));
#pragma unroll
                for (int r = 1; r < 16; ++r) ti = imax(imax(ti, imax(__float_as_int(paA[r]), __float_as_int(pbA[r]))), imax(__float_as_int(paB[r]), __float_as_int(pbB[r])));
                ti = imax_x32(ti);
                if (t == 0 || __any(ti > 0x41000000)) {
                    const float tmf = __int_as_float(ti); const float dl = (t == 0) ? tmf : fmaxf(tmf, 0.f); mref += dl;
#pragma unroll
                    for (int r = 0; r < 16; ++r) { paA[r] -= dl; pbA[r] -= dl; paB[r] -= dl; pbB[r] -= dl; nm[r] = -mref; }
                    if (t > 0) { const float f = __builtin_amdgcn_exp2f(-dl); lA *= f; lB *= f; oA[0] = oA[0] * f; oA[1] = oA[1] * f; oB[0] = oB[0] * f; oB[1] = oB[1] * f; } }
                }
                if (diag) {
#pragma unroll
                    for (int r = 0; r < 16; ++r) { const int kv = kv0 + (r & 3) + 8 * (r >> 2); if (kv > qabs) { paA[r] = -1e30f; paB[r] = -1e30f; } if (kv + 32 > qabs) { pbA[r] = -1e30f; pbB[r] = -1e30f; } } }
#define EXP_PACK(pa, pb, L_, pf) do { \
                float rs0 = 0.f, rs1 = 0.f; \
                  \
                if constexpr (!(VAR & 1)) { _Pragma("unroll") for (int r = 0; r < 16; ++r) { pa[r] = __builtin_amdgcn_exp2f(pa[r]); pb[r] = __builtin_amdgcn_exp2f(pb[r]); rs0 += pa[r]; asm("" : "+v"(rs0)); rs1 += pb[r]; asm("" : "+v"(rs1)); } } \
                L_ += rs0 + rs1; \
                PROBE_EXTRA_EXP(pa, pb); \
                _Pragma("unroll") for (int s = 0; s < 2; ++s) { \
                    u32x4 w0, w1; \
                    w0.x = pk2(pa[8 * s + 0], pa[8 * s + 1]); w0.y = pk2(pa[8 * s + 2], pa[8 * s + 3]); w0.z = pk2(pa[8 * s + 4], pa[8 * s + 5]); w0.w = pk2(pa[8 * s + 6], pa[8 * s + 7]); \
                    w1.x = pk2(pb[8 * s + 0], pb[8 * s + 1]); w1.y = pk2(pb[8 * s + 2], pb[8 * s + 3]); w1.z = pk2(pb[8 * s + 4], pb[8 * s + 5]); w1.w = pk2(pb[8 * s + 6], pb[8 * s + 7]); \
                    pf[s] = __builtin_bit_cast(bf16x8, w0); pf[2 + s] = __builtin_bit_cast(bf16x8, w1); } } while (0)
#define PV_ACC(O, pf) do { if constexpr (VAR & 4) { asm volatile("" :: "v"(pf[0]), "v"(pf[1]), "v"(pf[2]), "v"(pf[3]), "v"(vf[0]), "v"(vf[1]), "v"(vf[2]), "v"(vf[3]), "v"(vf[4]), "v"(vf[5]), "v"(vf[6]), "v"(vf[7])); } else { _Pragma("unroll") for (int dh = 0; dh < 2; ++dh) _Pragma("unroll") for (int s = 0; s < 4; ++s) O[dh] = MFMA32(vf[4 * dh + s], pf[s], O[dh]); } } while (0)
                __builtin_amdgcn_sched_barrier(0);
                LOAD_VF();
                bf16x8 pfA[4], pfB[4];
                EXP_PACK(paA, pbA, lA, pfA);
                __builtin_amdgcn_sched_barrier(0);
                PV_ACC(oA, pfA);
                EXP_PACK(paB, pbB, lB, pfB);
#pragma unroll
                for (int i = 0; i < 8; ++i) { __builtin_amdgcn_sched_group_barrier(0x008, 1, 0); __builtin_amdgcn_sched_group_barrier(0x402, 10, 0); }
                __builtin_amdgcn_sched_barrier(0);
                PV_ACC(oB, pfB);
#undef EXP_PACK
#undef PV_ACC
            } else {
                f32x16 pa = MFMA32(kf[0], qr[0], z16), pb = MFMA32(kf[1], qr[0], z16);
#pragma unroll
                for (int d0 = 1; d0 < 4; ++d0) { pa = MFMA32(kf[2 * d0], qr[d0], pa); pb = MFMA32(kf[2 * d0 + 1], qr[d0], pb); }
                const int qt = (q0 + wid * 32) >> 6;
                const float tf = __builtin_amdgcn_exp2f(64.0f * (float)(qt - t) * lg2);
#pragma unroll
                for (int r = 0; r < 16; ++r) { pa[r] *= tf; pb[r] *= tf; }
                if (diag) {
#pragma unroll
                    for (int r = 0; r < 16; ++r) { const int kv = kv0 + (r & 3) + 8 * (r >> 2); if (kv > qabs) pa[r] = 0.f; if (kv + 32 > qabs) pb[r] = 0.f; } }
                LOAD_VF();
                bf16x8 pf[4];
#pragma unroll
                for (int s = 0; s < 2; ++s) {
                    u32x4 w0, w1;
                    w0.x = pk2(pa[8 * s + 0], pa[8 * s + 1]); w0.y = pk2(pa[8 * s + 2], pa[8 * s + 3]); w0.z = pk2(pa[8 * s + 4], pa[8 * s + 5]); w0.w = pk2(pa[8 * s + 6], pa[8 * s + 7]);
                    w1.x = pk2(pb[8 * s + 0], pb[8 * s + 1]); w1.y = pk2(pb[8 * s + 2], pb[8 * s + 3]); w1.z = pk2(pb[8 * s + 4], pb[8 * s + 5]); w1.w = pk2(pb[8 * s + 6], pb[8 * s + 7]);
                    pf[s] = __builtin_bit_cast(bf16x8, w0); pf[2 + s] = __builtin_bit_cast(bf16x8, w1); }
#pragma unroll
                for (int dh = 0; dh < 2; ++dh)
#pragma unroll
                    for (int s = 0; s < 4; ++s) oA[dh] = MFMA32(vf[4 * dh + s], pf[s], oA[dh]);
            }
        }
    }
#undef DMA_K
#undef DMA_V
#undef LOAD_VF
    const size_t mrow = rowbase + qabs;
    if constexpr (MODE == 0) {
        lA = sum_x32(lA); lB = sum_x32(lB);
        const float rA = 1.0f / lA, rB = lam / lB;
        float ss = 0.f;
#pragma unroll
        for (int dh = 0; dh < 2; ++dh)
#pragma unroll
            for (int r = 0; r < 16; ++r) { const float v = oA[dh][r] * rA - oB[dh][r] * rB; oA[dh][r] = v; ss += v * v; }
        ss = sum_x32(ss);
        float li_ = lam_init; asm volatile("" : "+v"(li_));
        const float rn = (1.0f / sqrtf(ss * (1.f / 64.f) + EPS)) * (1.0f - li_);
#pragma unroll
        for (int dh = 0; dh < 2; ++dh)
#pragma unroll
            for (int g = 0; g < 4; ++g) { const int d = 32 * dh + 8 * g + 4 * hi; const f32x4 sg = *(const f32x4*)(subg + d);
                u32x2 w; w.x = pk2(oA[dh][4 * g] * rn * sg[0], oA[dh][4 * g + 1] * rn * sg[1]); w.y = pk2(oA[dh][4 * g + 2] * rn * sg[2], oA[dh][4 * g + 3] * rn * sg[3]);
                *(u32x2*)(Y + mrow * D + RW + 64 * h + d) = w; }
    } else {
        float ss = 0.f;
#pragma unroll
        for (int dh = 0; dh < 2; ++dh)
#pragma unroll
            for (int r = 0; r < 16; ++r) ss += oA[dh][r] * oA[dh][r];
        ss = sum_x32(ss);
        const float rn = 1.0f / sqrtf(ss * (1.f / 64.f) + EPS);
#pragma unroll
        for (int dh = 0; dh < 2; ++dh)
#pragma unroll
            for (int g = 0; g < 4; ++g) { const int d = 32 * dh + 8 * g + 4 * hi; const u32x2 tg = *(const u32x2*)(PROJ + mrow * NINP + C_TG + 64 * h + d);
                u32x2 w; w.x = pk2(siluf_(bflo(tg.x)) * oA[dh][4 * g] * rn, siluf_(bfhi(tg.x)) * oA[dh][4 * g + 1] * rn); w.y = pk2(siluf_(bflo(tg.y)) * oA[dh][4 * g + 2] * rn, siluf_(bfhi(tg.y)) * oA[dh][4 * g + 3] * rn);
                *(u32x2*)(Y + mrow * D + 768 + 64 * h + d) = w; }
    }
}

namespace rseq { constexpr int SLOT = 40960, KB_ = 0, KT_ = 8192, VT_ = 16384, QB_ = 24576, TG_ = 32768, RS_ = 139264, RSB = 8192; }
__device__ __forceinline__ void ret_seq(int b, int h, const bf16_t* PROJ, bf16_t* Y, LAS unsigned char* lds) {
    using namespace rseq;
    int tid_ = threadIdx.x; asm volatile("" : "+v"(tid_));
    const int tid = tid_, lane = tid & 63, r32 = lane & 31, hi = lane >> 5; const int wid = __builtin_amdgcn_readfirstlane(tid >> 6);
    const size_t rowbase = (size_t)b * T;
    const unsigned lds0 = (unsigned)(uintptr_t)lds;
    const bf16_t* kb_src = PROJ + (rowbase + lane) * NINP + C_TK + 64 * h + wid * 8;
    const bf16_t* qb_src = PROJ + (rowbase + lane) * NINP + C_TQ + 64 * h + wid * 8;
    const size_t tr_off = (size_t)(16 * (wid & 3) + (lane >> 2)) * NINP + (wid >> 2) * 32 + (lane & 3) * 8;
    const bf16_t* kt_src = PROJ + rowbase * NINP + C_TK + 64 * h + tr_off;
    const bf16_t* vt_src = PROJ + rowbase * NINP + C_TV + 64 * h + tr_off;
    const bf16_t* tg_src = PROJ + (rowbase + 8 * wid + (lane >> 3)) * NINP + C_TG + 64 * h + (lane & 7) * 8;
#define RS_DMA(blk, slot_) do { const size_t go_ = (size_t)(blk) * 64 * NINP; const unsigned d_ = lds0 + (slot_) * SLOT + wid * 1024; \
        glds16(kb_src + go_, (unsigned)__builtin_amdgcn_readfirstlane(d_ + KB_)); glds16(kt_src + go_, (unsigned)__builtin_amdgcn_readfirstlane(d_ + KT_)); \
        glds16(vt_src + go_, (unsigned)__builtin_amdgcn_readfirstlane(d_ + VT_)); glds16(qb_src + go_, (unsigned)__builtin_amdgcn_readfirstlane(d_ + QB_)); \
        glds16(tg_src + go_, (unsigned)__builtin_amdgcn_readfirstlane(d_ + TG_)); } while (0)
    RS_DMA(0, 0); RS_DMA(1, 1);
    { unsigned z = 0u; asm volatile("" : "+v"(z)); for (int i = tid; i < RSB / 16; i += 512) ((LAS u32x4*)(lds + RS_))[i] = (u32x4){z, z, z, z}; }
    const int qh = wid & 1;
    const int dvh = (wid >> 1) & 1, dkh = wid & 1;
    f32x16 Rq = f32x16{};
    const float g64 = __builtin_amdgcn_exp2f(64.0f * lg2gamma(h));
    const lds_cptr trb = (lds_cptr)lds + ((lane >> 4) & 1) * 32 + (lane & 3) * 8 + (4 * hi + ((lane & 15) >> 2)) * 64;
    for (int i = 0; i < T / 64; ++i) {
        if (i + 1 < T / 64) { if (wid < 2 && i > 0) asm volatile("s_waitcnt vmcnt(13) lgkmcnt(0)\n\ts_barrier" ::: "memory"); else asm volatile("s_waitcnt vmcnt(5) lgkmcnt(0)\n\ts_barrier" ::: "memory"); }
        else asm volatile("s_waitcnt vmcnt(0) lgkmcnt(0)\n\ts_barrier" ::: "memory");
        const int sl = (i % 3) * SLOT, rb = (i & 1) * RSB;
        if (i + 2 < T / 64) RS_DMA(i + 2, (i + 2) % 3);
        if (wid < 2) {
            bf16x8 kf[8], qr[4];
#pragma unroll
            for (int d0 = 0; d0 < 4; ++d0) { qr[d0] = *(const LAS bf16x8*)((lds_cptr)lds + sl + QB_ + (2 * d0 + hi) * 1024 + (32 * qh + r32) * 16);
                kf[2 * d0] = *(const LAS bf16x8*)((lds_cptr)lds + sl + KB_ + (2 * d0 + hi) * 1024 + r32 * 16); kf[2 * d0 + 1] = *(const LAS bf16x8*)((lds_cptr)lds + sl + KB_ + (2 * d0 + hi) * 1024 + 512 + r32 * 16); }
            const f32x16 z16 = f32x16{};
            f32x16 pa = MFMA32(kf[0], qr[0], z16), pb = z16;
#pragma unroll
            for (int d0 = 1; d0 < 4; ++d0) pa = MFMA32(kf[2 * d0], qr[d0], pa);
            if (qh) {
#pragma unroll
                for (int d0 = 0; d0 < 4; ++d0) pb = MFMA32(kf[2 * d0 + 1], qr[d0], pb); }
#pragma unroll
            for (int r = 0; r < 16; ++r) { const int kv = (r & 3) + 8 * (r >> 2) + 4 * hi; const bool dead = kv > r32;
                pa[r] = (dead && qh == 0) ? 0.f : pa[r]; pb[r] = (dead && qh != 0) ? 0.f : pb[r]; }
            bf16x8 pf[4];
#pragma unroll
            for (int s = 0; s < 2; ++s) { u32x4 w0, w1;
                w0.x = pk2(pa[8 * s + 0], pa[8 * s + 1]); w0.y = pk2(pa[8 * s + 2], pa[8 * s + 3]); w0.z = pk2(pa[8 * s + 4], pa[8 * s + 5]); w0.w = pk2(pa[8 * s + 6], pa[8 * s + 7]);
                w1.x = pk2(pb[8 * s + 0], pb[8 * s + 1]); w1.y = pk2(pb[8 * s + 2], pb[8 * s + 3]); w1.z = pk2(pb[8 * s + 4], pb[8 * s + 5]); w1.w = pk2(pb[8 * s + 6], pb[8 * s + 7]);
                pf[s] = __builtin_bit_cast(bf16x8, w0); pf[2 + s] = __builtin_bit_cast(bf16x8, w1); }
            f32x16 o[2]; o[0] = z16; o[1] = z16;
            bf16x8 rfv[2][4], vfv[2][4];
#pragma unroll
            for (int dh = 0; dh < 2; ++dh)
#pragma unroll
                for (int s = 0; s < 4; ++s) { rfv[dh][s] = *(const LAS bf16x8*)((lds_cptr)lds + RS_ + rb + (2 * s + hi) * 1024 + (32 * dh + r32) * 16);
                    if (s < 2 || qh) { const s16x4 lo = vtr(trb + sl + VT_ + dh * 4096 + s * 1024), hh = vtr(trb + sl + VT_ + dh * 4096 + s * 1024 + 512); vfv[dh][s] = (bf16x8){lo[0], lo[1], lo[2], lo[3], hh[0], hh[1], hh[2], hh[3]}; }
                    else vfv[dh][s] = rfv[dh][s]; }
#pragma unroll
            for (int s = 0; s < 4; ++s)
#pragma unroll
                for (int dh = 0; dh < 2; ++dh) { o[dh] = MFMA32(rfv[dh][s], qr[s], o[dh]); if (s < 2 || qh) o[dh] = MFMA32(vfv[dh][s], pf[s], o[dh]); }
            const size_t mrow = rowbase + (size_t)i * 64 + 32 * qh + r32;
            float ss = 0.f;
#pragma unroll
            for (int dh = 0; dh < 2; ++dh)
#pragma unroll
                for (int r = 0; r < 16; ++r) ss += o[dh][r] * o[dh][r];
            ss = sum_x32(ss);
            const float rn = __builtin_amdgcn_rsqf(ss * (1.f / 64.f) + EPS);
#pragma unroll
            for (int dh = 0; dh < 2; ++dh)
#pragma unroll
                for (int g = 0; g < 4; ++g) { const int d = 32 * dh + 8 * g + 4 * hi; const u32x2 tg = *(const LAS u32x2*)((lds_cptr)lds + sl + TG_ + (32 * qh + r32) * 128 + d * 2);
                    u32x2 w; w.x = pk2(siluf_(bflo(tg.x)) * o[dh][4 * g] * rn, siluf_(bfhi(tg.x)) * o[dh][4 * g + 1] * rn); w.y = pk2(siluf_(bflo(tg.y)) * o[dh][4 * g + 2] * rn, siluf_(bfhi(tg.y)) * o[dh][4 * g + 3] * rn);
                    *(u32x2*)(Y + mrow * D + 768 + 64 * h + d) = w; }
        } else if (wid >= 4) {
#pragma unroll
            for (int s = 0; s < 4; ++s) {
                const s16x4 vl = vtr(trb + sl + VT_ + dvh * 4096 + s * 1024), vh = vtr(trb + sl + VT_ + dvh * 4096 + s * 1024 + 512);
                const s16x4 kl = vtr(trb + sl + KT_ + dkh * 4096 + s * 1024), kh = vtr(trb + sl + KT_ + dkh * 4096 + s * 1024 + 512);
                Rq = MFMA32(((bf16x8){vl[0], vl[1], vl[2], vl[3], vh[0], vh[1], vh[2], vh[3]}), ((bf16x8){kl[0], kl[1], kl[2], kl[3], kh[0], kh[1], kh[2], kh[3]}), Rq); }
            Rq = Rq * g64;
            LAS bf16_t* rs = (LAS bf16_t*)(lds + RS_ + (RSB - rb));
            const int dk = 32 * dkh + r32;
#pragma unroll
            for (int r = 0; r < 16; ++r) { const int dv = 32 * dvh + (r & 3) + 8 * (r >> 2) + 4 * hi; rs[(dk >> 3) * 512 + dv * 8 + (dk & 7)] = (bf16_t)(pk2(Rq[r], 0.f) & 0xffffu); }
        }
    }
    asm volatile("s_waitcnt lgkmcnt(0)\n\ts_barrier" ::: "memory");
#undef RS_DMA
}

__device__ __forceinline__ float em1(float x) {
    if (x > -0.25f) { float p = 1.f / 720.f; p = p * x + 1.f / 120.f; p = p * x + 1.f / 24.f; p = p * x + 1.f / 6.f; p = p * x + 0.5f; p = p * x + 1.f; return p * x; }
    return expm1f(x);
}
template <int DD> __device__ __forceinline__ float dpp_shr(float v) { return __int_as_float(__builtin_amdgcn_update_dpp(__float_as_int(v), __float_as_int(v), 0x110 + DD, 0xF, 0xF, false)); }
template <int DD> __device__ __forceinline__ float dpp_shr_z(float v) { return __int_as_float(__builtin_amdgcn_update_dpp(0, __float_as_int(v), 0x110 + DD, 0xF, 0xF, true)); }
template <int DD> __device__ __forceinline__ float dpp_shr_o(float v) { return __int_as_float(__builtin_amdgcn_update_dpp(0x3f800000, __float_as_int(v), 0x110 + DD, 0xF, 0xF, false)); }
template <int DD> __device__ __forceinline__ f32x4 shup4o(f32x4 v) { f32x4 r; r[0] = dpp_shr_o<DD>(v[0]); r[1] = dpp_shr_o<DD>(v[1]); r[2] = dpp_shr_o<DD>(v[2]); r[3] = dpp_shr_o<DD>(v[3]); return r; }
template <int DD> __device__ __forceinline__ f32x4 shup4z(f32x4 v) { f32x4 r; r[0] = dpp_shr_z<DD>(v[0]); r[1] = dpp_shr_z<DD>(v[1]); r[2] = dpp_shr_z<DD>(v[2]); r[3] = dpp_shr_z<DD>(v[3]); return r; }
template <int DD> __device__ __forceinline__ f32x4 shup4(f32x4 v) { f32x4 r; r[0] = dpp_shr<DD>(v[0]); r[1] = dpp_shr<DD>(v[1]); r[2] = dpp_shr<DD>(v[2]); r[3] = dpp_shr<DD>(v[3]); return r; }
__device__ __forceinline__ float bc15f(float v) { return __int_as_float(__builtin_amdgcn_ds_swizzle(__float_as_int(v), (0x0F << 5) | 0x10)); }
__device__ __forceinline__ f32x4 bc15(f32x4 v) { f32x4 r; r[0] = bc15f(v[0]); r[1] = bc15f(v[1]); r[2] = bc15f(v[2]); r[3] = bc15f(v[3]); return r; }
template <int PASS>
__device__ __forceinline__ void rglru_item(int wi, const bf16_t* PROJ, const bf16_t* GWl, const float* SP8l, const float* cw, const float* cb, const float* ba, const float* bx, float* AGGA, float* AGGB, bf16_t* Y, int lane_in) {
    int lane = lane_in; asm volatile("" : "+v"(lane));
    const int fr = lane & 15, fq = lane >> 4;
    const int h = wi % 6, chunk = (wi / 6) & 63, b = wi / 384;
    const long m0 = (long)b * T + chunk * 64;
    const int chb = 64 * h + 4 * fq;
    bf16x8 wf[2][4][2];
#pragma unroll
    for (int g = 0; g < 2; ++g)
#pragma unroll
        for (int nbo = 0; nbo < 4; ++nbo)
#pragma unroll
            for (int ks = 0; ks < 2; ++ks) { const bf16_t* p = GWl + (((size_t)g * 6 + h) * 64 + 16 * nbo + fr) * 64 + 32 * ks + 4 * fq; const u32x2 lo = *(const u32x2*)p, hi2 = *(const u32x2*)(p + 16);
                wf[g][nbo][ks] = __builtin_bit_cast(bf16x8, (u32x4){lo.x, lo.y, hi2.x, hi2.y}); }
    f32x4 bav[4], bxv[4], spv[4], hc[4], At[4];
#pragma unroll
    for (int nb = 0; nb < 4; ++nb) { bav[nb] = *(const f32x4*)(ba + chb + 16 * nb); bxv[nb] = *(const f32x4*)(bx + chb + 16 * nb); spv[nb] = *(const f32x4*)(SP8l + chb + 16 * nb);
        hc[nb] = (f32x4){0.f, 0.f, 0.f, 0.f}; At[nb] = (f32x4){1.f, 1.f, 1.f, 1.f}; }
#define KS_STEP(DD, A_, B_) do { const f32x4 As = shup4<DD>(A_), Bs = shup4<DD>(B_); if (fr >= DD) { B_ = A_ * Bs + B_; A_ = A_ * As; } } while (0)
    if constexpr (PASS == 2) {
        f32x4 FA[4], FB[4];
#pragma unroll
        for (int nb = 0; nb < 4; ++nb) { FA[nb] = (f32x4){1.f, 1.f, 1.f, 1.f}; FB[nb] = (f32x4){0.f, 0.f, 0.f, 0.f}; }
#pragma unroll
        for (int k = 0; k < 4; ++k) { const int ci = 4 * fr + k;
            if (ci < chunk) {
#pragma unroll
                for (int nb = 0; nb < 4; ++nb) { const size_t o = ((size_t)(b * 64 + ci)) * RW + chb + 16 * nb; const f32x4 a = *(const f32x4*)(AGGA + o), bb = *(const f32x4*)(AGGB + o);
                    FB[nb] = a * FB[nb] + bb; FA[nb] = a * FA[nb]; } } }
#pragma unroll
        for (int nb = 0; nb < 4; ++nb) { KS_STEP(1, FA[nb], FB[nb]); KS_STEP(2, FA[nb], FB[nb]); KS_STEP(4, FA[nb], FB[nb]); KS_STEP(8, FA[nb], FB[nb]); }
#pragma unroll
        for (int nb = 0; nb < 4; ++nb) hc[nb] = bc15(FB[nb]);
    }
#pragma unroll 1
    for (int mb = 0; mb < 4; ++mb) {
        const int tl = 16 * mb + fr;
        f32x4 xc[4];
#pragma unroll
        for (int nb = 0; nb < 4; ++nb) { f32x4 acc = *(const f32x4*)(cb + chb + 16 * nb);
#pragma unroll
            for (int j = 0; j < 4; ++j) { const int tj = tl - 3 + j;
                if (chunk > 0 || tj >= 0) { const u32x2 w = *(const u32x2*)(PROJ + (size_t)(m0 + tj) * NINP + C_RX + chb + 16 * nb); const f32x4 cwv = *(const f32x4*)(cw + j * RW + chb + 16 * nb);
                    acc += cwv * (f32x4){bflo(w.x), bfhi(w.x), bflo(w.y), bfhi(w.y)}; } }
            xc[nb] = acc; }
        bf16x8 bfr[2];
#pragma unroll
        for (int ks = 0; ks < 2; ++ks) { u32x4 w; w.x = pk2(xc[2 * ks][0], xc[2 * ks][1]); w.y = pk2(xc[2 * ks][2], xc[2 * ks][3]); w.z = pk2(xc[2 * ks + 1][0], xc[2 * ks + 1][1]); w.w = pk2(xc[2 * ks + 1][2], xc[2 * ks + 1][3]);
            bfr[ks] = __builtin_bit_cast(bf16x8, w); }
#pragma unroll
        for (int nb = 0; nb < 4; ++nb) {
            f32x4 ra = bav[nb], ia = bxv[nb];
#pragma unroll
            for (int ks = 0; ks < 2; ++ks) { ra = MFMA16(wf[0][nb][ks], bfr[ks], ra); ia = MFMA16(wf[1][nb][ks], bfr[ks], ia); }
            f32x4 A, B;
#pragma unroll
            for (int r = 0; r < 4; ++r) { const float rg = sigmoidf_(ra[r]), ig = sigmoidf_(ia[r]); const float la = spv[nb][r] * rg;
                const float a = __builtin_amdgcn_exp2f(1.4426950408889634f * la), x2 = 2.0f * la;
                float p = 1.f / 5040.f; p = p * x2 + 1.f / 720.f; p = p * x2 + 1.f / 120.f; p = p * x2 + 1.f / 24.f; p = p * x2 + 1.f / 6.f; p = p * x2 + 0.5f; p = p * x2 + 1.f;
                const float om = x2 > -0.25f ? -(p * x2) : 1.0f - a * a;
                A[r] = a; B[r] = __builtin_amdgcn_sqrtf(om) * ig * xc[nb][r]; }
            KS_STEP(1, A, B); KS_STEP(2, A, B); KS_STEP(4, A, B); KS_STEP(8, A, B);
            const f32x4 hv = B + A * hc[nb];
            hc[nb] = bc15(hv);
            if constexpr (PASS == 1) { At[nb] = At[nb] * bc15(A); }
            else { const size_t mr = (size_t)(m0 + tl); const u32x2 gw = *(const u32x2*)(PROJ + mr * NINP + C_RG + chb + 16 * nb);
                u32x2 w; w.x = pk2(gelu_tanh(bflo(gw.x)) * hv[0], gelu_tanh(bfhi(gw.x)) * hv[1]); w.y = pk2(gelu_tanh(bflo(gw.y)) * hv[2], gelu_tanh(bfhi(gw.y)) * hv[3]);
                *(u32x2*)(Y + mr * D + chb + 16 * nb) = w; }
        }
    }
    if constexpr (PASS == 1) {
        if (fr == 15) {
#pragma unroll
            for (int nb = 0; nb < 4; ++nb) { const size_t o = ((size_t)(b * 64 + chunk)) * RW + chb + 16 * nb; *(f32x4*)(AGGA + o) = At[nb]; *(f32x4*)(AGGB + o) = hc[nb]; } }
    }
}
__device__ __forceinline__ unsigned pkh2u(float lo, float hi) { return pkh2(lo, hi); }
__device__ __forceinline__ void rglru_fused(int wi, const bf16_t* PROJ, const bf16_t* GWl, const float* SP8l, const float* cw, const float* cb, const float* ba, const float* bx, float* AGGA, float* AGGB, unsigned* flags, bf16_t* Y, LAS unsigned char* slab, LAS float* cst, int lane_in) {
    int lane = lane_in; asm volatile("" : "+v"(lane));
    const int fr = lane & 15, fq = lane >> 4;
    const int h = wi % 6, chunk = (wi / 6) & 63, b = wi / 384;
    const long m0 = (long)b * T + chunk * 64;
    const int chb = 64 * h + 16 * fq;
    bf16x8 wf[2][4][2];
#pragma unroll
    for (int g = 0; g < 2; ++g)
#pragma unroll
        for (int nbo = 0; nbo < 4; ++nbo)
#pragma unroll
            for (int ks = 0; ks < 2; ++ks) { const bf16_t* p = GWl + (((size_t)g * 6 + h) * 64 + 16 * (fr >> 2) + 4 * nbo + (fr & 3)) * 64 + 16 * fq + 8 * ks;
                wf[g][nbo][ks] = __builtin_bit_cast(bf16x8, *(const u32x4*)p); }
    u32x2 win[4][4];
#define RX_LOAD(mb_) do { _Pragma("unroll") for (int j = 0; j < 4; ++j) { const int tj = 16 * (mb_) + fr - 3 + j; const bf16_t* p_ = PROJ + (size_t)(m0 + tj) * NINP + C_RX + chb; const bool in_ = chunk > 0 || tj >= 0; \
        const u32x4 q0 = in_ ? *(const u32x4*)p_ : (u32x4){0u, 0u, 0u, 0u}, q1 = in_ ? *(const u32x4*)(p_ + 8) : (u32x4){0u, 0u, 0u, 0u}; \
        win[0][j] = (u32x2){q0.x, q0.y}; win[1][j] = (u32x2){q0.z, q0.w}; win[2][j] = (u32x2){q1.x, q1.y}; win[3][j] = (u32x2){q1.z, q1.w}; } } while (0)
    RX_LOAD(0);
    { const int a_ = lane >> 4, c16 = lane & 15, nb_ = c16 & 3, fq_ = c16 >> 2;
      const float* src0 = a_ == 0 ? ba : a_ == 1 ? bx : a_ == 2 ? SP8l : cb;
      const int u0 = a_ == 3 ? 28 : 4 * a_;
      const float sc = a_ < 2 ? -1.4426950408889634f : 1.0f;
      const f32x4 v0 = *(const f32x4*)(src0 + 64 * h + 4 * c16) * sc;
      const f32x4 v1 = *(const f32x4*)(cw + (size_t)a_ * RW + 64 * h + 4 * c16);
      *(LAS f32x4*)(cst + ((u0 + nb_) * 4 + fq_) * 4) = v0;
      *(LAS f32x4*)(cst + ((12 + 4 * a_ + nb_) * 4 + fq_) * 4) = v1; }
    f32x4 hc[4], At[4];
#pragma unroll
    for (int nb = 0; nb < 4; ++nb) { hc[nb] = (f32x4){0.f, 0.f, 0.f, 0.f}; At[nb] = (f32x4){1.f, 1.f, 1.f, 1.f};
        }
#define KS_STEP(DD, A_, B_) do { asm volatile("s_nop 1\n\t" \
        "v_fmac_f32_dpp %0, %0, %4 row_shr:" #DD " row_mask:0xf bank_mask:0xf\n\tv_fmac_f32_dpp %1, %1, %5 row_shr:" #DD " row_mask:0xf bank_mask:0xf\n\t" \
        "v_fmac_f32_dpp %2, %2, %6 row_shr:" #DD " row_mask:0xf bank_mask:0xf\n\tv_fmac_f32_dpp %3, %3, %7 row_shr:" #DD " row_mask:0xf bank_mask:0xf\n\t" \
        "v_mul_f32_dpp %4, %4, %4 row_shr:" #DD " row_mask:0xf bank_mask:0xf\n\tv_mul_f32_dpp %5, %5, %5 row_shr:" #DD " row_mask:0xf bank_mask:0xf\n\t" \
        "v_mul_f32_dpp %6, %6, %6 row_shr:" #DD " row_mask:0xf bank_mask:0xf\n\tv_mul_f32_dpp %7, %7, %7 row_shr:" #DD " row_mask:0xf bank_mask:0xf" \
        : "+v"(B_[0]), "+v"(B_[1]), "+v"(B_[2]), "+v"(B_[3]), "+v"(A_[0]), "+v"(A_[1]), "+v"(A_[2]), "+v"(A_[3])); } while (0)
#pragma unroll
    for (int mb = 0; mb < 4; ++mb) {
        const int tl = 16 * mb + fr;
        f32x4 xc[4];
#pragma unroll
        for (int nb = 0; nb < 4; ++nb) { f32x4 acc = *(const LAS f32x4*)(cst + ((28 + nb) * 4 + fq) * 4);
#pragma unroll
            for (int j = 0; j < 4; ++j) { const u32x2 w = win[nb][j]; const f32x4 cwv = *(const LAS f32x4*)(cst + ((12 + 4 * j + nb) * 4 + fq) * 4);
                acc += cwv * (f32x4){bflo(w.x), bfhi(w.x), bflo(w.y), bfhi(w.y)}; }
            xc[nb] = acc; }
        if (mb < 3) RX_LOAD(mb + 1);
        bf16x8 bfr[2];
#pragma unroll
        for (int ks = 0; ks < 2; ++ks) { u32x4 w; w.x = pk2(xc[2 * ks][0], xc[2 * ks][1]); w.y = pk2(xc[2 * ks][2], xc[2 * ks][3]); w.z = pk2(xc[2 * ks + 1][0], xc[2 * ks + 1][1]); w.w = pk2(xc[2 * ks + 1][2], xc[2 * ks + 1][3]);
            bfr[ks] = __builtin_bit_cast(bf16x8, w); }
#pragma unroll
        for (int nb = 0; nb < 4; ++nb) {
            f32x4 ra = *(const LAS f32x4*)(cst + (nb * 4 + fq) * 4), ia = *(const LAS f32x4*)(cst + ((4 + nb) * 4 + fq) * 4); const f32x4 sp = *(const LAS f32x4*)(cst + ((8 + nb) * 4 + fq) * 4);
#pragma unroll
            for (int ks = 0; ks < 2; ++ks) { ra = MFMA16(wf[0][nb][ks], bfr[ks], ra); ia = MFMA16(wf[1][nb][ks], bfr[ks], ia); }
            f32x4 A, B;
#pragma unroll
            for (int r = 0; r < 4; ++r) { const float rg = fast_rcp(1.f + __builtin_amdgcn_exp2f(ra[r])), ig = fast_rcp(1.f + __builtin_amdgcn_exp2f(ia[r])); const float la = sp[r] * rg;
                const float a = __builtin_amdgcn_exp2f(la);
                constexpr double c_ = 1.3862943611198906;
                float p = (float)(c_ * c_ * c_ / 6.0); p = p * la + (float)(c_ * c_ / 2.0); p = p * la + (float)c_;
                float oa_ = -(p * la), ob_ = 1.0f - a * a; asm("" : "+v"(oa_)); asm("" : "+v"(ob_));
                const float om = la > (float)(-1.0 / (64.0 * c_)) ? oa_ : ob_;
                A[r] = a; B[r] = __builtin_amdgcn_sqrtf(om) * ig * xc[nb][r]; }
            KS_STEP(1, A, B); KS_STEP(2, A, B); KS_STEP(4, A, B); KS_STEP(8, A, B);
            *(LAS u32x4*)(slab + ((mb * 4 + nb) * 64 + lane) * 16) = (u32x4){pkh2u(1.0f - A[0], B[0]), pkh2u(1.0f - A[1], B[1]), pkh2u(1.0f - A[2], B[2]), pkh2u(1.0f - A[3], B[3])};
            hc[nb] = B + A * hc[nb]; At[nb] = At[nb] * A;
        }
        asm volatile("" ::: "memory"); __builtin_amdgcn_sched_barrier(0);
    }
    if (fr == 15) {
#pragma unroll
        for (int nb = 0; nb < 4; ++nb) { const size_t o = ((size_t)(b * 64 + chunk)) * RW + chb + 4 * nb; typedef unsigned long long u64_;
            __hip_atomic_store((u64_*)(AGGA + o), ((u64_)__float_as_uint(At[nb][1]) << 32) | __float_as_uint(At[nb][0]), __ATOMIC_RELAXED, __HIP_MEMORY_SCOPE_AGENT);
            __hip_atomic_store((u64_*)(AGGA + o) + 1, ((u64_)__float_as_uint(At[nb][3]) << 32) | __float_as_uint(At[nb][2]), __ATOMIC_RELAXED, __HIP_MEMORY_SCOPE_AGENT);
            __hip_atomic_store((u64_*)(AGGB + o), ((u64_)__float_as_uint(hc[nb][1]) << 32) | __float_as_uint(hc[nb][0]), __ATOMIC_RELAXED, __HIP_MEMORY_SCOPE_AGENT);
            __hip_atomic_store((u64_*)(AGGB + o) + 1, ((u64_)__float_as_uint(hc[nb][3]) << 32) | __float_as_uint(hc[nb][2]), __ATOMIC_RELAXED, __HIP_MEMORY_SCOPE_AGENT); } }
    asm volatile("s_waitcnt vmcnt(0)" ::: "memory");
    if (lane == 0) __hip_atomic_store(flags + (b * 64 + chunk) * 6 + h, 1u, __ATOMIC_RELAXED, __HIP_MEMORY_SCOPE_AGENT);
    f32x4 cin[4];
#pragma unroll
    for (int nb = 0; nb < 4; ++nb) cin[nb] = (f32x4){0.f, 0.f, 0.f, 0.f};
    if (chunk > 0) {
        unsigned sp_ = 0;
        for (;;) { bool ok = true;
#pragma unroll
            for (int k = 0; k < 4; ++k) { const int ci = 4 * fr + k; if (ci < chunk) ok = ok && (__hip_atomic_load(flags + (b * 64 + ci) * 6 + h, __ATOMIC_RELAXED, __HIP_MEMORY_SCOPE_AGENT) != 0u); }
            if (__all(ok) || ++sp_ > (1u << 16)) break;
            __builtin_amdgcn_s_sleep(4); }
        __builtin_amdgcn_fence(__ATOMIC_ACQUIRE, "agent");
        f32x4 FA[4], FB[4];
#pragma unroll
        for (int nb = 0; nb < 4; ++nb) { FA[nb] = (f32x4){1.f, 1.f, 1.f, 1.f}; FB[nb] = (f32x4){0.f, 0.f, 0.f, 0.f}; }
#pragma unroll
        for (int k = 0; k < 4; ++k) { const int ci = 4 * fr + k;
            if (ci < chunk) {
#pragma unroll
                for (int nb = 0; nb < 4; ++nb) { const size_t o = ((size_t)(b * 64 + ci)) * RW + chb + 4 * nb; const f32x4 a = *(const f32x4*)(AGGA + o), bb = *(const f32x4*)(AGGB + o);
                    FB[nb] = a * FB[nb] + bb; FA[nb] = a * FA[nb]; } } }
#pragma unroll
        for (int nb = 0; nb < 4; ++nb) { KS_STEP(1, FA[nb], FB[nb]); KS_STEP(2, FA[nb], FB[nb]); KS_STEP(4, FA[nb], FB[nb]); KS_STEP(8, FA[nb], FB[nb]); }
#pragma unroll
        for (int nb = 0; nb < 4; ++nb) cin[nb] = bc15(FB[nb]);
    }
#pragma unroll
    for (int mb = 0; mb < 4; ++mb) {
        const size_t mr = (size_t)(m0 + 16 * mb + fr);
        const u32x4 g0_ = *(const u32x4*)(PROJ + mr * NINP + C_RG + chb), g1_ = *(const u32x4*)(PROJ + mr * NINP + C_RG + chb + 8); const unsigned gws_[8] = {g0_.x, g0_.y, g0_.z, g0_.w, g1_.x, g1_.y, g1_.z, g1_.w}; unsigned ow_[8];
#pragma unroll
        for (int nb = 0; nb < 4; ++nb) { f32x4 hv; const u32x4 pw = *(const LAS u32x4*)(slab + ((mb * 4 + nb) * 64 + lane) * 16);
#pragma unroll
            for (int r = 0; r < 4; ++r) { float t_, c_ = cin[nb][r]; const unsigned w = pw[r];
                asm("v_fma_mix_f32 %0, -%1, %2, %2 op_sel:[0,0,0] op_sel_hi:[1,0,0]" : "=v"(t_) : "v"(w), "v"(c_));
                asm("v_fma_mix_f32 %0, %1, 1.0, %2 op_sel:[1,0,0] op_sel_hi:[1,0,0]" : "=v"(hv[r]) : "v"(w), "v"(t_)); }
            cin[nb] = bc15(hv);
            const u32x2 gw = (u32x2){gws_[2 * nb], gws_[2 * nb + 1]};
            u32x2 w; w.x = pk2(gelu_mul(bflo(gw.x), hv[0]), gelu_mul(bfhi(gw.x), hv[1])); w.y = pk2(gelu_mul(bflo(gw.y), hv[2]), gelu_mul(bfhi(gw.y), hv[3]));
            ow_[2 * nb] = w.x; ow_[2 * nb + 1] = w.y; }
        *(u32x4*)(Y + mr * D + chb) = (u32x4){ow_[0], ow_[1], ow_[2], ow_[3]}; *(u32x4*)(Y + mr * D + chb + 8) = (u32x4){ow_[4], ow_[5], ow_[6], ow_[7]};
    }
#undef KS_STEP
#undef RX_LOAD
}
#undef KS_STEP
#undef MFMA32
#undef MFMA16
}

constexpr int NWAVES = 8;
struct Args { const float* in[27]; const int* pos; float* out; unsigned char* ws; float lam_init[4]; int ph_lo, ph_hi, li, pad; };
constexpr int PH_L0 = 3, NPH = 8, PH_FINAL = PH_L0 + NL * NPH, PH_END = PH_FINAL + 1;

struct Frame { LAS unsigned char* lds; int wave, vcu, G, gw, NGW; };

template <class Map>
__device__ __forceinline__ void transpose_item(const float* W, int K, int Nsrc, bf16_t* WT, int NT, LAS float* scr, int item, int lane, Map src, bool tiled = false) {
    const int nblk = NT / 32, kb = item / nblk, nb = item % nblk, k0 = 64 * kb, n0 = 32 * nb;
    const int sc = src(n0 + (lane & 31));
    float wv_[32];
#pragma unroll
    for (int i = 0; i < 32; ++i) { const int kk = 2 * i + (lane >> 5); wv_[i] = sc >= 0 ? __builtin_nontemporal_load(W + (size_t)(k0 + kk) * Nsrc + sc) : 0.f; }
#pragma unroll
    for (int i = 0; i < 32; ++i) { const int kk = 2 * i + (lane >> 5); scr[kk * 33 + (lane & 31)] = wv_[i]; }
    LDS_WAIT(); asm volatile("" ::: "memory");
    const int c = lane & 7;
#pragma unroll
    for (int j = 0; j < 4; ++j) { const int n = (lane >> 3) + 8 * j; const LAS float* s = scr + (8 * c) * 33 + n;
        u32x4 o; o.x = pk2(s[0 * 33], s[1 * 33]); o.y = pk2(s[2 * 33], s[3 * 33]); o.z = pk2(s[4 * 33], s[5 * 33]); o.w = pk2(s[6 * 33], s[7 * 33]);
        const size_t off = tiled ? (((size_t)((n0 + n) >> 8) * (K / 64) + kb) * 256 + ((n0 + n) & 255)) * 64 + 8 * c : (size_t)(n0 + n) * K + k0 + 8 * c;
        __builtin_nontemporal_store(o, (GAS u32x4*)(WT + off)); }
    LDS_WAIT(); asm volatile("" ::: "memory");
}
struct MapId { __device__ __forceinline__ int operator()(int n) const { return n; } };
struct MapFfnIn { __device__ __forceinline__ int operator()(int n) const { const int pn = n >> 8, bj = (n >> 7) & 1, cc = n & 127; return bj * F + pn * 128 + cc; } };
__device__ __forceinline__ int ret_dim(int pos) { const int w = pos >> 5, rem = pos & 31, fq = rem >> 3, n = (rem >> 2) & 1, j = rem & 3; return 32 * n + 16 * w + 4 * fq + j; }
struct MapMixIn { __device__ __forceinline__ int operator()(int p) const {
    if (p < C_DK) return 768 + p;
    if (p < C_TQ) return 1152 + (p - C_DK);
    if (p < C_TK) { const int q = p - C_TQ; return 1920 + (q & ~63) + ret_dim(q & 63); }
    if (p < C_DV) { const int q = p - C_TK; return 2176 + (q & ~63) + ret_dim(q & 63); }
    if (p < C_TV) return 1536 + (p - C_DV);
    if (p < C_TG) return 2432 + (p - C_TV);
    if (p < C_RX) return 2688 + (p - C_TG);
    if (p < C_RG) return p - C_RX;
    if (p < NIN) return 384 + (p - C_RG);
    return -1; } };

constexpr int I_FI = (D / 64) * (2 * F / 32), I_FO = (F / 64) * (D / 32), I_MI = (D / 64) * (NINP / 32), I_MO = (D / 64) * (D / 32), CONV_ITEMS_L = 2 * I_FI + 2 * I_FO + I_MI + I_MO;
constexpr int CONV_WG_ITEMS = (CONV_ITEMS_L + NWAVES - 1) / NWAVES;
struct ConvSrc { const float *f1i, *f1o, *f2i, *f2o, *mi, *mo; };
__device__ __forceinline__ void conv_item(const ConvSrc cs, unsigned char* ws, int l, int r, LAS float* scr, int lane) {
    unsigned char* wl = ws + WS_W + (size_t)l * W_L;
    if (r < I_FI) { transpose_item(cs.f1i + (size_t)l * D * 2 * F, D, 2 * F, (bf16_t*)(wl + W_1IN), 2 * F, scr, r, lane, MapFfnIn(), true); return; } r -= I_FI;
    if (r < I_FI) { transpose_item(cs.f2i + (size_t)l * D * 2 * F, D, 2 * F, (bf16_t*)(wl + W_2IN), 2 * F, scr, r, lane, MapFfnIn(), true); return; } r -= I_FI;
    if (r < I_FO) { transpose_item(cs.f1o + (size_t)l * F * D, F, D, (bf16_t*)(wl + W_1OUT), D, scr, r, lane, MapId(), true); return; } r -= I_FO;
    if (r < I_FO) { transpose_item(cs.f2o + (size_t)l * F * D, F, D, (bf16_t*)(wl + W_2OUT), D, scr, r, lane, MapId(), true); return; } r -= I_FO;
    if (r < I_MI) { transpose_item(cs.mi + (size_t)l * D * NIN, D, NIN, (bf16_t*)(wl + W_IN), NINP, scr, r, lane, MapMixIn(), true); return; } r -= I_MI;
    transpose_item(cs.mo + (size_t)l * D * D, D, D, (bf16_t*)(wl + W_OUT), D, scr, r, lane, MapId(), true);
}
__device__ __forceinline__ void bias_layer(unsigned char* ws, int l, int gw, int ngw, int lane) {
    const float* MOD = (const float*)(ws + WS_MOD); float* BIAS = (float*)(ws + WS_BIAS);
    for (int g = 0; g < 3; ++g) {
        const int lg = l * 3 + g; const int Nw = (g == 1) ? NINP : 2 * F;
        const bf16_t* Wt = (const bf16_t*)(ws + WS_W + (size_t)l * W_L + (g == 0 ? W_1IN : g == 1 ? W_IN : W_2IN));
        f32x4 Sv[4][4];
#pragma unroll
        for (int b = 0; b < 4; ++b)
#pragma unroll
            for (int q = 0; q < 4; ++q) Sv[b][q] = *(const f32x4*)(MOD + ((size_t)l * NB + b) * NMD + (3 * g) * D + 16 * lane + 4 * q);
        for (int n = gw; n < Nw; n += ngw) {
            const u32x4 w0 = *(const u32x4*)(Wt + (size_t)n * D + 16 * lane), w1 = *(const u32x4*)(Wt + (size_t)n * D + 16 * lane + 8);
            const f32x4 wv[4] = {{bflo(w0.x), bfhi(w0.x), bflo(w0.y), bfhi(w0.y)}, {bflo(w0.z), bfhi(w0.z), bflo(w0.w), bfhi(w0.w)}, {bflo(w1.x), bfhi(w1.x), bflo(w1.y), bfhi(w1.y)}, {bflo(w1.z), bfhi(w1.z), bflo(w1.w), bfhi(w1.w)}};
            float acc4[4];
#pragma unroll
            for (int b = 0; b < 4; ++b) { f32x4 a = Sv[b][0] * wv[0] + Sv[b][1] * wv[1] + Sv[b][2] * wv[2] + Sv[b][3] * wv[3]; acc4[b] = wave_sum((a[0] + a[1]) + (a[2] + a[3])); }
            if (lane < 4) BIAS[((size_t)lg * NB + lane) * (2 * F) + n] = lane == 0 ? acc4[0] : lane == 1 ? acc4[1] : lane == 2 ? acc4[2] : acc4[3];
        }
    }
}

__device__ __forceinline__ void bias_layer_mma(unsigned char* ws, int l, LAS unsigned char* lds, int j, int stride, int lane) {
    const float* MOD = (const float*)(ws + WS_MOD); float* BIAS = (float*)(ws + WS_BIAS);
    int tid_ = threadIdx.x; asm volatile("" : "+v"(tid_));
    for (int c = tid_; c < 3 * 4 * 128; c += NWAVES * 64) {
        const int g = c >> 9, b = (c >> 7) & 3, kc = c & 127;
        const float* sp = MOD + ((size_t)l * NB + b) * NMD + (3 * g) * D + 8 * kc;
        const f32x4 s0 = *(const f32x4*)sp, s1 = *(const f32x4*)(sp + 4);
        u32x4 hi, lo;
        hi.x = pk2(s0[0], s0[1]); hi.y = pk2(s0[2], s0[3]); hi.z = pk2(s1[0], s1[1]); hi.w = pk2(s1[2], s1[3]);
        lo.x = pk2(s0[0] - bflo(hi.x), s0[1] - bfhi(hi.x)); lo.y = pk2(s0[2] - bflo(hi.y), s0[3] - bfhi(hi.y)); lo.z = pk2(s1[0] - bflo(hi.z), s1[1] - bfhi(hi.z)); lo.w = pk2(s1[2] - bflo(hi.w), s1[3] - bfhi(hi.w));
        const int off = ((g * 2) * 32 + (kc >> 2)) * 256 + (kc & 3) * 64 + b * 16;
        *(LAS u32x4*)(lds + off) = hi; *(LAS u32x4*)(lds + off + 8192) = lo; }
    if (tid_ == 0) { unsigned z_ = 0u; asm volatile("" : "+v"(z_)); *(LAS u32x4*)(lds + 49152) = (u32x4){z_, z_, z_, z_}; }
    __syncthreads();
    int ln = lane; asm volatile("" : "+v"(ln));
    const int fr = ln & 15, fq = ln >> 4;
    for (int grp = j; grp < 896; grp += stride) {
        const int g = grp < 352 ? 0 : grp < 544 ? 1 : 2; const int n0 = 16 * (grp - (g == 0 ? 0 : g == 1 ? 352 : 544));
        const int nrow = n0 + fr;
        const bf16_t* Wt = (const bf16_t*)(ws + WS_W + (size_t)l * W_L + (g == 0 ? W_1IN : g == 1 ? W_IN : W_2IN)) + (size_t)(nrow >> 8) * (D / 64) * (256 * 64) + (size_t)(nrow & 255) * 64 + 8 * fq;
        bf16x8 wf[32];
#pragma unroll
        for (int ks = 0; ks < 32; ++ks) wf[ks] = *(const bf16x8*)(Wt + (size_t)(ks >> 1) * (256 * 64) + (ks & 1) * 32);
        const bool act = fr < 4; const int sb = act ? g * 16384 + fq * 64 + fr * 16 : 49152, st = act ? 256 : 0, lo_ = act ? 8192 : 0;
        f32x4 acc = {0.f, 0.f, 0.f, 0.f};
#pragma unroll
        for (int ks = 0; ks < 32; ++ks) { const bf16x8 sh = *(const LAS bf16x8*)(lds + sb + ks * st), sl = *(const LAS bf16x8*)(lds + sb + lo_ + ks * st);
            acc = __builtin_amdgcn_mfma_f32_16x16x32_bf16(wf[ks], sh, acc, 0, 0, 0); acc = __builtin_amdgcn_mfma_f32_16x16x32_bf16(wf[ks], sl, acc, 0, 0, 0); }
        if (act) *(f32x4*)(BIAS + ((size_t)(l * 3 + g) * NB + fr) * (2 * F) + n0 + 4 * fq) = acc;
    }
    __syncthreads();
}

__global__ void __launch_bounds__(NWAVES * 64, 2) mega(Args args) {
    Frame FR;
    FR.lds = (LAS unsigned char*)lds_raw;
    volatile LAS unsigned* MISC = (volatile LAS unsigned*)(FR.lds + MISC_OFF);
    FR.wave = __builtin_amdgcn_readfirstlane((int)threadIdx.x >> 6);
    FR.G = gridDim.x; { const int bx = blockIdx.x; FR.vcu = (FR.G % 8 == 0) ? (bx % 8) * (FR.G / 8) + bx / 8 : bx; }
    FR.gw = FR.vcu * NWAVES + FR.wave; FR.NGW = FR.G * NWAVES;
    unsigned char* ws = args.ws;
    gu32* ctl = (gu32*)(ws + WS_CTL);
    for (int u = (int)threadIdx.x; u < (LDS_BYTES - LDSCTL_OFF) / 4; u += NWAVES * 64) ((LAS unsigned*)(FR.lds + LDSCTL_OFF))[u] = 0u;
    __syncthreads();
#if PROBE_PRO
    if (blockIdx.x == 0 && (int)threadIdx.x == 0) ((volatile LAS unsigned long long*)((LAS unsigned char*)lds_raw + MISC_OFF + 200))[0] = __builtin_amdgcn_s_memrealtime();
#endif
    const int lo = args.ph_lo, hi = args.ph_hi;
    if (MK_ONE_LAUNCH || hi - lo > 1) (void)xcd_barrier_post((unsigned*)(ctl + CW_BAR) + args.li * XCD_BAR_WORDS, MISC + 8);
#define bar (XcdBarrier{(unsigned*)((gu32*)(args.ws + WS_CTL) + CW_BAR) + args.li * XCD_BAR_WORDS, xb_xcc_id(), (volatile LAS unsigned*)((LAS unsigned char*)lds_raw + MISC_OFF) + 8})
#if MK_ONE_LAUNCH
#define IN(k) true
#if PROBE_BAR2
#define SEAM(k) do { xcd_barrier(bar); xcd_barrier(bar); } while (0)
#else
#define SEAM(k) xcd_barrier(bar)
#endif
#else
#define IN(k) (lo <= (k) && (k) < hi)
#define SEAM(k) do { if (IN(k) && IN((k) + 1)) xcd_barrier(bar); } while (0)
#endif
    float* X = (float*)(ws + WS_X); bf16_t* H = (bf16_t*)(ws + WS_H); bf16_t* Y = (bf16_t*)(ws + WS_Y); bf16_t* ACT = (bf16_t*)(ws + WS_ACT); bf16_t* PROJ = (bf16_t*)(ws + WS_PROJ);
    float* MODP = (float*)(ws + WS_MODP); float* MOD = (float*)(ws + WS_MOD); float* TABD = (float*)(ws + WS_TABD); float* TABR = (float*)(ws + WS_TABR);

    float* ANORM = (float*)(ws + WS_ANORM); float* BIAS = (float*)(ws + WS_BIAS); float* SSQ = (float*)(ws + WS_SSQ); bf16_t* XS = H;
    for (int repp = 0; repp < PROBE_REPP; ++repp) {
    if (IN(0)) {
        for (int i = FR.gw * 64 + lane_id(); i < M * 36; i += FR.NGW * 64) {
            const int m = i / 36, f = i % 36; const float p = (float)args.pos[m];
            if (f < 4) { const float inv = powf(500000.0f, -0.25f * (float)f); float s, c; sincosf(p * (f == 0 ? 1.0f : inv), &s, &c); TABD[m * 8 + f] = c; TABD[m * 8 + 4 + f] = s; }
            else { const int g = f - 4; const float inv = powf(10000.0f, -(float)g * (2.0f / 64.0f)); float s, c; sincosf(p * inv, &s, &c); TABR[m * 64 + g] = c; TABR[m * 64 + 32 + g] = s; }
        }
        LAS float* sc = (LAS float*)(FR.lds + RING_OFF);
        for (int i = (int)threadIdx.x; i < NB * D; i += NWAVES * 64) sc[i] = siluf_(args.in[1][i]);
        __syncthreads();
        for (int it = FR.gw; it < NL * NKC * (NMD / 256); it += FR.NGW) {
            const int nb = it % (NMD / 256), kc = (it / (NMD / 256)) % NKC, l = it / ((NMD / 256) * NKC);
            const float* W = args.in[6] + ((size_t)l * D + kc * KC) * NMD + nb * 256 + lane_id() * 4;
            f32x4 a0 = {0, 0, 0, 0}, a1 = a0, a2 = a0, a3 = a0;
#pragma unroll 8
            for (int k = 0; k < KC; ++k) { const f32x4 w = __builtin_nontemporal_load((const GAS f32x4*)(W + (size_t)k * NMD)); const int kk = kc * KC + k;
                a0 += w * sc[kk]; a1 += w * sc[D + kk]; a2 += w * sc[2 * D + kk]; a3 += w * sc[3 * D + kk]; }
            float* P = MODP + ((size_t)(kc * NL + l) * NB) * NMD + nb * 256 + lane_id() * 4;
            *(f32x4*)(P) = a0; *(f32x4*)(P + NMD) = a1; *(f32x4*)(P + 2 * NMD) = a2; *(f32x4*)(P + 3 * NMD) = a3;
        }
        __syncthreads();
        { LAS float* scr = (LAS float*)(FR.lds + RING_OFF + FR.wave * 16384);
          for (int it = FR.gw; it < CONV_ITEMS_L; it += FR.NGW) conv_item(ConvSrc{args.in[8], args.in[9], args.in[10], args.in[11], args.in[12], args.in[13]}, ws, 0, it, scr, lane_id()); }
        __syncthreads();
    }
    SEAM(0);
    if (IN(1)) {
        for (int i = FR.gw * 64 + lane_id(); i < NL * NB * NMD; i += FR.NGW * 64) {
            const int l = i / (NB * NMD), b = (i / NMD) % NB, n = i % NMD; float s = args.in[7][l * NMD + n];
            for (int kc = 0; kc < NKC; ++kc) s += MODP[(size_t)kc * NL * NB * NMD + i];
            MOD[i] = s;
            const int part = n / D, k = n % D;
            if (part % 3 == 1) { const int j = part / 3; ANORM[(((size_t)l * 3 + j) * NB + b) * D + k] = args.in[3 + j][l * D + k] * (1.0f + s); } }
        { bf16_t* GW = (bf16_t*)(ws + WS_GW); float* SP8 = (float*)(ws + WS_SP8); float* LAMS = (float*)(ws + WS_LAMS);
          for (int i = FR.gw * 64 + lane_id(); i < NL * 2 * 6 * 64 * 64; i += FR.NGW * 64) { const int in_ = i & 63, out = (i >> 6) & 63, h = (i >> 12) % 6, g = ((i >> 12) / 6) & 1, l = (i >> 12) / 12;
              const float v = -1.4426950408889634f * args.in[g ? 18 : 16][(((size_t)l * 6 + h) * 64 + in_) * 64 + out]; GW[i] = (bf16_t)(pk2(v, 0.f) & 0xffffu); }
          for (int i = FR.gw * 64 + lane_id(); i < NL * RW; i += FR.NGW * 64) SP8[i] = -8.0f * 1.4426950408889634f * log1pf(expf(-args.in[20][i]));
          if (FR.gw < NL) { const int l = FR.gw; float s1 = 0.f, s2 = 0.f; if (lane_id() < 32) { s1 = args.in[21][l * 32 + lane_id()] * args.in[22][l * 32 + lane_id()]; s2 = args.in[23][l * 32 + lane_id()] * args.in[24][l * 32 + lane_id()]; }
              s1 = wave_sum(s1); s2 = wave_sum(s2); if (lane_id() == 0) LAMS[l] = expf(s1) - expf(s2) + args.lam_init[l]; } }
    }
    SEAM(1);
    if (IN(2)) {
        { const int b = FR.gw >> 9; const float* ap = ANORM + (size_t)b * D; f32x4 Av[4];
#pragma unroll
          for (int jj = 0; jj < 4; ++jj) Av[jj] = *(const f32x4*)(ap + 4 * lane_id() + 256 * jj);
          for (int rr = 0; rr < 8; ++rr) { const int m = FR.gw * 8 + rr; const GAS f32x4* xr = (const GAS f32x4*)(args.in[0] + (size_t)m * D) + lane_id(); f32x4 v[4]; float s2 = 0.f;
#pragma unroll
              for (int jj = 0; jj < 4; ++jj) { v[jj] = __builtin_nontemporal_load(xr + 64 * jj); s2 += (v[jj].x * v[jj].x + v[jj].y * v[jj].y) + (v[jj].z * v[jj].z + v[jj].w * v[jj].w); }
              s2 = wave_sum(s2);
              if (lane_id() < 16) SSQ[(size_t)m * 16 + lane_id()] = lane_id() == 0 ? s2 : 0.f;
              GAS u32x2* o8 = (GAS u32x2*)(XS + (size_t)m * D) + lane_id();
#pragma unroll
              for (int jj = 0; jj < 4; ++jj) { const f32x4 h = v[jj] * Av[jj]; u32x2 w; w.x = pk2(h.x, h.y); w.y = pk2(h.z, h.w); o8[64 * jj] = w;
                  u32x2 xw; xw.x = pkh2(v[jj].x, v[jj].y); xw.y = pkh2(v[jj].z, v[jj].w); ((GAS u32x2*)((bf16_t*)(ws + WS_X) + (size_t)m * D) + lane_id())[64 * jj] = xw; } } }
        bias_layer_mma(ws, 0, FR.lds + RING_OFF, FR.gw, FR.NGW, lane_id());
        __syncthreads();
    }
#if PROBE_PRO == 1
    if (blockIdx.x == 0 && (int)threadIdx.x == 0) { asm volatile("s_waitcnt vmcnt(0)" ::: "memory"); const unsigned long long r0_ = __builtin_amdgcn_s_memrealtime(), d_ = (r0_ - ((volatile LAS unsigned long long*)((LAS unsigned char*)lds_raw + MISC_OFF + 200))[0]) * 3ull;
        while (__builtin_amdgcn_s_memrealtime() - r0_ < d_ && __builtin_amdgcn_s_memrealtime() - r0_ < 2000000ull) __builtin_amdgcn_s_sleep(16); }
#endif
    SEAM(2);

    }
    LAS float* rstd_lds = (LAS float*)(FR.lds + LDS_RSTD_OFF);
    for (int l = 0; l < NL; ++l) {
        const int pb = PH_L0 + l * NPH;
        unsigned char* wl = ws + WS_W + (size_t)l * W_L;
        const float* modl = MOD + (size_t)l * NB * NMD;
#define RSTD_TABLE(Ncols, slot, lg_) do { int tl_ = (int)threadIdx.x; asm volatile("" : "+v"(tl_)); pg8::StaticOrder S_; S_.init(M, (Ncols), FR.G, (int)blockIdx.x); const float* sq_ = SSQ + (size_t)(slot) * M * 16; \
            int pmv_[6], pnv_[6];     \
            _Pragma("unroll") for (int i_ = 0; i_ < 6; ++i_) { pg8::Unit u_{0, 0, 0}; const bool k_ = S_.next(i_, u_); pmv_[i_] = __builtin_amdgcn_readfirstlane(k_ ? u_.pm : -1); pnv_[i_] = __builtin_amdgcn_readfirstlane(k_ ? u_.pn : 0); } \
            if (tl_ < 256) { f32x4 a_[6];     \
                _Pragma("unroll") for (int i_ = 0; i_ < 6; ++i_) { const GAS f32x4* q_ = (const GAS f32x4*)(sq_ + ((size_t)(pmv_[i_] < 0 ? 0 : pmv_[i_]) * 256 + tl_) * 16); a_[i_] = (q_[0] + q_[1]) + (q_[2] + q_[3]); } \
                _Pragma("unroll") for (int i_ = 0; i_ < 6; ++i_) if (pmv_[i_] >= 0) rstd_lds[i_ * 256 + tl_] = 1.0f / sqrtf(((a_[i_][0] + a_[i_][1]) + (a_[i_][2] + a_[i_][3])) * (1.f / D) + EPS); } \
            else { float b_[6]; const GAS float* bs_ = (const GAS float*)(BIAS + (size_t)(lg_) * NB * (2 * F)) + (tl_ - 256);     \
                _Pragma("unroll") for (int i_ = 0; i_ < 6; ++i_) b_[i_] = bs_[(size_t)((pmv_[i_] < 0 ? 0 : pmv_[i_]) >> 4) * (2 * F) + pnv_[i_] * 256]; \
                _Pragma("unroll") for (int i_ = 0; i_ < 6; ++i_) if (pmv_[i_] >= 0) ((LAS float*)(FR.lds + LDS_BIAS_OFF))[i_ * 256 + tl_ - 256] = b_[i_]; } \
            __syncthreads(); } while (0)
#define FFN_IN_PHASE(k, c, WOFF, g) do { if (IN(pb + (k))) { RSTD_TABLE(2 * F, (c) & 1, l * 3 + (g)); \
            pg8::Gemm g_{XS, (const bf16_t*)(wl + (WOFF)), M, 2 * F, D, 2}; pg8::StaticOrder S; S.init(M, 2 * F, FR.G, (int)blockIdx.x); pg8::EpiSwiglu E{ws, l * 3 + (g)}; \
            if ((k) == 0) CLK_BEGIN(1); pg8::gemm_phase<pg8::EpiSwiglu, pg8::StaticOrder, true, MK_SP2>(FR.lds + RING_OFF, g_, S, E); if ((k) == 0) { CLK_END(1); EPT_END(1); } } } while (0)
#define OUT_PHASE(k, c, Aop, WOFF, Kdim, gidx, coef_, jn) do { if (IN(pb + (k))) { \
            const bool last_ = (l == NL - 1) && ((jn) == 3); \
            pg8::Gemm g_{Aop, (const bf16_t*)(wl + (WOFF)), M, D, (Kdim), (Kdim) == F ? 3 : 2}; pg8::StaticOrder S; S.init(M, D, FR.G, (int)blockIdx.x); \
            pg8::EpiResid E{ws, l, (gidx), last_ ? -1 : ((jn) == 3 ? (l + 1) * 3 : l * 3 + (jn)), ((c) + 1) & 1, (coef_)}; \
            if ((k) == 1) CLK_BEGIN(3); pg8::gemm_phase<pg8::EpiResid, pg8::StaticOrder, true, MK_SP2>(FR.lds + RING_OFF, g_, S, E); if ((k) == 1) { CLK_END(3); EPT_END(3); } } } while (0)
        const int c0 = 3 * l;
        FFN_IN_PHASE(0, c0, W_1IN, 0);
#if PROBE_REPG > 1
        if (IN(pb + 0)) xcd_barrier(bar);
        FFN_IN_PHASE(0, c0, W_1IN, 0);
#endif
        SEAM_P(pb + 0);
        OUT_PHASE(1, c0, ACT, W_1OUT, F, 2, 0.5f, 1);
#if PROBE_REPO > 1
        xcd_barrier(bar); OUT_PHASE(1, (c0) + 2, ACT, W_1OUT, F, 2, 0.0f, 1);
#endif
        SEAM_P(pb + 1);
        if (IN(pb + 2)) { RSTD_TABLE(NINP, (c0 + 1) & 1, l * 3 + 1);
            pg8::Gemm g{XS, (const bf16_t*)(wl + W_IN), M, NINP, D, 2}; pg8::StaticOrder S; S.init(M, NINP, FR.G, (int)blockIdx.x); pg8::EpiMixIn E{ws, l};
            pg8::gemm_phase<pg8::EpiMixIn, pg8::StaticOrder, true, MK_SP2>(FR.lds + RING_OFF, g, S, E); EPT_END(5); }
        SEAM_P(pb + 2);
#if !MK_NAIVE_MIX
        for (int rep5 = 0; rep5 < PROBE_REP5; ++rep5) { if (rep5) xcd_barrier(bar);
        if (IN(pb + 3)) {
            const bf16_t* GWl = (const bf16_t*)(ws + WS_GW) + (size_t)l * 2 * 6 * 64 * 64;
            const float lam = ((const float*)(ws + WS_LAMS))[l], lam_init = args.lam_init[l];
            LAS unsigned* qw = (LAS unsigned*)(FR.lds + LDSCTL_OFF + 256);
            CLK_BEGIN(2);
            constexpr unsigned N_RG = NB * 64 * 6 / NWAVES, Q_RG = (unsigned)mix::N_RET, Q_DIFF = Q_RG + N_RG, Q_CONV = Q_DIFF + (unsigned)mix::N_DIFF;
            unsigned* rgflags = (unsigned*)(ctl + 200000 + (l + NL * rep5) * (NB * 64 * 6));
            for (;;) {
                if ((int)threadIdx.x == 0) *qw = __hip_atomic_fetch_add((unsigned*)(ctl + CW_Q + 64 * (l + NL * rep5)), 1u, RLX_AGENT);
                __syncthreads();
                const unsigned it = __builtin_amdgcn_readfirstlane(*qw);
                if (it >= Q_RG && it < Q_DIFF) { const int wi = (int)(it - Q_RG) * NWAVES + FR.wave;
                    mix::rglru_fused(wi, PROJ, GWl, (const float*)(ws + WS_SP8) + l * RW, args.in[14] + l * 4 * RW, args.in[15] + l * RW, args.in[17] + l * RW, args.in[19] + l * RW, (float*)(ws + WS_AGGA), (float*)(ws + WS_AGGB), rgflags, Y, FR.lds + RING_OFF + FR.wave * 16384, (LAS float*)(FR.lds + LDS_RSTD_OFF + FR.wave * 2048), lane_id());
                    continue; }
                if (it >= Q_CONV) {
                    const int cw = (int)(it - Q_CONV);
                    if (l + 1 >= NL || cw >= CONV_WG_ITEMS) break;
                    const int r = cw * NWAVES + FR.wave;
                    if (r < CONV_ITEMS_L) conv_item(ConvSrc{args.in[8], args.in[9], args.in[10], args.in[11], args.in[12], args.in[13]}, ws, l + 1, r, (LAS float*)(FR.lds + RING_OFF + FR.wave * 16384), lane_id());
                    continue; }
                const unsigned code = mix::g_items.v[it < Q_RG ? it : it - N_RG]; const int qb = (code >> 8) & 15, bh = code & 31;
                if (code & 0x8000u) mix::ret_seq(bh >> 2, bh & 3, PROJ, Y, FR.lds + RING_OFF);
                else mix::attn_unit<0>(bh / 6, bh % 6, qb, PROJ, Y, FR.lds + RING_OFF, lam, lam_init, args.in[25] + l * 64);
            }
            CLK_END(2);
        } }
#endif
        SEAM_P(pb + 3);
        OUT_PHASE(5, c0 + 1, Y, W_OUT, D, 5, 1.0f, 2);
#if PROBE_REPO > 1
        xcd_barrier(bar); OUT_PHASE(5, (c0 + 1) + 2, Y, W_OUT, D, 5, 0.0f, 2);
#endif
        SEAM_P(pb + 5);
        FFN_IN_PHASE(6, c0 + 2, W_2IN, 2);
        if (IN(pb + 6) && l + 1 < NL) {
            const int nfull = ((M / 256) * (2 * F / 256)) % FR.G;
            if (nfull > 0) { if ((int)blockIdx.x >= nfull) bias_layer_mma(ws, l + 1, FR.lds + RING_OFF, ((int)blockIdx.x - nfull) * NWAVES + FR.wave, (FR.G - nfull) * NWAVES, lane_id()); }
            else bias_layer_mma(ws, l + 1, FR.lds + RING_OFF, FR.gw, FR.NGW, lane_id());
        }
        SEAM_P(pb + 6);
#if MK_ONE_LAUNCH
        if (l == NL - 1) {
            pg8::Gemm g_{ACT, (const bf16_t*)(wl + W_2OUT), M, D, F, 3}; pg8::StaticOrder S; S.init(M, D, FR.G, (int)blockIdx.x);
            pg8::EpiFinal E{ws, args.out, args.in[26], (unsigned*)(ctl + 8192), l, 8, 0.5f};
            pg8::gemm_phase<pg8::EpiFinal, pg8::StaticOrder, true, MK_SP2>(FR.lds + RING_OFF, g_, S, E);
            break; }
#endif
        OUT_PHASE(7, c0 + 2, ACT, W_2OUT, F, 8, 0.5f, 3);
#if PROBE_REPO > 1
        xcd_barrier(bar); OUT_PHASE(7, (c0 + 2) + 2, ACT, W_2OUT, F, 8, 0.0f, 3);
#endif
        SEAM_P(pb + 7);
#if PROBE_PRO >= 30
        if (l == PROBE_PRO % 10 && blockIdx.x == 0 && (int)threadIdx.x == 0) ((volatile LAS unsigned long long*)((LAS unsigned char*)lds_raw + MISC_OFF + 200))[1] = __builtin_amdgcn_s_memrealtime();
#elif PROBE_PRO >= 10
        if (l == PROBE_PRO % 10 && blockIdx.x == 0 && (int)threadIdx.x == 0) { const unsigned long long r0_ = __builtin_amdgcn_s_memrealtime(), d_ = PROBE_PRO >= 20 ? 20000ull : (r0_ - ((volatile LAS unsigned long long*)((LAS unsigned char*)lds_raw + MISC_OFF + 200))[0]);
            while (__builtin_amdgcn_s_memrealtime() - r0_ < d_ && __builtin_amdgcn_s_memrealtime() - r0_ < 2000000ull) __builtin_amdgcn_s_sleep(16); }
#endif
    }
    if (!MK_ONE_LAUNCH && IN(PH_FINAL)) {
        int lnf = lane_id(); asm volatile("" : "+v"(lnf));
        const float* gp = args.in[26]; f32x4 Gv[4];
#pragma unroll
        for (int jj = 0; jj < 4; ++jj) Gv[jj] = *(const f32x4*)(gp + 4 * lnf + 256 * jj);
        for (int rr = 0; rr < 8; ++rr) { const int m = FR.gw * 8 + rr; const GAS u32x2* xr = (const GAS u32x2*)((const bf16_t*)(ws + WS_X) + (size_t)m * D) + lnf; f32x4 v[4]; float s2 = 0.f;
#pragma unroll
            for (int jj = 0; jj < 4; ++jj) { const u32x2 xw = xr[64 * jj]; v[jj] = (f32x4){hlo(xw.x), hhi(xw.x), hlo(xw.y), hhi(xw.y)}; s2 += (v[jj].x * v[jj].x + v[jj].y * v[jj].y) + (v[jj].z * v[jj].z + v[jj].w * v[jj].w); }
            const float rstd = 1.0f / sqrtf(wave_sum(s2) * (1.f / D) + EPS);
            GAS f32x4* o = (GAS f32x4*)(args.out + (size_t)m * D) + lnf;
#pragma unroll
            for (int jj = 0; jj < 4; ++jj) o[64 * jj] = v[jj] * rstd * Gv[jj]; }
    }
#if PROBE_PRO == 2 || PROBE_PRO >= 30
    if (blockIdx.x == 0 && (int)threadIdx.x == 0) { asm volatile("s_waitcnt vmcnt(0)" ::: "memory"); volatile LAS unsigned long long* st_ = (volatile LAS unsigned long long*)((LAS unsigned char*)lds_raw + MISC_OFF + 200); const unsigned long long r0_ = __builtin_amdgcn_s_memrealtime(), d_ = (PROBE_PRO >= 30 ? st_[1] : r0_) - st_[0];
        while (__builtin_amdgcn_s_memrealtime() - r0_ < d_ && __builtin_amdgcn_s_memrealtime() - r0_ < 2000000ull) __builtin_amdgcn_s_sleep(16); }
#endif
#if PROBE_TL
    if (blockIdx.x == 0 && (int)threadIdx.x == 0) { asm volatile("s_waitcnt vmcnt(0)" ::: "memory"); volatile LAS unsigned long long* st_ = (volatile LAS unsigned long long*)((LAS unsigned char*)lds_raw + MISC_OFF + 256);
        const int p_ = PROBE_TL - 1, q_ = p_ == 0 ? -1 : (p_ == 5 ? 3 : p_ - 1); const unsigned long long d_ = (st_[1 + p_] - st_[1 + q_]) * 2ull, r0_ = __builtin_amdgcn_s_memrealtime();
        while (__builtin_amdgcn_s_memrealtime() - r0_ < d_ && __builtin_amdgcn_s_memrealtime() - r0_ < 2000000ull) __builtin_amdgcn_s_sleep(16); }
#endif
#undef IN
#undef SEAM
#undef bar
}

__global__ void nv_conv(const bf16_t* PROJ, const float* cw, const float* cb, float* xc) {
    const int idx = blockIdx.x * 256 + threadIdx.x; if (idx >= M * RW) return;
    const int m = idx / RW, c = idx % RW, t = m & (T - 1); float s = cb[c];
    for (int j = 0; j < 4; ++j) { const int tt = t - 3 + j; if (tt >= 0) s += cw[j * RW + c] * bf2f(PROJ[(size_t)(m - 3 + j) * NINP + C_RX + c]); }
    xc[idx] = s;
}
__global__ void nv_gates(const float* xc, const float* wa, const float* ba, const float* wx, const float* bx, const float* lam, float* av, float* bv) {
    const int idx = blockIdx.x * 256 + threadIdx.x; if (idx >= M * RW) return;
    const int m = idx / RW, c = idx % RW, h = c >> 6, cc = c & 63; float sr = ba[c], si = bx[c];
    for (int i = 0; i < 64; ++i) { const float xv = xc[(size_t)m * RW + 64 * h + i]; sr += xv * wa[(h * 64 + i) * 64 + cc]; si += xv * wx[(h * 64 + i) * 64 + cc]; }
    const float r = 1.f / (1.f + expf(-sr)), ig = 1.f / (1.f + expf(-si)); const float sp = log1pf(expf(-lam[c])); const float la = -8.0f * r * sp;
    av[idx] = expf(la); bv[idx] = sqrtf(-expm1f(2.f * la)) * ig * xc[idx];
}
__global__ void nv_scan(const float* av, const float* bv, const bf16_t* PROJ, bf16_t* Y) {
    const int idx = blockIdx.x * 64 + threadIdx.x; if (idx >= NB * RW) return;
    const int b = idx / RW, c = idx % RW; float h = 0.f;
    for (int t = 0; t < T; ++t) { const size_t m = (size_t)b * T + t; h = av[m * RW + c] * h + bv[m * RW + c];
        const float g = bf2f(PROJ[m * NINP + C_RG + c]); const float u = 0.7978845608028654f * (g + 0.044715f * g * g * g); const float y = 0.5f * g * (1.f + tanhf(u)) * h;
        Y[m * D + c] = (bf16_t)(pk2(y, 0.f) & 0xffffu); }
}
__global__ void __launch_bounds__(64) nv_diff(const bf16_t* PROJ, float* OT) {
    const int t = blockIdx.x * 64 + threadIdx.x, hc = blockIdx.y, h = hc >> 1, comp = hc & 1, b = blockIdx.z;
    const size_t m = (size_t)b * T + t;
    float q[32], o[64];
#pragma unroll
    for (int i = 0; i < 32; ++i) q[i] = bf2f(PROJ[m * NINP + C_DQ + 64 * h + 32 * comp + i]);
#pragma unroll
    for (int i = 0; i < 64; ++i) o[i] = 0.f;
    float mx = -INFINITY, lsum = 0.f; const int tmax = blockIdx.x * 64 + 63;
    for (int j = 0; j <= tmax; ++j) {
        const bf16_t* kr = PROJ + ((size_t)b * T + j) * NINP + C_DK + 64 * h + 32 * comp; const bf16_t* vr = PROJ + ((size_t)b * T + j) * NINP + C_DV + 64 * h;
        float s = 0.f;
#pragma unroll
        for (int i = 0; i < 32; ++i) s += q[i] * bf2f(kr[i]);
        if (j <= t) { const float mn = fmaxf(mx, s); const float al = exp2f(mx - mn), p = exp2f(s - mn); lsum = lsum * al + p; mx = mn;
#pragma unroll
            for (int i = 0; i < 64; ++i) o[i] = o[i] * al + p * bf2f(vr[i]); }
    }
    const float il = 1.f / lsum; float* op = OT + ((m * 6 + h) * 2 + comp) * 64;
#pragma unroll
    for (int i = 0; i < 64; ++i) op[i] = o[i] * il;
}
__global__ void nv_diff_fin(const float* OT, const float* lq1, const float* lk1, const float* lq2, const float* lk2, const float* subg, float lambda_init, bf16_t* Y) {
    const int idx = blockIdx.x * 256 + threadIdx.x; if (idx >= M * 6) return;
    float s1 = 0.f, s2 = 0.f; for (int i = 0; i < 32; ++i) { s1 += lq1[i] * lk1[i]; s2 += lq2[i] * lk2[i]; }
    const float lam = expf(s1) - expf(s2) + lambda_init;
    const int m = idx / 6, h = idx % 6; const float* o1 = OT + ((size_t)idx * 2) * 64; const float* o2 = o1 + 64; float ss = 0.f;
    for (int i = 0; i < 64; ++i) { const float v = o1[i] - lam * o2[i]; ss += v * v; }
    const float r = 1.0f / sqrtf(ss * (1.f / 64.f) + EPS) * (1.f - lambda_init);
    for (int i = 0; i < 64; ++i) { const float v = (o1[i] - lam * o2[i]) * r * subg[i]; Y[(size_t)m * D + RW + 64 * h + i] = (bf16_t)(pk2(v, 0.f) & 0xffffu); }
}
__global__ void __launch_bounds__(64) nv_ret(const bf16_t* PROJ, bf16_t* Y) {
    const int t = blockIdx.x * 64 + threadIdx.x, h = blockIdx.y, b = blockIdx.z; const size_t m = (size_t)b * T + t;
    float q[64], o[64];
#pragma unroll
    for (int i = 0; i < 64; ++i) { q[i] = bf2f(PROJ[m * NINP + C_TQ + 64 * h + i]); o[i] = 0.f; }
    const float lg2 = log2f(1.0f - exp2f(-5.0f - (float)h)); const int tmax = blockIdx.x * 64 + 63;
    for (int j = 0; j <= tmax; ++j) {
        const bf16_t* kr = PROJ + ((size_t)b * T + j) * NINP + C_TK + 64 * h; const bf16_t* vr = PROJ + ((size_t)b * T + j) * NINP + C_TV + 64 * h;
        float s = 0.f;
#pragma unroll
        for (int i = 0; i < 64; ++i) s += q[i] * bf2f(kr[i]);
        if (j <= t) { const float p = s * exp2f(64.0f * (float)((t >> 6) - (j >> 6)) * lg2);
#pragma unroll
            for (int i = 0; i < 64; ++i) o[i] += p * bf2f(vr[i]); }
    }
    float ss = 0.f;
#pragma unroll
    for (int i = 0; i < 64; ++i) ss += o[i] * o[i];
    const float r = 1.0f / sqrtf(ss * (1.f / 64.f) + EPS);
#pragma unroll
    for (int i = 0; i < 64; ++i) { const float g = bf2f(PROJ[m * NINP + C_TG + 64 * h + i]); const float v = g / (1.f + expf(-g)) * o[i] * r; Y[m * D + 768 + 64 * h + i] = (bf16_t)(pk2(v, 0.f) & 0xffffu); }
}

extern "C" void kernel_launch(void* const* d_in, const int* in_sizes, int n_in, void* d_out, int out_size, void* d_ws, size_t ws_size, hipStream_t stream) {
    static int grid = 0;
    if (grid == 0) {
        if (n_in != 27 || in_sizes[0] != M * D || out_size != M * D || ws_size < WS_END) { fprintf(stderr, "kernel_launch: unexpected shapes (n_in %d, ws %zu < %zu)\n", n_in, ws_size, (size_t)WS_END); grid = -1; return; }
        int dev = 0, cus = 0;
        if (hipGetDevice(&dev) != hipSuccess || hipDeviceGetAttribute(&cus, hipDeviceAttributeMultiprocessorCount, dev) != hipSuccess) { grid = -1; return; }
        if (hipFuncSetAttribute((const void*)mega, hipFuncAttributeMaxDynamicSharedMemorySize, LDS_BYTES) != hipSuccess) { fprintf(stderr, "kernel_launch: hipFuncSetAttribute failed\n"); grid = -1; return; }
        int per_cu = 0;
        if (hipOccupancyMaxActiveBlocksPerMultiprocessor(&per_cu, (const void*)mega, NWAVES * 64, LDS_BYTES) != hipSuccess || per_cu < 1) fprintf(stderr, "kernel_launch: occupancy query says %d\n", per_cu);
        (void)hipGetLastError();
        grid = cus;
        if (grid != 256) { fprintf(stderr, "kernel_launch: built for 256 CUs, got %d\n", grid); }
    }
    if (grid < 0) return;
    (void)hipMemsetAsync((char*)d_ws + WS_CTL, 0, CTL_ZERO_BYTES, stream);
    Args a{};
    for (int i = 0; i < 27; ++i) a.in[i] = (const float*)d_in[i];
    a.pos = (const int*)d_in[2]; a.out = (float*)d_out; a.ws = (unsigned char*)d_ws;
    for (int l = 0; l < NL; ++l) a.lam_init[l] = (float)(0.8 - 0.6 * exp(-0.3 * (double)l));
    unsigned char* ws = (unsigned char*)d_ws;
#if MK_ONE_LAUNCH
    a.ph_lo = 0; a.ph_hi = PH_END;
    hipLaunchKernelGGL(mega, dim3(grid), dim3(NWAVES * 64), LDS_BYTES, stream, a);
#else
    int nrun = 0; auto run = [&](int lo, int hi) { a.ph_lo = lo; a.ph_hi = hi; a.li = nrun++; hipLaunchKernelGGL(mega, dim3(grid), dim3(NWAVES * 64), LDS_BYTES, stream, a); };
    int seg_lo = 0;
    for (int l = 0; l < NL; ++l) {
        const int pb = PH_L0 + l * NPH;
        run(seg_lo, pb + 3); seg_lo = pb + 5;
#if !MK_NAIVE_MIX
        run(pb + 3, pb + 4); run(pb + 4, pb + 5);
#endif
        if (MK_NAIVE_MASK) {
            const bf16_t* PROJ = (const bf16_t*)(ws + WS_PROJ); bf16_t* Y = (bf16_t*)(ws + WS_Y);
            float* xc = (float*)(ws + WS_TMP); float* av = xc + (size_t)M * RW; float* bv = av + (size_t)M * RW; float* OT = (float*)(ws + WS_TMP);
            if (MK_NAIVE_MASK & 1) {
                hipLaunchKernelGGL(nv_conv, dim3(M * RW / 256), dim3(256), 0, stream, PROJ, a.in[14] + l * 4 * RW, a.in[15] + l * RW, xc);
                hipLaunchKernelGGL(nv_gates, dim3(M * RW / 256), dim3(256), 0, stream, xc, a.in[16] + l * 6 * 64 * 64, a.in[17] + l * RW, a.in[18] + l * 6 * 64 * 64, a.in[19] + l * RW, a.in[20] + l * RW, av, bv);
                hipLaunchKernelGGL(nv_scan, dim3(NB * RW / 64), dim3(64), 0, stream, av, bv, PROJ, Y); }
            if (MK_NAIVE_MASK & 2) {
                hipLaunchKernelGGL(nv_diff, dim3(T / 64, 12, NB), dim3(64), 0, stream, PROJ, OT);
                hipLaunchKernelGGL(nv_diff_fin, dim3(M * 6 / 256), dim3(256), 0, stream, OT, a.in[21] + l * 32, a.in[22] + l * 32, a.in[23] + l * 32, a.in[24] + l * 32, a.in[25] + l * 64, a.lam_init[l], Y); }
            if (MK_NAIVE_MASK & 4) hipLaunchKernelGGL(nv_ret, dim3(T / 64, 4, NB), dim3(64), 0, stream, PROJ, Y);
        }
    }
    run(seg_lo, PH_END);
#endif
}
```
